# Optimizing an MI355X kernel written in HIP

```python
import jax, jax.numpy as jnp
from jax import lax
import numpy as np

D_MODEL = 2048
BATCH = 2
SEQ = 4096
DEPTH = 4

GRID_W = 64
CTX_LEN = 256
HEAD_DIM = 64
BLOCK = 128
WINDOW = 128
ROPE_THETA = 10000.0
A_HEADS = D_MODEL // 256
A_KV_HEADS = A_HEADS // 4
C_HEADS = D_MODEL // 256
C_KV_HEADS = C_HEADS // 4
B_HEADS = D_MODEL // 128
B_WIDTH = B_HEADS * HEAD_DIM
LORA_DECAY = 96
LORA_ICLR = 96
LORA_GATE = 256
D_FF = 4 * D_MODEL
A_Q_W = A_HEADS * HEAD_DIM
A_KV_W = A_KV_HEADS * HEAD_DIM
C_Q_W = C_HEADS * HEAD_DIM
C_KV_W = C_KV_HEADS * HEAD_DIM
A_IN = A_Q_W + 2 * A_KV_W
B_IN = 3 * B_WIDTH + 2 * LORA_DECAY + 2 * LORA_ICLR + LORA_GATE
C_IN = C_Q_W + 2 * C_KV_W
N_IN = A_IN + B_IN + C_IN
MIX_W = A_Q_W + B_WIDTH + C_Q_W
B_SPLITS = (B_WIDTH, 2 * B_WIDTH, 3 * B_WIDTH, 3 * B_WIDTH + LORA_DECAY, 3 * B_WIDTH + 2 * LORA_DECAY, 3 * B_WIDTH + 2 * LORA_DECAY + LORA_ICLR, 3 * B_WIDTH + 2 * LORA_DECAY + 2 * LORA_ICLR)
NORM_EPS = 1e-6
GN_EPS = 64e-5
NEG_INF = -1e30

kernel_name = "hybrid_parallel_heads_dit_block"


def rms_norm(x, g):
    xf = x.astype(jnp.float32)
    y = xf * lax.rsqrt(jnp.mean(xf * xf, -1, keepdims=True) + NORM_EPS)
    return (y * g.astype(jnp.float32)).astype(x.dtype)


def axial_rope_tables(length):
    rows = length // GRID_W
    row = jnp.broadcast_to(jnp.arange(rows)[:, None], (rows, GRID_W)).reshape(-1)
    col = jnp.broadcast_to(jnp.arange(GRID_W)[None, :], (rows, GRID_W)).reshape(-1)
    n_freq = HEAD_DIM // 4
    inv = ROPE_THETA ** (-jnp.arange(n_freq, dtype=jnp.float32) / n_freq)
    ang = jnp.concatenate([row[:, None].astype(jnp.float32) * inv, col[:, None].astype(jnp.float32) * inv], -1)
    return jnp.cos(ang), jnp.sin(ang)


def apply_rope(x, cos, sin):
    half = HEAD_DIM // 2
    xf = x.astype(jnp.float32)
    x1, x2 = xf[..., :half], xf[..., half:]
    c, s = cos[:, None, :], sin[:, None, :]
    return jnp.concatenate([x1 * c - x2 * s, x1 * s + x2 * c], -1).astype(x.dtype)


def joint_softmax(logits, sink=None):
    sizes = [s.shape[-1] for s in logits]
    parts = list(logits)
    if sink is not None:
        parts.append(jnp.broadcast_to(sink.astype(jnp.float32), logits[0].shape[:-1] + (1,)))
    p = jax.nn.softmax(jnp.concatenate(parts, -1), axis=-1)
    out, start = [], 0
    for n in sizes:
        out.append(p[..., start:start + n])
        start += n
    return out


def attn_heads(p, n_heads, n_kv, q_g, k_g):
    bsz, t = p.shape[:2]
    q, k, v = jnp.split(p, (n_heads * HEAD_DIM, (n_heads + n_kv) * HEAD_DIM), -1)
    q = rms_norm(q.reshape(bsz, t, n_heads, HEAD_DIM), q_g)
    k = rms_norm(k.reshape(bsz, t, n_kv, HEAD_DIM), k_g)
    return q, k, v.reshape(bsz, t, n_kv, HEAD_DIM)


def window_attention(q, k, v, kc, vc, sink):
    bsz, t, h, dh = q.shape
    hk = k.shape[2]
    nb = t // BLOCK
    scale = dh ** -0.5
    qb = q.reshape(bsz, nb, BLOCK, hk, h // hk, dh)
    pad = ((0, 0), (BLOCK, BLOCK), (0, 0), (0, 0))
    kp, vp = jnp.pad(k, pad), jnp.pad(v, pad)
    idx = jnp.arange(nb)[:, None] * BLOCK + jnp.arange(3 * BLOCK)[None, :]
    kb, vb = kp[:, idx], vp[:, idx]
    qpos = jnp.arange(nb)[:, None] * BLOCK + jnp.arange(BLOCK)[None, :]
    kpos = idx - BLOCK
    valid = (jnp.abs(qpos[:, :, None] - kpos[:, None, :]) <= WINDOW) & (kpos[:, None, :] >= 0) & (kpos[:, None, :] < t)
    s_lat = jnp.einsum('bnqhgd,bnkhd->bnhgqk', qb, kb).astype(jnp.float32) * scale
    s_lat = jnp.where(valid[None, :, None, None], s_lat, NEG_INF)
    s_ctx = jnp.einsum('bnqhgd,bchd->bnhgqc', qb, kc).astype(jnp.float32) * scale
    p_lat, p_ctx = joint_softmax([s_lat, s_ctx], sink)
    o = (jnp.einsum('bnhgqk,bnkhd->bnqhgd', p_lat.astype(v.dtype), vb)
         + jnp.einsum('bnhgqc,bchd->bnqhgd', p_ctx.astype(vc.dtype), vc))
    return o.reshape(bsz, t, h * dh)


def global_attention(q, k, v, kc, vc):
    bsz, t, h, dh = q.shape
    hk = k.shape[2]
    nb = t // BLOCK
    scale = dh ** -0.5
    qb = jnp.moveaxis(q.reshape(bsz, nb, BLOCK, hk, h // hk, dh), 1, 0)

    def one_block(qblk):
        s_lat = jnp.einsum('bqhgd,bkhd->bhgqk', qblk, k).astype(jnp.float32) * scale
        s_ctx = jnp.einsum('bqhgd,bchd->bhgqc', qblk, kc).astype(jnp.float32) * scale
        p_lat, p_ctx = joint_softmax([s_lat, s_ctx])
        return (jnp.einsum('bhgqk,bkhd->bqhgd', p_lat.astype(v.dtype), v)
                + jnp.einsum('bhgqc,bchd->bqhgd', p_ctx.astype(vc.dtype), vc))

    o = lax.map(one_block, qb)
    return jnp.moveaxis(o, 0, 1).reshape(bsz, t, h * dh)


def context_attention(q, k, v, sink):
    bsz, cn, h, dh = q.shape
    hk = k.shape[2]
    qg = q.reshape(bsz, cn, hk, h // hk, dh)
    s = jnp.einsum('bqhgd,bkhd->bhgqk', qg, k).astype(jnp.float32) * dh ** -0.5
    (p,) = joint_softmax([s], sink)
    o = jnp.einsum('bhgqk,bkhd->bqhgd', p.astype(v.dtype), v)
    return o.reshape(bsz, cn, h * dh)


def centred_shift(p, mu_prev, mu_next):
    prev = jnp.pad(p, ((0, 0), (1, 0), (0, 0)))[:, :-1]
    nxt = jnp.pad(p, ((0, 0), (0, 1), (0, 0)))[:, 1:]
    return p + mu_prev * (prev - p) + mu_next * (nxt - p)


def rwkv_streams(p, w0, w_up, a0, a_up, g_up, k_k, k_a):
    p = p.astype(jnp.float32)
    r, k, v, wd_f, wd_b, ad_f, ad_b, gd = jnp.split(p, B_SPLITS, -1)
    bsz, t = p.shape[:2]
    heads = lambda z: z.reshape(bsz, t, B_HEADS, HEAD_DIM)
    kk = heads(k * k_k)
    kk = kk / jnp.maximum(jnp.sqrt(jnp.sum(kk * kk, -1, keepdims=True)), 1e-12)
    decay, keys, iclr = [], [], []
    for d, (wd, ad) in enumerate(((wd_f, ad_f), (wd_b, ad_b))):
        w_log = -jax.nn.softplus(-(w0[d] + jnp.tanh(wd) @ w_up[d])) - 0.5
        a = jax.nn.sigmoid(a0[d] + ad @ a_up[d])
        decay.append(heads(jnp.exp(-jnp.exp(w_log))))
        keys.append(heads(k * (1.0 + (a - 1.0) * k_a)))
        iclr.append(heads(a))
    g = jax.nn.sigmoid(gd) @ g_up
    return dict(r=heads(r), v=heads(v), kk=kk, decay=decay, k=keys, a=iclr, g=g)


def wkv7_scan(state0, s, d, reverse):
    tm = lambda z: jnp.swapaxes(z, 0, 1)
    xs = (tm(s['r']), tm(s['decay'][d]), tm(s['k'][d]), tm(s['v']), tm(s['kk']), tm(s['a'][d]))

    def step(S, inp):
        r_t, w_t, k_t, v_t, kk_t, a_t = inp
        sa = jnp.einsum('bhvk,bhk->bhv', S, kk_t)
        S = S * w_t[:, :, None, :] - sa[..., None] * (kk_t * a_t)[:, :, None, :] + v_t[..., None] * k_t[:, :, None, :]
        return S, jnp.einsum('bhvk,bhk->bhv', S, r_t)

    s_fin, y = lax.scan(step, state0, xs, reverse=reverse)
    return s_fin, jnp.swapaxes(y, 0, 1)


def rwkv_readout(ys, s, r_k, gn_g, gn_b):
    y = ys[0] + ys[1]
    bsz, t = y.shape[:2]
    mu = jnp.mean(y, -1, keepdims=True)
    var = jnp.mean(jnp.square(y - mu), -1, keepdims=True)
    yn = ((y - mu) * lax.rsqrt(var + GN_EPS)).reshape(bsz, t, B_WIDTH) * gn_g + gn_b
    rk = r_k.reshape(B_HEADS, HEAD_DIM)
    bonus = jnp.sum(s['r'] * (s['k'][0] + s['k'][1]) * rk, -1, keepdims=True) * s['v']
    return (yn + bonus.reshape(bsz, t, B_WIDTH)) * s['g']


def rwkv_mixer(p_c, p_l, mu, w0, w_up, a0, a_up, g_up, k_k, k_a, r_k, gn_g, gn_b, need_ctx_out):
    s_c = rwkv_streams(centred_shift(p_c, mu[0], mu[1]), w0, w_up, a0, a_up, g_up, k_k, k_a)
    s_l = rwkv_streams(centred_shift(p_l, mu[0], mu[1]), w0, w_up, a0, a_up, g_up, k_k, k_a)
    state0 = jnp.zeros((p_l.shape[0], B_HEADS, HEAD_DIM, HEAD_DIM), jnp.float32)
    ys_c, ys_l = [], []
    for d in range(2):
        st_c, y_c = wkv7_scan(state0, s_c, d, d == 1)
        _, y_l = wkv7_scan(st_c, s_l, d, d == 1)
        ys_c.append(y_c)
        ys_l.append(y_l)
    out_l = rwkv_readout(ys_l, s_l, r_k, gn_g, gn_b).astype(p_l.dtype)
    out_c = rwkv_readout(ys_c, s_c, r_k, gn_g, gn_b).astype(p_c.dtype) if need_ctx_out else None
    return out_c, out_l


def sqrelu_mlp(u, w1, w2):
    return jnp.square(jax.nn.relu(u @ w1)) @ w2


def setup_inputs(seed: int = 0) -> dict:
    key = jax.random.key(seed)
    ks = jax.random.split(key, 32)
    f32 = jnp.float32
    nrm = lambda k, shape, s: jax.random.normal(k, shape, f32) * s
    return {
        'x': nrm(ks[0], (BATCH, SEQ, D_MODEL), 1.0),
        'c': nrm(ks[1], (BATCH, D_MODEL), 1.0),
        'ctx': nrm(ks[2], (BATCH, CTX_LEN, D_MODEL), 1.0),
        'c_ctx': nrm(ks[3], (D_MODEL,), 1.0),
        'ada_w': nrm(ks[4], (DEPTH, D_MODEL, 6 * D_MODEL), 0.5 * D_MODEL ** -0.5),
        'ada_b': nrm(ks[5], (DEPTH, 6 * D_MODEL), 0.02),
        'norm1_g': 1.0 + nrm(ks[6], (DEPTH, D_MODEL), 0.02),
        'norm2_g': 1.0 + nrm(ks[7], (DEPTH, D_MODEL), 0.02),
        'w_in': nrm(ks[8], (DEPTH, D_MODEL, N_IN), D_MODEL ** -0.5),
        'a_q_norm': 1.0 + nrm(ks[9], (DEPTH, HEAD_DIM), 0.02),
        'a_k_norm': 1.0 + nrm(ks[10], (DEPTH, HEAD_DIM), 0.02),
        'a_sink': nrm(ks[11], (DEPTH, A_HEADS), 0.5),
        'c_q_norm': 1.0 + nrm(ks[12], (DEPTH, HEAD_DIM), 0.02),
        'c_k_norm': 1.0 + nrm(ks[13], (DEPTH, HEAD_DIM), 0.02),
        'shift_mu': jax.random.uniform(ks[14], (DEPTH, 2, B_IN), f32, 0.0, 0.5),
        'decay_w0': jax.random.uniform(ks[15], (DEPTH, 2, B_WIDTH), f32, -4.0, 1.0),
        'decay_up': nrm(ks[16], (DEPTH, 2, LORA_DECAY, B_WIDTH), 0.5 * LORA_DECAY ** -0.5),
        'iclr_a0': nrm(ks[17], (DEPTH, 2, B_WIDTH), 0.5),
        'iclr_up': nrm(ks[18], (DEPTH, 2, LORA_ICLR, B_WIDTH), 0.5 * LORA_ICLR ** -0.5),
        'gate_up': nrm(ks[19], (DEPTH, LORA_GATE, B_WIDTH), LORA_GATE ** -0.5),
        'k_k': 0.85 + nrm(ks[20], (DEPTH, B_WIDTH), 0.02),
        'k_a': 1.0 + nrm(ks[21], (DEPTH, B_WIDTH), 0.02),
        'r_k': nrm(ks[22], (DEPTH, B_WIDTH), 0.1),
        'gn_g': 1.0 + nrm(ks[23], (DEPTH, B_WIDTH), 0.02),
        'gn_b': nrm(ks[24], (DEPTH, B_WIDTH), 0.02),
        'w_out': nrm(ks[25], (DEPTH, MIX_W, D_MODEL), MIX_W ** -0.5),
        'mlp_w1': nrm(ks[26], (DEPTH, D_MODEL, D_FF), D_MODEL ** -0.5),
        'mlp_w2': nrm(ks[27], (DEPTH, D_FF, D_MODEL), D_FF ** -0.5),
    }


def reference(x, c, ctx, c_ctx, ada_w, ada_b, norm1_g, norm2_g, w_in, a_q_norm, a_k_norm, a_sink, c_q_norm, c_k_norm, shift_mu, decay_w0, decay_up, iclr_a0, iclr_up, gate_up, k_k, k_a, r_k, gn_g, gn_b, w_out, mlp_w1, mlp_w2):
    cos, sin = axial_rope_tables(x.shape[1])
    h_lat, h_ctx = x, ctx
    for l in range(DEPTH):
        last = l == DEPTH - 1
        mod_lat = jax.nn.silu(c) @ ada_w[l] + ada_b[l]
        mod_ctx = jax.nn.silu(c_ctx) @ ada_w[l] + ada_b[l]
        sh1_l, sc1_l, g1_l, sh2_l, sc2_l, g2_l = jnp.split(mod_lat[:, None, :], 6, -1)
        sh1_c, sc1_c, g1_c, sh2_c, sc2_c, g2_c = jnp.split(mod_ctx, 6, -1)

        u_lat = rms_norm(h_lat, norm1_g[l]) * (1.0 + sc1_l) + sh1_l
        u_ctx = rms_norm(h_ctx, norm1_g[l]) * (1.0 + sc1_c) + sh1_c
        pA_l, pB_l, pC_l = jnp.split(u_lat @ w_in[l], (A_IN, A_IN + B_IN), -1)
        pA_c, pB_c, pC_c = jnp.split(u_ctx @ w_in[l], (A_IN, A_IN + B_IN), -1)

        qA_l, kA_l, vA_l = attn_heads(pA_l, A_HEADS, A_KV_HEADS, a_q_norm[l], a_k_norm[l])
        qA_l, kA_l = apply_rope(qA_l, cos, sin), apply_rope(kA_l, cos, sin)
        qA_c, kA_c, vA_c = attn_heads(pA_c, A_HEADS, A_KV_HEADS, a_q_norm[l], a_k_norm[l])
        sinkA = a_sink[l].reshape(A_KV_HEADS, A_HEADS // A_KV_HEADS, 1, 1)
        oA_l = window_attention(qA_l, kA_l, vA_l, kA_c, vA_c, sinkA)

        oB_c, oB_l = rwkv_mixer(pB_c, pB_l, shift_mu[l], decay_w0[l], decay_up[l], iclr_a0[l], iclr_up[l], gate_up[l], k_k[l], k_a[l], r_k[l], gn_g[l], gn_b[l], not last)

        qC_l, kC_l, vC_l = attn_heads(pC_l, C_HEADS, C_KV_HEADS, c_q_norm[l], c_k_norm[l])
        qC_l, kC_l = apply_rope(qC_l, cos, sin), apply_rope(kC_l, cos, sin)
        qC_c, kC_c, vC_c = attn_heads(pC_c, C_HEADS, C_KV_HEADS, c_q_norm[l], c_k_norm[l])
        oC_l = global_attention(qC_l, kC_l, vC_l, kC_c, vC_c)

        h_lat = h_lat + g1_l * (jnp.concatenate([oA_l, oB_l, oC_l], -1) @ w_out[l])
        u2_l = rms_norm(h_lat, norm2_g[l]) * (1.0 + sc2_l) + sh2_l
        h_lat = h_lat + g2_l * sqrelu_mlp(u2_l, mlp_w1[l], mlp_w2[l])

        if not last:
            oA_c = context_attention(qA_c, kA_c, vA_c, sinkA)
            oC_c = context_attention(qC_c, kC_c, vC_c, None)
            h_ctx = h_ctx + g1_c * (jnp.concatenate([oA_c, oB_c, oC_c], -1) @ w_out[l])
            u2_c = rms_norm(h_ctx, norm2_g[l]) * (1.0 + sc2_c) + sh2_c
            h_ctx = h_ctx + g2_c * sqrelu_mlp(u2_c, mlp_w1[l], mlp_w2[l])
    return h_lat
```

```cpp
#include <hip/hip_runtime.h>
#include <cstdio>
#include <cstdint>
namespace pg8 {
#define PG8_LAS __attribute__((address_space(3)))
typedef unsigned short bf16_t;
typedef short bf16x8 __attribute__((ext_vector_type(8)));
typedef float f32x4 __attribute__((ext_vector_type(4)));
typedef unsigned u32x4 __attribute__((ext_vector_type(4)));
constexpr int BM = 256, BK = 64, HALF = 128, HTB = HALF * BK * 2  , STAGE_BYTES = 8 * HTB, NXCD = 8, WGM = 8;

__host__ __device__ __forceinline__ int lds_byte(int r, int c) { const int st = (r >> 4) * 2 + (c >> 5), rr = r & 15, cc = c & 31, ob = rr * 64 + cc * 2; return st * 1024 + (ob ^ (((ob >> 9) & 1) << 5)); }
__host__ __device__ __forceinline__ void stage_rc(int b, int& R, int& C) { const int st = b / 1024, sb = b % 1024, swz = sb ^ (((sb >> 9) & 1) << 5); R = (st >> 1) * 16 + swz / 64; C = (st & 1) * 32 + (swz % 64) / 2; }
__host__ __device__ __forceinline__ int perm32(int rho) { const int n = rho >> 4, i = rho & 15; return 8 * (i >> 2) + 4 * n + (i & 3); }

struct Unit { int pm, pn; };
struct Gemm { const bf16_t* A; const bf16_t* Bt; int M, N, K; };

struct StaticOrder {
    int nM, nN, nwg, G, c;
    __host__ __device__ void init(int M, int N, int G_, int c_) { nM = M / BM; nN = N / BM; nwg = nM * nN; G = G_; c = c_; }
    __host__ __device__ bool next(int i, Unit& u) const {
        const long L = (long)i * G + c; if (L >= nwg) return false;
        int wgid = (int)L; { const int q = nwg / NXCD, r = nwg % NXCD, xcd = wgid % NXCD, off = wgid / NXCD; wgid = (xcd < r ? xcd * (q + 1) : r * (q + 1) + (xcd - r) * q) + off; }
        const int nig = WGM * nN, gid = wgid / nig, fm = gid * WGM, gsz = (nM - fm) < WGM ? (nM - fm) : WGM;
        u.pm = fm + ((wgid % nig) % gsz); u.pn = (wgid % nig) / gsz; return true;
    }
    __device__ __forceinline__ void a_ready(const Unit&) const {}
    __device__ __forceinline__ void done(const Unit&) const {}
};

__device__ __forceinline__ unsigned cvt_pk_bf16(float lo, float hi) { unsigned r; asm volatile("v_cvt_pk_bf16_f32 %0, %1, %2" : "=v"(r) : "v"(lo), "v"(hi)); return r; }
typedef float f32x2 __attribute__((ext_vector_type(2)));
__device__ __forceinline__ f32x2 gelu_pk(f32x2 v) {
    const f32x2 av = __builtin_elementwise_abs(v), d = av * 0.2316418882f + 1.0f;
    f32x2 t; t.x = __builtin_amdgcn_rcpf(d.x); t.y = __builtin_amdgcn_rcpf(d.y);
    f32x2 q = t * 0.5307027145f + (-0.7265760135f); q = q * t + 0.7107068705f; q = q * t + (-0.142248368f); q = q * t + 0.127414796f; q = q * t;
    const f32x2 s = (v * v) * (-0.72134752044f);
    f32x2 e; e.x = __builtin_amdgcn_exp2f(s.x); e.y = __builtin_amdgcn_exp2f(s.y);
    const f32x2 m = v * (q * e), r = v - m;
    f32x2 o; o.x = v.x < 0.f ? m.x : r.x; o.y = v.y < 0.f ? m.y : r.y; return o;
}

template <int ACT  > struct EpiBf16 {
    static constexpr bool PERM = true, AFTER_DRAIN = false; static_assert(ACT == 0 || ACT == 1, "EpiBf16: ACT is 0 (none) or 1 (gelu_pk)");
    bf16_t* O; int ldc; const float* bias; int split_cols; size_t split_stride; float scale0;
    __device__ __forceinline__ void operator()(const f32x4 (&acc)[2][2][4][2], const Unit& u, int wr, int wc, int fr, int fq) const {
        const int row0 = u.pm * BM + wr * 64 + fr; int colt = u.pn * BM; bf16_t* base = O;
        float sc = 1.f; if (split_cols) { const int t = colt / split_cols; base += (size_t)t * split_stride; colt -= t * split_cols; if (t == 0) sc = scale0; }
        const int col0 = colt + wc * 32 + 8 * fq, bcol0 = u.pn * BM + wc * 32 + 8 * fq;
        f32x4 bv[2][2];
#pragma unroll
        for (int bj = 0; bj < 2; ++bj)
#pragma unroll
            for (int n = 0; n < 2; ++n) bv[bj][n] = bias ? *(const f32x4*)(bias + bcol0 + bj * HALF + 4 * n) : (f32x4){0.f, 0.f, 0.f, 0.f};
#pragma unroll
        for (int ai = 0; ai < 2; ++ai)
#pragma unroll
            for (int m = 0; m < 4; ++m) { bf16_t* rowp = base + (size_t)(row0 + ai * HALF + m * 16) * ldc + col0;
#pragma unroll
                for (int bj = 0; bj < 2; ++bj) { f32x4 v0 = acc[ai][bj][m][0] + bv[bj][0], v1 = acc[ai][bj][m][1] + bv[bj][1];
                    if (ACT == 1) { f32x2 a = gelu_pk((f32x2){v0[0], v0[1]}), b = gelu_pk((f32x2){v0[2], v0[3]}), c = gelu_pk((f32x2){v1[0], v1[1]}), d = gelu_pk((f32x2){v1[2], v1[3]});
                        v0 = (f32x4){a.x, a.y, b.x, b.y}; v1 = (f32x4){c.x, c.y, d.x, d.y}; }
                    v0 = v0 * sc; v1 = v1 * sc; u32x4 w; w.x = cvt_pk_bf16(v0[0], v0[1]); w.y = cvt_pk_bf16(v0[2], v0[3]); w.z = cvt_pk_bf16(v1[0], v1[1]); w.w = cvt_pk_bf16(v1[2], v1[3]);
                    *(u32x4*)(rowp + bj * HALF) = w; } }
    }
};
struct EpiRelu2 {
    static constexpr bool PERM = true, AFTER_DRAIN = false;
    bf16_t* O; int ldc;
    __device__ __forceinline__ void operator()(const f32x4 (&acc)[2][2][4][2], const Unit& u, int wr, int wc, int fr, int fq) const {
        const int row0 = u.pm * BM + wr * 64 + fr, col0 = u.pn * BM + wc * 32 + 8 * fq;
#pragma unroll
        for (int ai = 0; ai < 2; ++ai)
#pragma unroll
            for (int m = 0; m < 4; ++m) { bf16_t* rowp = O + (size_t)(row0 + ai * HALF + m * 16) * ldc + col0;
#pragma unroll
                for (int bj = 0; bj < 2; ++bj) { f32x4 v0 = acc[ai][bj][m][0], v1 = acc[ai][bj][m][1];
#pragma unroll
                    for (int e = 0; e < 4; ++e) { const float a = v0[e] > 0.f ? v0[e] : 0.f, b = v1[e] > 0.f ? v1[e] : 0.f; v0[e] = a * a; v1[e] = b * b; }
                    u32x4 w; w.x = cvt_pk_bf16(v0[0], v0[1]); w.y = cvt_pk_bf16(v0[2], v0[3]); w.z = cvt_pk_bf16(v1[0], v1[1]); w.w = cvt_pk_bf16(v1[2], v1[3]);
                    *(u32x4*)(rowp + bj * HALF) = w; } }
    }
};
struct EpiResid {
    static constexpr bool PERM = false, AFTER_DRAIN = false;
    const float* src_lat; const float* src_ctx; float* dst_lat; float* dst_ctx; const float* gate;
    __device__ __forceinline__ void operator()(const f32x4 (&acc)[2][2][4][2], const Unit& u, int wr, int wc, int fr, int fq) const {
        const int b = u.pm / 17, j = u.pm % 17; const bool isctx = (j == 0);
        const float* src = isctx ? src_ctx + (size_t)b * 256 * 2048 : src_lat + ((size_t)b * 4096 + (size_t)(j - 1) * 256) * 2048;
        float* dst = isctx ? dst_ctx + (size_t)b * 256 * 2048 : dst_lat + ((size_t)b * 4096 + (size_t)(j - 1) * 256) * 2048;
        const float* g = gate + (isctx ? 2 : b) * 12288;
        const int r0 = wr * 64 + fr, col0 = u.pn * BM + wc * 32 + 4 * fq;
        f32x4 gv[2][2];
#pragma unroll
        for (int bj = 0; bj < 2; ++bj)
#pragma unroll
            for (int n = 0; n < 2; ++n) gv[bj][n] = *(const f32x4*)(g + col0 + bj * HALF + n * 16);
#pragma unroll
        for (int ai = 0; ai < 2; ++ai)
#pragma unroll
            for (int m = 0; m < 4; ++m) { const size_t roff = (size_t)(r0 + ai * HALF + m * 16) * 2048 + col0;
#pragma unroll
                for (int bj = 0; bj < 2; ++bj)
#pragma unroll
                    for (int n = 0; n < 2; ++n) { const f32x4 s = *(const f32x4*)(src + roff + bj * HALF + n * 16); *(f32x4*)(dst + roff + bj * HALF + n * 16) = s + gv[bj][n] * acc[ai][bj][m][n]; } }
    }
};
struct EpiLora {
    static constexpr bool PERM = false, AFTER_DRAIN = false;
    float* out; const float* w0; const float* a0;
    __device__ __forceinline__ void operator()(const f32x4 (&acc)[2][2][4][2], const Unit& u, int wr, int wc, int fr, int fq) const {
        const int p = u.pn >> 2, rt = u.pm - 34 * p, ct = u.pn & 3;
        float* o = out + (size_t)p * 8704 * 1024;
        const int row0 = rt * BM + wr * 64 + fr, col0 = ct * BM + wc * 32 + 4 * fq;
        const float* bias = p < 2 ? w0 + p * 1024 : a0 + (p & 1) * 1024;
        f32x4 bv[2][2];
#pragma unroll
        for (int bj = 0; bj < 2; ++bj)
#pragma unroll
            for (int n = 0; n < 2; ++n) bv[bj][n] = p < 4 ? *(const f32x4*)(bias + col0 + bj * HALF + n * 16) : (f32x4){0.f, 0.f, 0.f, 0.f};
#pragma unroll
        for (int ai = 0; ai < 2; ++ai)
#pragma unroll
            for (int m = 0; m < 4; ++m) { float* rowp = o + (size_t)(row0 + ai * HALF + m * 16) * 1024 + col0;
#pragma unroll
                for (int bj = 0; bj < 2; ++bj)
#pragma unroll
                    for (int n = 0; n < 2; ++n) { const f32x4 x = acc[ai][bj][m][n] + bv[bj][n];
                        *(f32x4*)(rowp + bj * HALF + n * 16) = x; } }
    }
};
struct RowMapOrder : StaticOrder {
    int skip;
    __device__ void init2(int N, int G_, int c_, int skip_) { skip = skip_; init(skip_ ? 8192 : 8704, N, G_, c_); }
    __device__ bool next(int i, Unit& u) const { if (!StaticOrder::next(i, u)) return false; if (skip) u.pm = u.pm + 1 + (u.pm >> 4); return true; }
};
struct LoraOrder {
    int G, c;
    __device__ bool next(int i, Unit& u) const { const int L = i * G + c; if (L >= 680) return false; const int p = L / 136, rem = L % 136; u.pm = 34 * p + rem % 34; u.pn = 4 * p + rem / 34; return true; }
    __device__ __forceinline__ void a_ready(const Unit&) const {}
    __device__ __forceinline__ void done(const Unit&) const {}
};
template <class Epi, class Sched, bool ALIGN_EPI = false, bool SP2 = false>
__device__ __forceinline__ void gemm_phase(PG8_LAS unsigned char* lds, const Gemm g, const Sched& S, const Epi& E) {
    int tid_ = threadIdx.x; asm volatile("" : "+v"(tid_));
    const int tid = tid_, wid = __builtin_amdgcn_readfirstlane(tid >> 6), lane = tid & 63, wr = wid >> 2, wc = wid & 3, fr = lane & 15, fq = lane >> 4;
    const int K = g.K, nt = K / BK;
    unsigned voffA[2], voffB[2];
#pragma unroll
    for (int i = 0; i < 2; ++i) { int R, C; stage_rc(tid * 16 + i * 8192, R, C); const int Rb = Epi::PERM ? ((R & ~31) + perm32(R & 31)) : R;
        voffA[i] = (unsigned)(R * K + C) * 2u; voffB[i] = (unsigned)(Rb * K + C) * 2u; }
    const size_t kstep = (size_t)(BK * 2);
    const size_t hstep = (size_t)HALF * K * 2;
    const size_t tstep = 2 * hstep;
    const unsigned ldsw = (unsigned)wid * 1024u;
    const int aoff = lds_byte(wr * 64 + fr, fq * 8), boff = lds_byte(wc * 32 + fr, fq * 8);
#define PG8_SA(b, h) (((b) * 2 + (h)) * HTB)
#define PG8_SB(b, h) ((4 + (b) * 2 + (h)) * HTB)
#define PG8_STAGE(bufoff, gbase, voff) do { _Pragma("unroll") for (int _i = 0; _i < 2; ++_i) \
        __builtin_amdgcn_global_load_lds((const unsigned*)((const char*)(gbase) + (voff)[_i]), (PG8_LAS unsigned*)(lds + (bufoff) + ldsw + _i * 8192), 16, 0, 0); } while (0)
#define PG8_LDA(dst, b, h) do { _Pragma("unroll") for (int m = 0; m < 4; ++m) _Pragma("unroll") for (int k = 0; k < 2; ++k) dst[m][k] = *(const PG8_LAS bf16x8*)(lds + PG8_SA(b, h) + aoff + m * 2048 + k * 1024); } while (0)
#define PG8_LDB(dst, b, h) do { _Pragma("unroll") for (int n = 0; n < 2; ++n) _Pragma("unroll") for (int k = 0; k < 2; ++k) dst[n][k] = *(const PG8_LAS bf16x8*)(lds + PG8_SB(b, h) + boff + n * 2048 + k * 1024); } while (0)
#define PG8_MMA(ai, bj, At, Bt) do { __builtin_amdgcn_s_setprio(1); _Pragma("unroll") for (int m = 0; m < 4; ++m) _Pragma("unroll") for (int n = 0; n < 2; ++n) _Pragma("unroll") for (int k = 0; k < 2; ++k) \
        acc[ai][bj][m][n] = __builtin_amdgcn_mfma_f32_16x16x32_bf16(Bt[n][k], At[m][k], acc[ai][bj][m][n], 0, 0, 0); __builtin_amdgcn_s_setprio(0); } while (0)
#define PG8_WAIT_V(n) asm volatile("s_waitcnt vmcnt(" #n ")" ::: "memory")
#define PG8_WAIT_L(n) asm volatile("s_waitcnt lgkmcnt(" #n ")" ::: "memory")
#define PG8_BAR __builtin_amdgcn_s_barrier()
#define PG8_SCHED __builtin_amdgcn_sched_barrier(0)
    Unit cur, nxt; int ui = 0;
    if (!S.next(0, cur)) return;
    f32x4 acc[2][2][4][2];
#pragma unroll
    for (int a = 0; a < 2; ++a)
#pragma unroll
        for (int b = 0; b < 2; ++b)
#pragma unroll
            for (int m = 0; m < 4; ++m)
#pragma unroll
                for (int n = 0; n < 2; ++n) acc[a][b][m][n] = (f32x4){0.f, 0.f, 0.f, 0.f};
    bf16x8 At[4][2], B0[2][2], B1[2][2];
    const char* cA = (const char*)g.A + (size_t)cur.pm * tstep; const char* cB = (const char*)g.Bt + (size_t)cur.pn * tstep;
    S.a_ready(cur);
    if constexpr (SP2) {
        PG8_STAGE(PG8_SB(0, 0), cB, voffB); PG8_STAGE(PG8_SB(0, 1), cB + hstep, voffB); PG8_STAGE(PG8_SA(0, 0), cA, voffA); PG8_STAGE(PG8_SA(0, 1), cA + hstep, voffA);
        if (wr == 1) PG8_BAR;
        PG8_WAIT_V(2); PG8_BAR;
        PG8_STAGE(PG8_SB(1, 0), cB + kstep, voffB); PG8_STAGE(PG8_SA(1, 0), cA + kstep, voffA); PG8_STAGE(PG8_SB(1, 1), cB + hstep + kstep, voffB);
        PG8_WAIT_V(6); PG8_BAR;
    } else {
        PG8_STAGE(PG8_SB(0, 0), cB, voffB); PG8_STAGE(PG8_SA(0, 0), cA, voffA); PG8_STAGE(PG8_SB(0, 1), cB + hstep, voffB); PG8_STAGE(PG8_SA(0, 1), cA + hstep, voffA);
        if (wr == 1) PG8_BAR;
        PG8_WAIT_V(4); PG8_BAR;
        PG8_STAGE(PG8_SB(1, 0), cB + kstep, voffB); PG8_STAGE(PG8_SA(1, 0), cA + kstep, voffA); PG8_STAGE(PG8_SB(1, 1), cB + hstep + kstep, voffB);
        PG8_WAIT_V(6); PG8_BAR;
    }
    for (;;) {
        const bool has_next = S.next(ui + 1, nxt);
        const char* nA = has_next ? (const char*)g.A + (size_t)nxt.pm * tstep : cA; const char* nB = has_next ? (const char*)g.Bt + (size_t)nxt.pn * tstep : cB;
#pragma unroll 1
        for (int t = 0; t < nt; t += 2) {
            const bool last = (t == nt - 2);
            const char* a1 = cA + (size_t)(t + 1) * kstep;
            const char* a2 = last ? nA : cA + (size_t)(t + 2) * kstep; const char* b2 = last ? nB : cB + (size_t)(t + 2) * kstep;
            const char* a3 = a2 + kstep; const char* b3 = b2 + kstep;
            if (last && has_next) S.a_ready(nxt);
            if constexpr (SP2) {
            PG8_LDB(B0, 0, 0); PG8_LDB(B1, 0, 1); PG8_SCHED; PG8_LDA(At, 0, 0); PG8_STAGE(PG8_SA(1, 1), a1 + hstep, voffA);
            PG8_WAIT_V(8); PG8_WAIT_L(0); PG8_BAR; PG8_MMA(0, 0, At, B0); PG8_MMA(0, 1, At, B1); PG8_BAR; PG8_SCHED;
            PG8_LDA(At, 0, 1); PG8_STAGE(PG8_SB(0, 0), b2, voffB); PG8_STAGE(PG8_SB(0, 1), b2 + hstep, voffB); PG8_STAGE(PG8_SA(0, 0), a2, voffA);
            PG8_WAIT_V(8); PG8_WAIT_L(0); PG8_BAR; PG8_MMA(1, 0, At, B0); PG8_MMA(1, 1, At, B1); PG8_BAR; PG8_SCHED;
            PG8_LDB(B0, 1, 0); PG8_LDB(B1, 1, 1); PG8_SCHED; PG8_LDA(At, 1, 0); PG8_STAGE(PG8_SA(0, 1), a2 + hstep, voffA);
            PG8_WAIT_V(8); PG8_WAIT_L(0); PG8_BAR; PG8_MMA(0, 0, At, B0); PG8_MMA(0, 1, At, B1); PG8_BAR; PG8_SCHED;
            PG8_LDA(At, 1, 1); PG8_STAGE(PG8_SB(1, 0), b3, voffB); PG8_STAGE(PG8_SB(1, 1), b3 + hstep, voffB); PG8_STAGE(PG8_SA(1, 0), a3, voffA);
            PG8_WAIT_V(8); PG8_WAIT_L(0); PG8_BAR; PG8_MMA(1, 0, At, B0); PG8_MMA(1, 1, At, B1); PG8_BAR; PG8_SCHED;
            } else {
            PG8_LDB(B0, 0, 0); PG8_SCHED; PG8_LDA(At, 0, 0); PG8_STAGE(PG8_SA(1, 1), a1 + hstep, voffA);
            PG8_WAIT_L(8); PG8_BAR; PG8_WAIT_L(0); PG8_MMA(0, 0, At, B0); PG8_BAR; PG8_SCHED;
            PG8_LDB(B1, 0, 1); PG8_STAGE(PG8_SB(0, 0), b2, voffB);
            PG8_BAR; PG8_WAIT_L(0); PG8_MMA(0, 1, At, B1); PG8_BAR;
            PG8_LDA(At, 0, 1); PG8_STAGE(PG8_SA(0, 0), a2, voffA);
            PG8_BAR; PG8_WAIT_L(0); PG8_MMA(1, 0, At, B0); PG8_BAR; PG8_SCHED;
            PG8_STAGE(PG8_SB(0, 1), b2 + hstep, voffB);
            PG8_WAIT_V(6); PG8_BAR; PG8_MMA(1, 1, At, B1); PG8_BAR;
            PG8_LDB(B0, 1, 0); PG8_SCHED; PG8_LDA(At, 1, 0); PG8_STAGE(PG8_SA(0, 1), a2 + hstep, voffA);
            PG8_WAIT_L(8); PG8_BAR; PG8_WAIT_L(0); PG8_MMA(0, 0, At, B0); PG8_BAR; PG8_SCHED;
            PG8_LDB(B1, 1, 1); PG8_STAGE(PG8_SB(1, 0), b3, voffB);
            PG8_BAR; PG8_WAIT_L(0); PG8_MMA(0, 1, At, B1); PG8_BAR;
            PG8_LDA(At, 1, 1); PG8_STAGE(PG8_SA(1, 0), a3, voffA);
            PG8_BAR; PG8_WAIT_L(0); PG8_MMA(1, 0, At, B0); PG8_BAR; PG8_SCHED;
            PG8_STAGE(PG8_SB(1, 1), b3 + hstep, voffB);
            PG8_WAIT_V(6); PG8_BAR; PG8_MMA(1, 1, At, B1); PG8_BAR;
            }
        }
        if constexpr (ALIGN_EPI) { if (wr == 0) PG8_BAR; }
        if constexpr (!Epi::AFTER_DRAIN) { E(acc, cur, wr, wc, fr, fq); S.done(cur); }
        if (!has_next) break;
#pragma unroll
        for (int a = 0; a < 2; ++a)
#pragma unroll
            for (int b = 0; b < 2; ++b)
#pragma unroll
                for (int m = 0; m < 4; ++m)
#pragma unroll
                    for (int n = 0; n < 2; ++n) acc[a][b][m][n] = (f32x4){0.f, 0.f, 0.f, 0.f};
        cur = nxt; cA = nA; cB = nB; ++ui;
        if constexpr (ALIGN_EPI) { if (wr == 1) PG8_BAR; }
    }
    PG8_WAIT_V(0);
    if constexpr (!ALIGN_EPI) { if (wr == 0) PG8_BAR; }
    PG8_BAR;
    if constexpr (Epi::AFTER_DRAIN) { E.fused(acc, cur, wr, wc, fr, fq, lds, wid, lane); S.done(cur); }
#undef PG8_SA
#undef PG8_SB
#undef PG8_STAGE
#undef PG8_LDA
#undef PG8_LDB
#undef PG8_MMA
#undef PG8_WAIT_V
#undef PG8_WAIT_L
#undef PG8_BAR
#undef PG8_SCHED
}
}
constexpr int NWAVES = 8;
constexpr int D = 2048, NB = 2, T = 4096, CT = 256, SU = T + CT  , M = NB * SU  , DEPTH = 4;
constexpr int NIN = 5248, NINP = 5376, BIN = 3712, FF = 8192, BW = 1024;
constexpr int PA_Q = 0, PA_K = 512, PA_V = 640, PB0 = 768, PC_Q = 4480, PC_K = 4992, PC_V = 5120;
constexpr int MODW = 6 * D;
#ifndef MK_PER_PHASE
#define MK_PER_PHASE 0
#endif
constexpr int N_PHASES = 2 + 10 * DEPTH;
constexpr size_t MiB = 1u << 20;
constexpr size_t WS_CTL = 0, CTL_ZERO_BYTES = 1 * MiB;
constexpr size_t WS_MOD = 1 * MiB;
constexpr size_t WS_MODP = 2 * MiB;
constexpr size_t WS_ROPE = 10 * MiB;
constexpr size_t WS_WIN = 11 * MiB;
constexpr size_t WS_WOUT = WS_WIN + 84 * MiB;
constexpr size_t WS_W1 = WS_WOUT + 32 * MiB;
constexpr size_t WS_W2 = WS_W1 + 128 * MiB;
constexpr size_t WS_LW = WS_W2 + 128 * MiB;
constexpr size_t WS_HCTX = WS_LW + 10 * MiB;
constexpr size_t WS_U = WS_HCTX + 4 * MiB;
constexpr size_t WS_P = WS_U + 34 * MiB;
constexpr size_t WS_QA = WS_P + 90 * MiB;
constexpr size_t WS_KA = WS_QA + 9 * MiB;
constexpr size_t WS_QC = WS_KA + 3 * MiB;
constexpr size_t WS_KC = WS_QC + 9 * MiB;
constexpr size_t WS_LA = WS_KC + 3 * MiB;
constexpr size_t WS_MIX = WS_LA + 22 * MiB;
constexpr size_t WS_Y = WS_MIX + 34 * MiB;
constexpr size_t WS_LO = WS_Y + 68 * MiB;
constexpr size_t WS_STR = WS_LO + 170 * MiB;
constexpr size_t WS_END = WS_STR + 136 * MiB;
constexpr size_t WS_HID = WS_LO;
static_assert(WS_HID + (size_t)M * FF * 2 <= WS_END, "hidden overlay");
constexpr int CW_TMO = 0, CW_BAR = 4096;
constexpr int RING_BYTES = 131072, LDSCTL_OFF = RING_BYTES, MISC_OFF = LDSCTL_OFF + 320, LDS_BYTES = 147456;

#define GAS __attribute__((address_space(1)))
#define LAS __attribute__((address_space(3)))
typedef unsigned short bf16;
typedef unsigned v4u __attribute__((ext_vector_type(4)));
typedef unsigned v2u __attribute__((ext_vector_type(2)));
typedef float f32x4 __attribute__((ext_vector_type(4)));
typedef GAS unsigned gu32;
#define RLX_AGENT __ATOMIC_RELAXED, __HIP_MEMORY_SCOPE_AGENT
#define LDS_WAIT() asm volatile("s_waitcnt lgkmcnt(0)" ::: "memory")
__device__ __forceinline__ unsigned f2bf(float f) { unsigned u = __builtin_bit_cast(unsigned, f); return (u + 0x7fffu + ((u >> 16) & 1u)) >> 16; }
__device__ __forceinline__ unsigned pk2(float lo, float hi) { return f2bf(lo) | (f2bf(hi) << 16); }
__device__ __forceinline__ float bf2f(bf16 x) { return __builtin_bit_cast(float, (unsigned)x << 16); }
struct Args { const float* in[28]; float* out; unsigned char* ws; int ph_lo, ph_hi; };
#include <hip/hip_bf16.h>
#include <cmath>
namespace attn_body {
using bf16=__hip_bfloat16;
using bf16x8=__attribute__((ext_vector_type(8)))short;
using s16x4=__attribute__((ext_vector_type(4)))short;
using f32x16=__attribute__((ext_vector_type(16)))float;
using u32x4=__attribute__((ext_vector_type(4)))unsigned;
constexpr int D=64,QP=512,KP=128,VP=5376,OP=2048;
constexpr int NW=8,QBLK=32,QB=QBLK*NW,KVBLK=64;
__device__ __forceinline__ int crow(int r,int hi){return (r&3)+8*(r>>2)+4*hi;}
#define SBAR() __builtin_amdgcn_sched_barrier(0)
__device__ __forceinline__ void wmask(f32x16&p0,f32x16&p1,int kpos,int qpos,int hi){
  const float NEG=-INFINITY; const int kb=kpos+4*hi-qpos;
  #pragma unroll
  for(int r=0;r<16;++r){const int d=kb+(r&3)+8*(r>>2); if(d>128||d<-128)p0[r]=NEG; if(d+32>128||d+32<-128)p1[r]=NEG;}
}

constexpr int NSLOT=3, SLOTB=8192;
constexpr int LDS_K=0, LDS_V=NSLOT*SLOTB, LDS_WS=2*NSLOT*SLOTB, LDS_OST=LDS_WS+NW*64*4, LDS_BYTES=LDS_OST+NW*4096;
constexpr float C2=0.125f*1.4426950408889634f;
__device__ __forceinline__ void glds16(const void*gsrc,unsigned lds_dst){unsigned keep;
  asm volatile("s_mov_b32 %0, m0\n\ts_mov_b32 m0, %2\n\ts_nop 0\n\tglobal_load_lds_dwordx4 %1, off\n\ts_mov_b32 m0, %0":"=&s"(keep):"v"(gsrc),"s"(lds_dst):"memory");}
__device__ __forceinline__ float max3f(float a,float b,float c){float r;asm("v_max3_f32 %0, %1, %2, %3":"=v"(r):"v"(a),"v"(b),"v"(c));return r;}
__device__ __forceinline__ float max2f(float a,float b){float r;asm("v_max_f32_e32 %0, %1, %2":"=v"(r):"v"(a),"v"(b));return r;}
__device__ __forceinline__ float fadd_s(float a,float b){float r;asm("v_add_f32_e32 %0, %1, %2":"=v"(r):"v"(a),"v"(b));return r;}
__device__ __forceinline__ float fsub_s(float a,float b){float r;asm("v_sub_f32_e32 %0, %1, %2":"=v"(r):"v"(a),"v"(b));return r;}
typedef float f32x2_t __attribute__((ext_vector_type(2))); typedef __bf16 bf16x2_t __attribute__((ext_vector_type(2)));
__device__ __forceinline__ unsigned cvtpk_s(float lo,float hi){f32x2_t v={lo,hi};bf16x2_t b=__builtin_convertvector(v,bf16x2_t);return __builtin_bit_cast(unsigned,b);}
#define WAIT_BAR(N) asm volatile("s_waitcnt vmcnt(" #N ") lgkmcnt(0)\n\ts_barrier":::"memory")

__device__ __forceinline__ void qkt(f32x16&p0,f32x16&p1,const char*Kslot,const bf16x8*qr,const f32x16&negm,int r32,int hi){
  const char*kb=Kslot+hi*1024+r32*16;
  #pragma unroll
  for(int d0=0;d0<4;++d0){
    const bf16x8 b0=*reinterpret_cast<const bf16x8*>(kb+d0*2048);
    const bf16x8 b1=*reinterpret_cast<const bf16x8*>(kb+d0*2048+512);
    if(d0==0){p0=__builtin_amdgcn_mfma_f32_32x32x16_bf16(b0,qr[0],negm,0,0,0);p1=__builtin_amdgcn_mfma_f32_32x32x16_bf16(b1,qr[0],negm,0,0,0);}
    else{p0=__builtin_amdgcn_mfma_f32_32x32x16_bf16(b0,qr[d0],p0,0,0,0);p1=__builtin_amdgcn_mfma_f32_32x32x16_bf16(b1,qr[d0],p1,0,0,0);}}
}
typedef __attribute__((address_space(3))) const char* lds_cptr;
typedef short v4i16_t __attribute__((ext_vector_type(4)));
__device__ __forceinline__ void kload8(bf16x8*kf,lds_cptr kp){
  kf[0]=*(const __attribute__((address_space(3))) bf16x8*)(kp);      kf[1]=*(const __attribute__((address_space(3))) bf16x8*)(kp+512);
  kf[2]=*(const __attribute__((address_space(3))) bf16x8*)(kp+2048); kf[3]=*(const __attribute__((address_space(3))) bf16x8*)(kp+2560);
  kf[4]=*(const __attribute__((address_space(3))) bf16x8*)(kp+4096); kf[5]=*(const __attribute__((address_space(3))) bf16x8*)(kp+4608);
  kf[6]=*(const __attribute__((address_space(3))) bf16x8*)(kp+6144); kf[7]=*(const __attribute__((address_space(3))) bf16x8*)(kp+6656);
}
__device__ __forceinline__ void kload2(bf16x8*kf,lds_cptr kp,int j){ kf[2*j]=*(const __attribute__((address_space(3))) bf16x8*)(kp+j*2048); kf[2*j+1]=*(const __attribute__((address_space(3))) bf16x8*)(kp+j*2048+512); }
__device__ __forceinline__ s16x4 vtr(lds_cptr p){ return __builtin_bit_cast(s16x4,__builtin_amdgcn_ds_read_tr16_b64_v4i16((__attribute__((address_space(3))) v4i16_t*)p)); }
__device__ __forceinline__ float rowmax(const f32x16&p0,const f32x16&p1){
  float a=max3f(p0[0],p0[1],p1[0]),b=max3f(p0[2],p0[3],p1[1]);a=max3f(a,p1[2],p1[3]);
  #pragma unroll
  for(int r=4;r<16;r+=4){a=max3f(a,p0[r],p0[r+1]);b=max3f(b,p0[r+2],p0[r+3]);a=max3f(a,p1[r],p1[r+1]);b=max3f(b,p1[r+2],p1[r+3]);}
  const float m=max2f(a,b);
  auto rr=__builtin_amdgcn_permlane32_swap(__float_as_uint(m),__float_as_uint(m),false,false);
  return max2f(__uint_as_float(rr[0]),__uint_as_float(rr[1]));
}
__device__ __forceinline__ void pv(f32x16*o,int vb,bf16x8 pa0,bf16x8 pa1,bf16x8 pa2,bf16x8 pa3){
  #pragma unroll
  for(int d0=0;d0<2;++d0){s16x4 lo[4],hi[4];
    #pragma unroll
    for(int ks=0;ks<4;++ks){
      asm volatile("ds_read_b64_tr_b16 %0,%1 offset:%c2":"=&v"(lo[ks]):"v"(vb),"i"(d0*4096+ks*1024):"memory");
      asm volatile("ds_read_b64_tr_b16 %0,%1 offset:%c2":"=&v"(hi[ks]):"v"(vb),"i"(d0*4096+ks*1024+512):"memory");}
    asm volatile("s_waitcnt lgkmcnt(0)":::"memory");SBAR();
    #define PK(k) (bf16x8){lo[k][0],lo[k][1],lo[k][2],lo[k][3],hi[k][0],hi[k][1],hi[k][2],hi[k][3]}
    o[d0]=__builtin_amdgcn_mfma_f32_32x32x16_bf16(pa0,PK(0),o[d0],0,0,0);
    o[d0]=__builtin_amdgcn_mfma_f32_32x32x16_bf16(pa1,PK(1),o[d0],0,0,0);
    o[d0]=__builtin_amdgcn_mfma_f32_32x32x16_bf16(pa2,PK(2),o[d0],0,0,0);
    o[d0]=__builtin_amdgcn_mfma_f32_32x32x16_bf16(pa3,PK(3),o[d0],0,0,0);
    #undef PK
  }
}

#ifndef ATTN_STORE16
#define ATTN_STORE16(p,v) (*(u32x4*)(p)=(v))
#endif
struct AttnJob { const bf16* Qw0; const bf16* Kh; const bf16* Vh; unsigned o_off; int NT, lat_lo, qpos0, sidx; };
template<int MODE,int THRL> __device__ __forceinline__ void attn_unit(const AttnJob&J,const Args&A,char*shm){
  int tid_=threadIdx.x; asm volatile("":"+v"(tid_));
  const int tid=tid_,lane=tid&63,r32=lane&31,hi=lane>>5; const int wid=__builtin_amdgcn_readfirstlane(tid>>6);
  const int lat_lo=J.lat_lo;
  const bf16*Qw=J.Qw0+(long)(wid*QBLK)*QP;
  const bf16*Kh=J.Kh,*Vh=J.Vh;
  const unsigned lds0=(unsigned)(uintptr_t)shm;
  float*wsf=(float*)(shm+LDS_WS)+wid*64;
  const bf16*ksrc=Kh+(long)lane*KP+wid*8;
  const bf16*vsrc=Vh+(long)(16*(wid&3)+(lane>>2))*VP+(wid>>2)*32+(lane&3)*8;
  const unsigned kdst=lds0+LDS_K+wid*1024, vdst=lds0+LDS_V+wid*1024;
  #define TROW(t) ((long)KVBLK*((t)+(((t)>=4)?lat_lo:0)))
  #define DMA_K(t,slot) glds16(ksrc+TROW(t)*KP,(unsigned)__builtin_amdgcn_readfirstlane(kdst+(slot)))
  #define DMA_V(t,slot) glds16(vsrc+TROW(t)*VP,(unsigned)__builtin_amdgcn_readfirstlane(vdst+(slot)))
  const int vb0=(int)(lds0+LDS_V)+((lane>>4)&1)*32+(lane&3)*8+(4*hi+((lane&15)>>2))*64;
  const char*Kbase=shm+LDS_K; bf16x8 kf[8];
  const lds_cptr shm3=(lds_cptr)shm; const lds_cptr kp0=shm3+LDS_K+hi*1024+r32*16; const lds_cptr vp0=shm3+LDS_V+((lane>>4)&1)*32+(lane&3)*8+(4*hi+((lane&15)>>2))*64;
  const int NT=J.NT;
  DMA_K(0,0);DMA_V(0,0);DMA_K(1,SLOTB);
  bf16x8 qr[4];
  #pragma unroll
  for(int d0=0;d0<4;++d0)qr[d0]=*reinterpret_cast<const bf16x8*>(&Qw[(long)r32*QP+d0*16+hi*8]);
  float mhat=0.f,l_reg=0.f;f32x16 o[2];o[0]=f32x16{};o[1]=f32x16{};f32x16 negm=f32x16{};asm volatile("":"+v"(negm));
  const int qpos=J.qpos0+wid*QBLK+r32;
  #define CMASK(P0,P1,t) do{ if(MODE==1&&(t)>=4)wmask(P0,P1,KVBLK*(lat_lo+(t)-4),qpos,hi); }while(0)
  bool resc=false;
  #define START(P0,P1) do{ const float rm=rowmax(P0,P1); resc=false; \
    { const float dl=rm; mhat=fadd_s(mhat,dl); \
      _Pragma("unroll") for(int r=0;r<16;++r){P0[r]=fsub_s(P0[r],dl);P1[r]=fsub_s(P1[r],dl);} \
      _Pragma("unroll") for(int r=0;r<16;++r)negm[r]=-mhat; asm volatile("":"+v"(negm)); } \
    _Pragma("unroll") for(int r=0;r<16;++r)P0[r]=__builtin_amdgcn_exp2f(P0[r]); }while(0)
  #define RESC() do{ if(resc){ asm volatile("s_waitcnt lgkmcnt(0)":::"memory"); \
      _Pragma("unroll") for(int d_=0;d_<2;++d_) _Pragma("unroll") for(int r=0;r<16;++r)o[d_][r]*=wsf[crow(r,hi)]; } }while(0)
  f32x16 pA0,pA1,pB0,pB1;
  int sl_prev=0,sl_cur=0,sl_next=SLOTB;
  #define ROT() do{sl_prev=sl_cur;sl_cur=sl_next;sl_next=(sl_next==(NSLOT-1)*SLOTB)?0:sl_next+SLOTB;}while(0)
  DMA_K(2,2*SLOTB);
  WAIT_BAR(3);
  qkt(pA0,pA1,Kbase,qr,negm,r32,hi);asm volatile("s_nop 15\n\ts_nop 7":"+v"(pA0),"+v"(pA1));CMASK(pA0,pA1,0);
  START(pA0,pA1);
  _Pragma("unroll") for(int r=0;r<16;++r)pA1[r]=__builtin_amdgcn_exp2f(pA1[r]);
  WAIT_BAR(0);
  DMA_K(3,0);DMA_V(1,SLOTB);
  ROT();
  kload8(kf,kp0+sl_cur);
  WAIT_BAR(2);
  s16x4 vlo[8],vhi[8]; u32x4 pw0,pw1,pw2,pw3;
  #define PKW(P,B) cvtpk_s(P[B],P[B+1])
  #define PAF(k) __builtin_bit_cast(bf16x8,pw##k)
  #define VFR(i) (bf16x8){vlo[i][0],vlo[i][1],vlo[i][2],vlo[i][3],vhi[i][0],vhi[i][1],vhi[i][2],vhi[i][3]}
  #define PIN(x) asm volatile("":"+v"(x))
  #define MX3(a,b,c) __builtin_fmaxf(__builtin_fmaxf((a),(b)),(c))
  #define GAPA(MF,A0,A1,A2,A3,W0,W1,PW) do{ MF; sacc+=A0; sacc+=A1; sacc+=A2; sacc+=A3; PIN(sacc); W0; W1; PIN(PW); SBAR(); }while(0)
  #define EX(v) __builtin_amdgcn_exp2f(v)
  #define GAPB(MF,X,B) do{ MF; X[B]=EX(X[B]); X[B+1]=EX(X[B+1]); X[B+2]=EX(X[B+2]); X[B+3]=EX(X[B+3]); PIN(X); SBAR(); }while(0)
  #define VRD(i) do{ vlo[i]=vtr(vp_+(((i)>>2)*4096+((i)&3)*1024)); vhi[i]=vtr(vp_+(((i)>>2)*4096+((i)&3)*1024+512)); }while(0)
  #define KRD(G,j) do{ if(G){ kload2(kf,kp0+sl_next,j); SBAR(); } }while(0)
  #define STEP(C0,C1,P0,P1,t,GK,GV,GL) do{ SBAR(); \
    const lds_cptr vp_=vp0+sl_prev; \
    VRD(0); SBAR(); float sacc=(P0[0]+P0[1]); \
    GAPA(C0=__builtin_amdgcn_mfma_f32_32x32x16_bf16(kf[0],qr[0],negm,0,0,0), P0[2],P0[3],P0[4],P0[5],     pw0[0]=PKW(P0,0), pw0[1]=PKW(P0,2), pw0); \
    VRD(4); SBAR(); GAPA(C1=__builtin_amdgcn_mfma_f32_32x32x16_bf16(kf[1],qr[0],negm,0,0,0), P0[6],P0[7],P0[8],P0[9],     pw0[2]=PKW(P0,4), pw0[3]=PKW(P0,6), pw0); \
    VRD(1); SBAR(); GAPA(C0=__builtin_amdgcn_mfma_f32_32x32x16_bf16(kf[2],qr[1],C0,0,0,0),   P0[10],P0[11],P0[12],P0[13], pw1[0]=PKW(P0,8), pw1[1]=PKW(P0,10), pw1); \
    VRD(5); SBAR(); GAPA(C1=__builtin_amdgcn_mfma_f32_32x32x16_bf16(kf[3],qr[1],C1,0,0,0),   P0[14],P0[15],P1[0],P1[1],   pw1[2]=PKW(P0,12),pw1[3]=PKW(P0,14), pw1); \
    VRD(2); SBAR(); GAPA(C0=__builtin_amdgcn_mfma_f32_32x32x16_bf16(kf[4],qr[2],C0,0,0,0),   P1[2],P1[3],P1[4],P1[5],     pw2[0]=PKW(P1,0), pw2[1]=PKW(P1,2), pw2); \
    VRD(6); SBAR(); GAPA(C1=__builtin_amdgcn_mfma_f32_32x32x16_bf16(kf[5],qr[2],C1,0,0,0),   P1[6],P1[7],P1[8],P1[9],     pw2[2]=PKW(P1,4), pw2[3]=PKW(P1,6), pw2); \
    VRD(3); SBAR(); GAPA(C0=__builtin_amdgcn_mfma_f32_32x32x16_bf16(kf[6],qr[3],C0,0,0,0),   P1[10],P1[11],P1[12],P1[13], pw3[0]=PKW(P1,8), pw3[1]=PKW(P1,10), pw3); \
    VRD(7); SBAR(); GAPA(C1=__builtin_amdgcn_mfma_f32_32x32x16_bf16(kf[7],qr[3],C1,0,0,0),   P1[14],P1[15],0.f,0.f,       pw3[2]=PKW(P1,12),pw3[3]=PKW(P1,14), pw3); \
    l_reg+=sacc; \
    if(GK){DMA_K((t)+3,sl_cur);} if(GV){DMA_V((t)+1,sl_next);} \
    CMASK(C0,C1,t); \
    { float a=MX3(C0[0],C0[1],C1[0]),b=MX3(C0[2],C0[3],C1[1]); a=MX3(a,C1[2],C1[3]); \
      _Pragma("unroll") for(int r=4;r<16;r+=4){a=MX3(a,C0[r],C0[r+1]);b=MX3(b,C0[r+2],C0[r+3]);a=MX3(a,C1[r],C1[r+1]);b=MX3(b,C1[r+2],C1[r+3]);} \
      float rm=__builtin_fmaxf(a,b); { auto rr=__builtin_amdgcn_permlane32_swap(__float_as_uint(rm),__float_as_uint(rm),false,false); rm=__builtin_fmaxf(__uint_as_float(rr[0]),__uint_as_float(rr[1])); } \
      resc=false; \
      if(__builtin_expect(__any(rm>(float)THRL),0)){ const float dl=__builtin_fmaxf(rm,0.f); mhat+=dl; \
        _Pragma("unroll") for(int r=0;r<16;++r){C0[r]-=dl;C1[r]-=dl;} \
        _Pragma("unroll") for(int r=0;r<16;++r)negm[r]=-mhat; asm volatile("":"+v"(negm)); \
        const float f=__builtin_amdgcn_exp2f(-dl); l_reg*=f; if(hi==0)wsf[r32]=f; resc=true; } } \
    SBAR(); \
    GAPB(o[0]=__builtin_amdgcn_mfma_f32_32x32x16_bf16(PAF(0),VFR(0),o[0],0,0,0), C0,0); \
    GAPB(o[1]=__builtin_amdgcn_mfma_f32_32x32x16_bf16(PAF(0),VFR(4),o[1],0,0,0), C0,4); \
    KRD(GL,0); GAPB(o[0]=__builtin_amdgcn_mfma_f32_32x32x16_bf16(PAF(1),VFR(1),o[0],0,0,0), C0,8); \
    KRD(GL,1); GAPB(o[1]=__builtin_amdgcn_mfma_f32_32x32x16_bf16(PAF(1),VFR(5),o[1],0,0,0), C0,12); \
    KRD(GL,2); GAPB(o[0]=__builtin_amdgcn_mfma_f32_32x32x16_bf16(PAF(2),VFR(2),o[0],0,0,0), C1,0); \
    KRD(GL,3); GAPB(o[1]=__builtin_amdgcn_mfma_f32_32x32x16_bf16(PAF(2),VFR(6),o[1],0,0,0), C1,4); \
    GAPB(o[0]=__builtin_amdgcn_mfma_f32_32x32x16_bf16(PAF(3),VFR(3),o[0],0,0,0), C1,8); \
    GAPB(o[1]=__builtin_amdgcn_mfma_f32_32x32x16_bf16(PAF(3),VFR(7),o[1],0,0,0), C1,12); \
    }while(0)
  int t=1;
  for(;t+5<NT;t+=2){
    STEP(pB0,pB1,pA0,pA1,t,true,true,true);     WAIT_BAR(2); RESC(); ROT();
    STEP(pA0,pA1,pB0,pB1,t+1,true,true,true);   WAIT_BAR(2); RESC(); ROT();
  }
  #define ENDW(tt) do{ if((tt)+3<NT){WAIT_BAR(2);} else if((tt)+2<NT){WAIT_BAR(1);} else {WAIT_BAR(0);} }while(0)
  for(;t+1<NT;t+=2){
    STEP(pB0,pB1,pA0,pA1,t,(t+3<NT),(t+1<NT),(t+1<NT));       ENDW(t);   RESC(); ROT();
    STEP(pA0,pA1,pB0,pB1,t+1,(t+4<NT),(t+2<NT),(t+2<NT));     ENDW(t+1); RESC(); ROT();
  }
  STEP(pB0,pB1,pA0,pA1,NT-1,false,false,false); RESC();
  { float sacc=pB0[0]+pB0[1]; _Pragma("unroll") for(int r=2;r<16;++r)sacc+=pB0[r]; _Pragma("unroll") for(int r=0;r<16;++r)sacc+=pB1[r]; l_reg+=sacc;
    pw0=(u32x4){PKW(pB0,0),PKW(pB0,2),PKW(pB0,4),PKW(pB0,6)};pw1=(u32x4){PKW(pB0,8),PKW(pB0,10),PKW(pB0,12),PKW(pB0,14)};pw2=(u32x4){PKW(pB1,0),PKW(pB1,2),PKW(pB1,4),PKW(pB1,6)};pw3=(u32x4){PKW(pB1,8),PKW(pB1,10),PKW(pB1,12),PKW(pB1,14)};
    SBAR(); pv(o,vb0+sl_cur,PAF(0),PAF(1),PAF(2),PAF(3)); }
  #undef PKW
  #undef PAF
  #undef VFR
  #undef PIN
  #undef MX3
  #undef GAPA
  #undef GAPB
  #undef EX
  #undef VRD
  #undef KRD
  #undef STEP
  #undef ENDW
  {auto rr=__builtin_amdgcn_permlane32_swap(__float_as_uint(l_reg),__float_as_uint(l_reg),false,false);l_reg=__uint_as_float(rr[0])+__uint_as_float(rr[1]);}
  if(J.sidx>=0)l_reg+=__builtin_amdgcn_exp2f(A.in[11][J.sidx]*1.4426950408889634f-mhat);
  if(hi==0)wsf[32+r32]=l_reg;asm volatile("s_waitcnt lgkmcnt(0)":::"memory");
  float rli[16];
  #pragma unroll
  for(int r=0;r<16;++r)rli[r]=__builtin_amdgcn_rcpf(wsf[32+crow(r,hi)]);
  bf16*Ow=(bf16*)(A.ws+WS_MIX)+J.o_off+(long)(wid*QBLK)*OP;
  { bf16*stg=(bf16*)(shm+LDS_OST)+wid*2048;
    #pragma unroll
    for(int r=0;r<16;++r){const int orow=crow(r,hi);
      #pragma unroll
      for(int d0=0;d0<2;++d0)stg[orow*64+d0*32+r32]=__float2bfloat16(o[d0][r]*rli[r]);}
    asm volatile("s_waitcnt lgkmcnt(0)":::"memory");
    #pragma unroll
    for(int i=0;i<4;++i){const int row=i*8+(lane>>3),ch=lane&7; const u32x4 v=*(const u32x4*)(stg+row*64+ch*8); ATTN_STORE16(Ow+(long)row*OP+ch*8,v);} }
  asm volatile("s_waitcnt lgkmcnt(0)\n\ts_barrier":::"memory");
  #undef TROW
  #undef DMA_K
  #undef DMA_V
  #undef CMASK
  #undef START
  #undef RESC
  #undef ROT
}
constexpr int ATTN_LDS_BYTES=LDS_BYTES;
#undef SBAR
#undef WAIT_BAR
}
#define XB_TMO      128
#define XB_XCNT(j)  (256  + 64 * (j))
#define XB_XSUB(j)  (1280 + 64 * (j))
#define XB_XGEN(j)  (2304 + 64 * (j))
#define XB_TOP      3328
#define XB_TOPGEN   3392
#define XCD_BAR_WORDS 3456
#define XB_SPIN_CAP (1u << 18)

__device__ __forceinline__ unsigned xb_ld(unsigned* p)              { return __hip_atomic_load(p, __ATOMIC_RELAXED, __HIP_MEMORY_SCOPE_AGENT); }
__device__ __forceinline__ unsigned xb_add(unsigned* p, unsigned v) { return __hip_atomic_fetch_add(p, v, __ATOMIC_RELAXED, __HIP_MEMORY_SCOPE_AGENT); }
__device__ __forceinline__ unsigned xb_xcc_id() { return (unsigned)__builtin_amdgcn_s_getreg((3 << 11) | 20) & 0xFu; }
#define XB_SPIN(cond, bar) do { unsigned _sp = 0; while (cond) { __builtin_amdgcn_s_sleep(1); \
    if ((++_sp & 255u) == 0u) { if (xb_ld(&(bar)[XB_TMO])) break; if (_sp > XB_SPIN_CAP) { atomicAdd(&(bar)[XB_TMO], 1u); break; } } } } while (0)

struct XcdBarrier {
    unsigned* bar; unsigned x;
    volatile LAS unsigned* st;
};

__device__ __forceinline__ XcdBarrier xcd_barrier_post(unsigned* bar, volatile LAS unsigned* st) {
    XcdBarrier b; b.bar = bar; b.x = xb_xcc_id(); b.st = st;
    if (threadIdx.x == 0) (void)xb_add(&bar[XB_XCNT(b.x)], 1u);
    return b;
}
__device__ __forceinline__ void xcd_barrier_complete(unsigned* bar, unsigned x, unsigned& nloc, unsigned& nx) {
    const unsigned G = gridDim.x * gridDim.y * gridDim.z;
    unsigned sum, cnt, mine, sp = 0u;
    for (;;) {
        sum = 0u; cnt = 0u; mine = 0u;
#pragma unroll
        for (unsigned j = 0; j < 16; ++j) { const unsigned c = xb_ld(&bar[XB_XCNT(j)]); sum += c; cnt += (c > 0u) ? 1u : 0u; mine = (j == x) ? c : mine; }
        if (sum == G) break;
        __builtin_amdgcn_s_sleep(1);
        if ((++sp & 255u) == 0u) { if (xb_ld(&bar[XB_TMO])) break; if (sp > XB_SPIN_CAP) { atomicAdd(&bar[XB_TMO], 1u); break; } }
    }
    nloc = mine > 0u ? mine : 1u; nx = cnt > 0u ? cnt : 1u;
}

__device__ __forceinline__ void xcd_barrier(const XcdBarrier& b) {
    asm volatile("s_waitcnt vmcnt(0)" ::: "memory");
    __syncthreads();
    if (threadIdx.x == 0) {
        unsigned* bar = b.bar;
        __builtin_amdgcn_s_waitcnt(0);
        unsigned nloc = b.st[0], nx = b.st[1];
        if (nloc == 0u) { xcd_barrier_complete(bar, b.x, nloc, nx); b.st[0] = nloc; b.st[1] = nx; }
        const unsigned old = xb_add(&bar[XB_XSUB(b.x)], 1u);
        const unsigned gen = old / nloc;
        if (old + 1u == (gen + 1u) * nloc) {
            __builtin_amdgcn_fence(__ATOMIC_RELEASE, "agent");
            asm volatile("s_waitcnt vmcnt(0)" ::: "memory");
            const unsigned og = xb_add(&bar[XB_TOP], 1u);
            const unsigned tg = og / nx;
            if (og + 1u == (tg + 1u) * nx) xb_add(&bar[XB_TOPGEN], 1u);
            else XB_SPIN(xb_ld(&bar[XB_TOPGEN]) == tg, bar);
            __builtin_amdgcn_fence(__ATOMIC_ACQUIRE, "agent");
            xb_add(&bar[XB_XGEN(b.x)], 1u);
            asm volatile("s_waitcnt vmcnt(0)" ::: "memory");
        } else {
            XB_SPIN(xb_ld(&bar[XB_XGEN(b.x)]) == gen, bar);
            __builtin_amdgcn_fence(__ATOMIC_ACQUIRE, "agent");
            asm volatile("s_waitcnt vmcnt(0)" ::: "memory");
        }
    }
    __syncthreads();
}
struct Ctx { LAS unsigned char* lds; int tid, lane, wave, vcu, G, gw, NGW; };
__device__ __forceinline__ float lora_e(float x) { const float z = -x; const float sp = fmaxf(z, 0.f) + log1pf(__expf(-fabsf(z))); return __expf(-sp - 0.5f); }
__device__ __forceinline__ float sigm(float x) { return 1.0f / (1.0f + __expf(-x)); }
__device__ __forceinline__ float wave_sum(float v) {
#pragma unroll
    for (int o = 1; o < 64; o <<= 1) v += __shfl_xor(v, o);
    return v;
}
__device__ __forceinline__ void p0_transpose_item(const float* W, int K, int N, bf16* WT, LAS float* scr, int item, int lane) {
    const int nblk = N / 32, kb = item / nblk, nb = item % nblk, k0 = 64 * kb, n0 = 32 * nb;
#pragma unroll 8
    for (int i = 0; i < 32; ++i) { const int kk = 2 * i + (lane >> 5); scr[kk * 33 + (lane & 31)] = W[(size_t)(k0 + kk) * N + n0 + (lane & 31)]; }
    LDS_WAIT(); asm volatile("" ::: "memory");
    const int c = lane & 7;
#pragma unroll
    for (int j = 0; j < 4; ++j) { const int n = (lane >> 3) + 8 * j; const LAS float* s = scr + (8 * c) * 33 + n;
        v4u o; o.x = pk2(s[0 * 33], s[1 * 33]); o.y = pk2(s[2 * 33], s[3 * 33]); o.z = pk2(s[4 * 33], s[5 * 33]); o.w = pk2(s[6 * 33], s[7 * 33]);
        *(v4u*)(WT + (size_t)(n0 + n) * K + k0 + 8 * c) = o; }
    LDS_WAIT(); asm volatile("" ::: "memory");
}
__device__ __forceinline__ void p0_prologue(const Ctx& F, const Args& A) {
    LAS float* sil = (LAS float*)F.lds;
    for (int i = F.tid; i < 3 * D; i += NWAVES * 64) { const int v = i / D, k = i % D; const float xv = v < 2 ? (A.in[1])[v * D + k] : (A.in[3])[k]; sil[i] = xv / (1.0f + __expf(-xv)); }
    __syncthreads();
    for (int it = F.gw; it < DEPTH * 48 * 8; it += F.NGW) {
        const int l = it / 384, r = it % 384, nb = r >> 3, ks = r & 7;
        const float* W = (A.in[4]) + ((size_t)l * D + (size_t)ks * 256) * MODW + nb * 256 + F.lane * 4;
        f32x4 a0 = {0.f, 0.f, 0.f, 0.f}, a1 = a0, a2 = a0;
#pragma unroll 8
        for (int k = 0; k < 256; ++k) { const f32x4 w = *(const f32x4*)(W + (size_t)k * MODW); const int kk = ks * 256 + k; a0 += sil[kk] * w; a1 += sil[D + kk] * w; a2 += sil[2 * D + kk] * w; }
        float* o = ((float*)(A.ws + WS_MODP)) + ((size_t)ks * 12 + l * 3) * MODW + nb * 256 + F.lane * 4;
        *(f32x4*)o = a0; *(f32x4*)(o + MODW) = a1; *(f32x4*)(o + 2 * MODW) = a2;
    }
    __syncthreads();
    LAS float* scr = (LAS float*)(F.lds + F.wave * 16384);
    constexpr int I_IN = 32 * (NIN / 32), I_OUT = 32 * 64, I_1 = 32 * 256, I_2 = 128 * 64, I_L = I_IN + I_OUT + I_1 + I_2;
    for (int it = F.gw; it < DEPTH * I_L; it += F.NGW) {
        const int l = it / I_L; int r = it % I_L;
        if (r < I_IN) { p0_transpose_item((A.in[8]) + (size_t)l * D * NIN, D, NIN, ((bf16*)(A.ws + WS_WIN)) + (size_t)l * NINP * D, scr, r, F.lane); continue; } r -= I_IN;
        if (r < I_OUT) { p0_transpose_item((A.in[25]) + (size_t)l * D * D, D, D, ((bf16*)(A.ws + WS_WOUT)) + (size_t)l * D * D, scr, r, F.lane); continue; } r -= I_OUT;
        if (r < I_1) { p0_transpose_item((A.in[26]) + (size_t)l * D * FF, D, FF, ((bf16*)(A.ws + WS_W1)) + (size_t)l * FF * D, scr, r, F.lane); continue; } r -= I_1;
        p0_transpose_item((A.in[27]) + (size_t)l * FF * D, FF, D, ((bf16*)(A.ws + WS_W2)) + (size_t)l * D * FF, scr, r, F.lane);
    }
    const int gt = F.gw * 64 + F.lane, NGT = F.NGW * 64;
    for (int i = gt; i < DEPTH * 128 * 256; i += NGT) {
        const int l = i / (128 * 256), r = i % (128 * 256);
        *(v4u*)(((bf16*)(A.ws + WS_WIN)) + ((size_t)l * NINP + NIN) * D + (size_t)r * 8) = (v4u){0u, 0u, 0u, 0u};
    }
    for (int i = gt; i < DEPTH * 5 * 1024 * 32; i += NGT) {
        const int k0 = (i & 31) * 8, n = (i >> 5) & 1023, lp = i >> 15, p = lp % 5, l = lp / 5;
        float v[8];
#pragma unroll
        for (int e = 0; e < 8; ++e) { const int k = k0 + e;
            v[e] = p < 2 ? (k < 96 ? (A.in[16])[((size_t)(l * 2 + p) * 96 + k) * BW + n] : 0.f) : p < 4 ? (k < 96 ? (A.in[18])[((size_t)(l * 2 + (p - 2)) * 96 + k) * BW + n] : 0.f) : (A.in[19])[((size_t)l * 256 + k) * BW + n]; }
        *(v4u*)(((bf16*)(A.ws + WS_LW)) + (size_t)i * 8) = (v4u){pk2(v[0], v[1]), pk2(v[2], v[3]), pk2(v[4], v[5]), pk2(v[6], v[7])};
    }
    for (int i = gt; i < T * 32; i += NGT) {
        const int t = i >> 5, j = i & 31, pos = j < 16 ? (t >> 6) : (t & 63);
        const float inv = (float)pow(10000.0, -(double)(j & 15) / 16.0), ang = (float)pos * inv;
        ((float*)(A.ws + WS_ROPE))[i] = (float)cos((double)ang); ((float*)(A.ws + WS_ROPE))[T * 32 + i] = (float)sin((double)ang);
    }
}
__device__ __forceinline__ void p0b_mods(const Ctx& F, const Args& A) {
    const int gt = F.gw * 64 + F.lane, NGT = F.NGW * 64;
    for (int i = gt; i < DEPTH * 3 * MODW; i += NGT) { const int l = i / (3 * MODW), n = i % MODW; float s = (A.in[5])[l * MODW + n];
#pragma unroll
        for (int ks = 0; ks < 8; ++ks) s += ((float*)(A.ws + WS_MODP))[(size_t)ks * 12 * MODW + i];
        ((float*)(A.ws + WS_MOD))[i] = s; }
}
__device__ __forceinline__ void ph_norm(const Ctx& F, const Args& A, int l, int which) {
    const float* gain = (which ? (A.in[7]) : (A.in[6])) + l * D;
    const bool last = (l == DEPTH - 1);
    for (int m = F.gw; m < M; m += F.NGW) {
        const int b = m / SU, s = m % SU; const bool isctx = s < CT;
        if (isctx && last && which) continue;
        const float* row = isctx ? (l == 0 && !which ? (A.in[2]) : ((float*)(A.ws + WS_HCTX))) + ((size_t)b * CT + s) * D : (l == 0 && !which ? (A.in[0]) : (A.out)) + ((size_t)b * T + (s - CT)) * D;
        const float* mod = ((float*)(A.ws + WS_MOD)) + ((size_t)l * 3 + (isctx ? 2 : b)) * MODW + which * 3 * D;
        f32x4 v[8]; float ss = 0.f;
#pragma unroll
        for (int j = 0; j < 8; ++j) { v[j] = *(const f32x4*)(row + F.lane * 4 + 256 * j); ss += (v[j].x * v[j].x + v[j].y * v[j].y) + (v[j].z * v[j].z + v[j].w * v[j].w); }
        const float rstd = 1.0f / sqrtf(wave_sum(ss) * (1.0f / D) + 1e-6f);
        bf16* o = ((bf16*)(A.ws + WS_U)) + (size_t)m * D;
#pragma unroll
        for (int j = 0; j < 8; ++j) { const int col = F.lane * 4 + 256 * j; const f32x4 g = *(const f32x4*)(gain + col), sh = *(const f32x4*)(mod + col), sc = *(const f32x4*)(mod + D + col);
            const f32x4 y = (v[j] * rstd) * g * (1.0f + sc) + sh;
            *(v2u*)(o + col) = (v2u){pk2(y.x, y.y), pk2(y.z, y.w)}; }
    }
}
__device__ __forceinline__ void ph_prep(const Ctx& F, const Args& A, int l) {
    const int lane = F.lane;
    constexpr float C2 = 0.125f * 1.4426950408889634f;
    float* R = ((float*)(A.ws + WS_STR)); float* KS = ((float*)(A.ws + WS_STR)) + (size_t)M * BW; float* VS = ((float*)(A.ws + WS_STR)) + 2 * (size_t)M * BW; float* KK = ((float*)(A.ws + WS_STR)) + 3 * (size_t)M * BW;
    for (int m = F.gw; m < M; m += F.NGW) {
        const int s = m % SU; const bool isctx = s < CT; const int t = s - CT;
        const bf16* prow = ((bf16*)(A.ws + WS_P)) + (size_t)m * NINP;
        float cs = 1.f, sn = 0.f;
        if (!isctx) { cs = ((float*)(A.ws + WS_ROPE))[t * 32 + (lane & 31)]; sn = ((float*)(A.ws + WS_ROPE))[T * 32 + t * 32 + (lane & 31)]; }
#pragma unroll
        for (int part = 0; part < 2; ++part) {
            const float qg = (part ? (A.in[12]) : (A.in[9]))[l * 64 + lane], kg = (part ? (A.in[13]) : (A.in[10]))[l * 64 + lane];
            const int qoff = part ? PC_Q : PA_Q, koff = part ? PC_K : PA_K;
            bf16* Qo = (part ? ((bf16*)(A.ws + WS_QC)) : ((bf16*)(A.ws + WS_QA))) + (size_t)m * 512; bf16* Ko = (part ? ((bf16*)(A.ws + WS_KC)) : ((bf16*)(A.ws + WS_KA))) + (size_t)m * 128;
            for (int h = 0; h < 10; ++h) {
                const float xv = bf2f(h < 8 ? prow[qoff + h * 64 + lane] : prow[koff + (h - 8) * 64 + lane]);
                const float ms = wave_sum(xv * xv) * (1.0f / 64.0f);
                float y = xv * (1.0f / sqrtf(ms + 1e-6f)) * (h < 8 ? qg : kg);
                const float pr = __shfl_xor(y, 32);
                if (!isctx) y = lane < 32 ? y * cs - pr * sn : pr * sn + y * cs;
                if (h < 8) Qo[h * 64 + lane] = (bf16)f2bf(y * C2); else Ko[(h - 8) * 64 + lane] = (bf16)f2bf(y);
            }
        }
        const bool hasp = (s != 0 && s != CT), hasn = (s != CT - 1 && s != SU - 1);
        const float* mu0 = (A.in[14]) + (size_t)(l * 2) * BIN; const float* mu1 = mu0 + BIN;
        for (int c0 = 0; c0 < 58; ++c0) {
            const int c = c0 * 64 + lane;
            const float p = bf2f(prow[PB0 + c]), pv = hasp ? bf2f(prow[PB0 + c - NINP]) : 0.f, nx = hasn ? bf2f(prow[PB0 + c + NINP]) : 0.f;
            const float xs = p + mu0[c] * (pv - p) + mu1[c] * (nx - p);
            if (c0 < 16) R[(size_t)m * BW + c] = xs;
            else if (c0 < 32) { const int cc = c - BW; KS[(size_t)m * BW + cc] = xs; const float z = xs * (A.in[20])[l * BW + cc]; const float n2 = wave_sum(z * z); KK[(size_t)m * BW + cc] = z / fmaxf(sqrtf(n2), 1e-12f); }
            else if (c0 < 48) VS[(size_t)m * BW + c - 2 * BW] = xs;
            else { const int cl = c - 3 * BW;
                if (cl < 192) { const int p2 = cl / 96; ((bf16*)(A.ws + WS_LA))[((size_t)p2 * M + m) * 256 + (cl - 96 * p2)] = (bf16)f2bf(tanhf(xs)); }
                else if (cl < 384) { const int p2 = cl / 96; ((bf16*)(A.ws + WS_LA))[((size_t)p2 * M + m) * 256 + (cl - 96 * p2)] = (bf16)f2bf(xs); }
                else ((bf16*)(A.ws + WS_LA))[((size_t)4 * M + m) * 256 + (cl - 384)] = (bf16)f2bf(1.0f / (1.0f + __expf(-xs))); }
        }
#pragma unroll
        for (int p2 = 0; p2 < 4; ++p2)
#pragma unroll
            for (int q = 0; q < 3; ++q) { const int k = 96 + q * 64 + lane; if (k < 256) ((bf16*)(A.ws + WS_LA))[((size_t)p2 * M + m) * 256 + k] = (bf16)0; }
    }
}
__device__ __forceinline__ float dpp_xor_sum8(float v) {
    v += __builtin_bit_cast(float, __builtin_amdgcn_update_dpp(0, __builtin_bit_cast(int, v), 0xB1, 0xF, 0xF, false));
    v += __builtin_bit_cast(float, __builtin_amdgcn_update_dpp(0, __builtin_bit_cast(int, v), 0x4E, 0xF, 0xF, false));
    v += __builtin_bit_cast(float, __builtin_amdgcn_update_dpp(0, __builtin_bit_cast(int, v), 0x141, 0xF, 0xF, false));
    return v;
}
__device__ __forceinline__ void scan_chain(const Ctx& F, const Args& A, int l, int chain) {
    constexpr int TS = 32;
    asm volatile("" : "+s"(l), "+s"(chain));
    const int b = chain >> 5, h = (chain >> 1) & 15, dir = chain & 1;
    LAS float* buf = (LAS float*)F.lds;
    LAS float* ybuf = (LAS float*)(F.lds + TS * 6 * 64 * 4);
    const float* R = ((float*)(A.ws + WS_STR)); const float* KS = ((float*)(A.ws + WS_STR)) + (size_t)M * BW; const float* VS = ((float*)(A.ws + WS_STR)) + 2 * (size_t)M * BW; const float* KK = ((float*)(A.ws + WS_STR)) + 3 * (size_t)M * BW;
    const float* E = ((float*)(A.ws + WS_LO)) + (size_t)dir * M * BW; const float* Aa = ((float*)(A.ws + WS_LO)) + (size_t)(2 + dir) * M * BW;
    float* Yo = ((float*)(A.ws + WS_Y)) + (size_t)dir * M * BW;
    const int tid = F.tid, lane = F.lane, i = F.wave * 8 + (lane >> 3), j0 = (lane & 7) * 8;
    float S[8];
#pragma unroll
    for (int c = 0; c < 8; ++c) S[c] = 0.f;
    float pre[4][6];
#define rowof(p) (b * SU + (dir == 0 ? (p) : ((p) < CT ? CT - 1 - (p) : SU + CT - 1 - (p))))
#define SCAN_LOAD(ci) do { _Pragma("unroll") for (int q = 0; q < 4; ++q) { const int it = tid + 512 * q, st = it >> 6, j = it & 63; const size_t a = (size_t)rowof((ci) * TS + st) * BW + h * 64 + j; \
        pre[q][0] = KK[a]; pre[q][1] = E[a]; pre[q][2] = Aa[a]; pre[q][3] = KS[a]; pre[q][4] = R[a]; pre[q][5] = VS[a]; } } while (0)
    SCAN_LOAD(0);
    constexpr int NCH = SU / TS;
    for (int ci = 0; ci < NCH; ++ci) {
#pragma unroll
        for (int q = 0; q < 4; ++q) { const int it = tid + 512 * q, st = it >> 6, j = it & 63; const float ka = (A.in[21])[l * BW + h * 64 + j];
            LAS float* d = buf + st * 384 + j; const float kk = pre[q][0], a = sigm(pre[q][2]);
            d[0] = kk; d[64] = __expf(-lora_e(pre[q][1])); d[128] = kk * a; d[192] = pre[q][3] * (1.0f + (a - 1.0f) * ka); d[256] = pre[q][4]; d[320] = pre[q][5]; }
        __syncthreads();
        if (ci + 1 < NCH) SCAN_LOAD(ci + 1);
        for (int st = 0; st < TS; ++st) {
            const LAS float* d = buf + st * 384;
            const f32x4 k0 = *(const LAS f32x4*)(d + j0), k1 = *(const LAS f32x4*)(d + j0 + 4), w0 = *(const LAS f32x4*)(d + 64 + j0), w1 = *(const LAS f32x4*)(d + 64 + j0 + 4);
            const f32x4 b0 = *(const LAS f32x4*)(d + 128 + j0), b1 = *(const LAS f32x4*)(d + 128 + j0 + 4), q0 = *(const LAS f32x4*)(d + 192 + j0), q1 = *(const LAS f32x4*)(d + 192 + j0 + 4);
            const f32x4 r0 = *(const LAS f32x4*)(d + 256 + j0), r1 = *(const LAS f32x4*)(d + 256 + j0 + 4); const float vi = d[320 + i];
            float sa = (S[0] * k0.x + S[1] * k0.y) + (S[2] * k0.z + S[3] * k0.w) + (S[4] * k1.x + S[5] * k1.y) + (S[6] * k1.z + S[7] * k1.w);
            sa = dpp_xor_sum8(sa);
            S[0] = S[0] * w0.x - sa * b0.x + vi * q0.x; S[1] = S[1] * w0.y - sa * b0.y + vi * q0.y; S[2] = S[2] * w0.z - sa * b0.z + vi * q0.z; S[3] = S[3] * w0.w - sa * b0.w + vi * q0.w;
            S[4] = S[4] * w1.x - sa * b1.x + vi * q1.x; S[5] = S[5] * w1.y - sa * b1.y + vi * q1.y; S[6] = S[6] * w1.z - sa * b1.z + vi * q1.z; S[7] = S[7] * w1.w - sa * b1.w + vi * q1.w;
            float y = (S[0] * r0.x + S[1] * r0.y) + (S[2] * r0.z + S[3] * r0.w) + (S[4] * r1.x + S[5] * r1.y) + (S[6] * r1.z + S[7] * r1.w);
            y = dpp_xor_sum8(y);
            if ((lane & 7) == 0) ybuf[st * 64 + i] = y;
        }
        __syncthreads();
#pragma unroll
        for (int q = 0; q < 4; ++q) { const int it = tid + 512 * q, st = it >> 6, j = it & 63; Yo[(size_t)rowof(ci * TS + st) * BW + h * 64 + j] = ybuf[st * 64 + j]; }
    }
#undef SCAN_LOAD
#undef rowof
    __syncthreads();
}
__device__ __forceinline__ void ph_readout(const Ctx& F, const Args& A, int l) {
    const int lane = F.lane; const bool last = (l == DEPTH - 1);
    const float* R = ((float*)(A.ws + WS_STR)); const float* KS = ((float*)(A.ws + WS_STR)) + (size_t)M * BW; const float* VS = ((float*)(A.ws + WS_STR)) + 2 * (size_t)M * BW;
    const float* Y0 = ((float*)(A.ws + WS_Y)); const float* Y1 = ((float*)(A.ws + WS_Y)) + (size_t)M * BW; const float* A0 = ((float*)(A.ws + WS_LO)) + (size_t)2 * M * BW; const float* A1 = ((float*)(A.ws + WS_LO)) + (size_t)3 * M * BW; const float* Gt = ((float*)(A.ws + WS_LO)) + (size_t)4 * M * BW;
    for (int m = F.gw; m < M; m += F.NGW) {
        if (last && (m % SU) < CT) continue;
        for (int h = 0; h < 16; ++h) {
            const int col = h * 64 + lane; const size_t a = (size_t)m * BW + col;
            const float y = Y0[a] + Y1[a];
            const float mu = wave_sum(y) * (1.0f / 64.0f), dlt = y - mu, var = wave_sum(dlt * dlt) * (1.0f / 64.0f);
            const float yn = dlt * (1.0f / sqrtf(var + 64e-5f)) * (A.in[23])[l * BW + col] + (A.in[24])[l * BW + col];
            const float ksum = KS[a] * (2.0f + (sigm(A0[a]) + sigm(A1[a]) - 2.0f) * (A.in[21])[l * BW + col]);
            const float bon = wave_sum(R[a] * ksum * (A.in[22])[l * BW + col]);
            ((bf16*)(A.ws + WS_MIX))[(size_t)m * D + 512 + col] = (bf16)f2bf((yn + bon * VS[a]) * Gt[a]);
        }
    }
}
__device__ __forceinline__ void ph_attn(const Ctx& F, const Args& A, int l, char* ldsg) {
    const bool last = (l == DEPTH - 1);
    const int NU = last ? 512 : 544;
    typedef attn_body::bf16 abf;
    for (int i = 0;; ++i) {
        const int u = i * F.G + F.vcu; if (u >= NU) break;
        attn_body::AttnJob J;
        if (u < 256) {
            const int b = u >> 7, h = (u >> 4) & 7, qb = u & 15; const size_t r0 = (size_t)b * SU, q0 = r0 + CT + (size_t)qb * 256;
            J.Qw0 = (const abf*)(((bf16*)(A.ws + WS_QC)) + q0 * 512 + h * 64); J.Kh = (const abf*)(((bf16*)(A.ws + WS_KC)) + r0 * 128 + (h >> 2) * 64); J.Vh = (const abf*)(((bf16*)(A.ws + WS_P)) + r0 * NINP + PC_V + (h >> 2) * 64);
            J.o_off = (unsigned)(q0 * D + 1536 + h * 64); J.NT = 68; J.lat_lo = 0; J.qpos0 = 0; J.sidx = -1;
            attn_body::attn_unit<0, 8>(J, A, ldsg);
        } else if (u < 512) {
            const int w = u - 256, b = w >> 7, h = (w >> 4) & 7, qb = w & 15; const size_t r0 = (size_t)b * SU, q0 = r0 + CT + (size_t)qb * 256;
            const int lo = (4 * qb - 2) < 0 ? 0 : 4 * qb - 2, hi = (4 * qb + 5) > 63 ? 63 : 4 * qb + 5;
            J.Qw0 = (const abf*)(((bf16*)(A.ws + WS_QA)) + q0 * 512 + h * 64); J.Kh = (const abf*)(((bf16*)(A.ws + WS_KA)) + r0 * 128 + (h >> 2) * 64); J.Vh = (const abf*)(((bf16*)(A.ws + WS_P)) + r0 * NINP + PA_V + (h >> 2) * 64);
            J.o_off = (unsigned)(q0 * D + h * 64); J.NT = 4 + (hi - lo + 1); J.lat_lo = lo; J.qpos0 = qb * 256; J.sidx = l * 8 + h;
            attn_body::attn_unit<1, 8>(J, A, ldsg);
        } else {
            const int c = u - 512, part = c >> 4, b = (c >> 3) & 1, h = c & 7; const size_t r0 = (size_t)b * SU;
            J.Qw0 = (const abf*)((part ? ((bf16*)(A.ws + WS_QC)) : ((bf16*)(A.ws + WS_QA))) + r0 * 512 + h * 64); J.Kh = (const abf*)((part ? ((bf16*)(A.ws + WS_KC)) : ((bf16*)(A.ws + WS_KA))) + r0 * 128 + (h >> 2) * 64);
            J.Vh = (const abf*)(((bf16*)(A.ws + WS_P)) + r0 * NINP + (part ? PC_V : PA_V) + (h >> 2) * 64); J.o_off = (unsigned)(r0 * D + (part ? 1536 : 0) + h * 64);
            J.NT = 4; J.lat_lo = 0; J.qpos0 = 0; J.sidx = part ? -1 : l * 8 + h;
            attn_body::attn_unit<0, 8>(J, A, ldsg);
        }
    }
    __syncthreads();
    for (int ch = F.vcu; ch < 64; ch += F.G) scan_chain(F, A, l, ch);
}
__global__ void __launch_bounds__(NWAVES * 64, 2) fwd(Args args) {
    extern __shared__ __attribute__((aligned(16))) unsigned char lds_raw[];
    LAS unsigned char* const ldsb = (LAS unsigned char*)lds_raw;
    const Args& A = args; unsigned char* ws = args.ws;
    for (int u = threadIdx.x; u < (LDS_BYTES - LDSCTL_OFF) / 4; u += NWAVES * 64) ((LAS unsigned*)(ldsb + LDSCTL_OFF))[u] = 0u;
    __syncthreads();
    gu32* ctl = (gu32*)(ws + WS_CTL);
    XcdBarrier bar; bar.bar = (unsigned*)(ctl + CW_BAR); bar.x = 0; bar.st = nullptr;
    if (!MK_PER_PHASE) bar = xcd_barrier_post((unsigned*)(ctl + CW_BAR), (volatile LAS unsigned*)(ldsb + MISC_OFF) + 8);
    const int lo = args.ph_lo, hi = args.ph_hi;
#define MKCTX() Ctx F; { int t_ = threadIdx.x; asm volatile("" : "+v"(t_)); F.lds = ldsb; F.tid = t_; F.lane = t_ & 63; F.wave = __builtin_amdgcn_readfirstlane(t_ >> 6); F.G = gridDim.x; \
        { const int bx = blockIdx.x; F.vcu = (F.G % 8 == 0) ? (bx % 8) * (F.G / 8) + bx / 8 : bx; } F.gw = F.vcu * NWAVES + F.wave; F.NGW = F.G * NWAVES; }
#ifndef ONLY_PHASE
#define ONLY_PHASE -1
#endif
#define EN(j) (ONLY_PHASE < 0 || ONLY_PHASE == (j))
#define IN(k) (lo <= (k) && (k) < hi)
#define SEAM(k) do { if (IN((k) + 1)) { if (MK_PER_PHASE) { if (threadIdx.x == 0) __hip_atomic_store(ctl + CW_TMO, 0xBADBA0u, RLX_AGENT); } else xcd_barrier(bar); } } while (0)
    if (EN(0) && IN(0)) { MKCTX(); p0_prologue(F, A); SEAM(0); }
    if (EN(1) && IN(1)) { MKCTX(); p0b_mods(F, A); SEAM(1); }
    for (int l = 0; l < DEPTH; ++l) {
        const int pb = 2 + 10 * l; const bool last = (l == DEPTH - 1);
        if (EN(2) && IN(pb + 0)) { MKCTX(); ph_norm(F, A, l, 0); SEAM(pb + 0); }
        if (EN(3) && IN(pb + 1)) {
            pg8::Gemm g{((bf16*)(A.ws + WS_U)), ((bf16*)(A.ws + WS_WIN)) + (size_t)l * NINP * D, M, NINP, D}; pg8::StaticOrder S; S.init(M, NINP, (int)gridDim.x, (int)blockIdx.x);
            pg8::EpiBf16<0> E{((bf16*)(A.ws + WS_P)), NINP, nullptr, 0, 0, 1.f};
            pg8::gemm_phase<pg8::EpiBf16<0>, pg8::StaticOrder, true, true>(ldsb, g, S, E);
            SEAM(pb + 1);
        }
        if (EN(4) && IN(pb + 2)) { MKCTX(); ph_prep(F, A, l); SEAM(pb + 2); }
        if (EN(5) && IN(pb + 3)) {
            pg8::Gemm g{((bf16*)(A.ws + WS_LA)), ((bf16*)(A.ws + WS_LW)) + (size_t)l * 5 * 1024 * 256, 5 * M, 5 * 1024, 256}; pg8::LoraOrder S{(int)gridDim.x, (int)blockIdx.x};
            pg8::EpiLora E{((float*)(A.ws + WS_LO)), (A.in[15]) + (size_t)l * 2 * BW, (A.in[17]) + (size_t)l * 2 * BW};
            pg8::gemm_phase<pg8::EpiLora, pg8::LoraOrder, true, true>(ldsb, g, S, E);
            SEAM(pb + 3);
        }
        if (EN(6) && IN(pb + 4)) { MKCTX(); ph_attn(F, A, l, (char*)lds_raw); SEAM(pb + 4); }
        if (EN(7) && IN(pb + 5)) { MKCTX(); ph_readout(F, A, l); SEAM(pb + 5); }
        if (EN(8) && IN(pb + 6)) {
            pg8::Gemm g{((bf16*)(A.ws + WS_MIX)), ((bf16*)(A.ws + WS_WOUT)) + (size_t)l * D * D, M, D, D}; pg8::RowMapOrder S; S.init2(D, (int)gridDim.x, (int)blockIdx.x, last ? 1 : 0);
            pg8::EpiResid E{l == 0 ? (A.in[0]) : (A.out), l == 0 ? (A.in[2]) : ((float*)(A.ws + WS_HCTX)), (A.out), ((float*)(A.ws + WS_HCTX)), ((float*)(A.ws + WS_MOD)) + (size_t)l * 3 * MODW + 2 * D};
            pg8::gemm_phase<pg8::EpiResid, pg8::RowMapOrder, true, true>(ldsb, g, S, E);
            SEAM(pb + 6);
        }
        if (EN(9) && IN(pb + 7)) { MKCTX(); ph_norm(F, A, l, 1); SEAM(pb + 7); }
        if (EN(10) && IN(pb + 8)) {
            pg8::Gemm g{((bf16*)(A.ws + WS_U)), ((bf16*)(A.ws + WS_W1)) + (size_t)l * FF * D, M, FF, D}; pg8::RowMapOrder S; S.init2(FF, (int)gridDim.x, (int)blockIdx.x, last ? 1 : 0);
            pg8::EpiRelu2 E{((bf16*)(A.ws + WS_HID)), FF};
            pg8::gemm_phase<pg8::EpiRelu2, pg8::RowMapOrder, true, true>(ldsb, g, S, E);
            SEAM(pb + 8);
        }
        if (EN(11) && IN(pb + 9)) {
            pg8::Gemm g{((bf16*)(A.ws + WS_HID)), ((bf16*)(A.ws + WS_W2)) + (size_t)l * D * FF, M, D, FF}; pg8::RowMapOrder S; S.init2(D, (int)gridDim.x, (int)blockIdx.x, last ? 1 : 0);
            pg8::EpiResid E{(A.out), ((float*)(A.ws + WS_HCTX)), (A.out), ((float*)(A.ws + WS_HCTX)), ((float*)(A.ws + WS_MOD)) + (size_t)l * 3 * MODW + 5 * D};
            pg8::gemm_phase<pg8::EpiResid, pg8::RowMapOrder, true, true>(ldsb, g, S, E);
            SEAM(pb + 9);
        }
    }
#undef IN
#undef SEAM
}
extern "C" void kernel_launch(void* const* d_in, const int* in_sizes, int n_in, void* d_out, int out_size, void* d_ws, size_t ws_size, hipStream_t stream) {
    static int grid = 0;
    if (grid == 0) {
        if (n_in != 28 || out_size != NB * T * D || ws_size < WS_END) { fprintf(stderr, "kernel_launch: unexpected shapes (n_in %d, out %d, ws %zu < %zu)\n", n_in, out_size, ws_size, (size_t)WS_END); grid = -1; return; }
        int dev = 0, cus = 0, per_cu = 0;
        if (hipGetDevice(&dev) != hipSuccess || hipDeviceGetAttribute(&cus, hipDeviceAttributeMultiprocessorCount, dev) != hipSuccess) { grid = -1; return; }
        if (hipFuncSetAttribute((const void*)fwd, hipFuncAttributeMaxDynamicSharedMemorySize, LDS_BYTES) != hipSuccess) { fprintf(stderr, "kernel_launch: hipFuncSetAttribute failed\n"); grid = -1; return; }
        if (hipOccupancyMaxActiveBlocksPerMultiprocessor(&per_cu, (const void*)fwd, NWAVES * 64, LDS_BYTES) != hipSuccess || per_cu < 1) fprintf(stderr, "kernel_launch: occupancy query reports %d\n", per_cu);
        (void)hipGetLastError();
        grid = cus;
    }
    if (grid < 0) return;
    if (hipMemsetAsync((char*)d_ws + WS_CTL, 0, CTL_ZERO_BYTES, stream) != hipSuccess) return;
    Args a{};
    for (int i = 0; i < 28; ++i) a.in[i] = (const float*)d_in[i];
    a.out = (float*)d_out; a.ws = (unsigned char*)d_ws;
#if MK_PER_PHASE
    for (int p = 0; p < N_PHASES; ++p) { a.ph_lo = p; a.ph_hi = p + 1; hipLaunchKernelGGL(fwd, dim3(grid), dim3(NWAVES * 64), LDS_BYTES, stream, a); }
#else
    a.ph_lo = 0; a.ph_hi = N_PHASES;
    hipLaunchKernelGGL(fwd, dim3(grid), dim3(NWAVES * 64), LDS_BYTES, stream, a);
#endif
    const hipError_t le = hipPeekAtLastError();
    if (le != hipSuccess) fprintf(stderr, "kernel_launch: launch failed: %s\n", hipGetErrorName(le));
}
```

```cpp
#include <hip/hip_runtime.h>
#include <cstdio>
#include <cstdint>
namespace pg8 {
#define PG8_LAS __attribute__((address_space(3)))
typedef unsigned short bf16_t;
typedef short bf16x8 __attribute__((ext_vector_type(8)));
typedef float f32x4 __attribute__((ext_vector_type(4)));
typedef unsigned u32x4 __attribute__((ext_vector_type(4)));
constexpr int BM = 256, BK = 64, HALF = 128, HTB = HALF * BK * 2  , STAGE_BYTES = 8 * HTB, NXCD = 8, WGM = 8;

__host__ __device__ __forceinline__ int lds_byte(int r, int c) { const int st = (r >> 4) * 2 + (c >> 5), rr = r & 15, cc = c & 31, ob = rr * 64 + cc * 2; return st * 1024 + (ob ^ (((ob >> 9) & 1) << 5)); }
__host__ __device__ __forceinline__ void stage_rc(int b, int& R, int& C) { const int st = b / 1024, sb = b % 1024, swz = sb ^ (((sb >> 9) & 1) << 5); R = (st >> 1) * 16 + swz / 64; C = (st & 1) * 32 + (swz % 64) / 2; }
__host__ __device__ __forceinline__ int perm32(int rho) { const int n = rho >> 4, i = rho & 15; return 8 * (i >> 2) + 4 * n + (i & 3); }

struct Unit { int pm, pn, k0, nt, slice; };
struct Gemm { const bf16_t* A; const bf16_t* Bt; int M, N, K; };

struct StaticOrder {
    int nM, nN, nwg, G, c;
    __host__ __device__ void init(int M, int N, int G_, int c_) { nM = M / BM; nN = N / BM; nwg = nM * nN; G = G_; c = c_; }
    __host__ __device__ bool next(int i, Unit& u) const {
        const long L = (long)i * G + c; if (L >= nwg) return false;
        int wgid = (int)L; { const int q = nwg / NXCD, r = nwg % NXCD, xcd = wgid % NXCD, off = wgid / NXCD; wgid = (xcd < r ? xcd * (q + 1) : r * (q + 1) + (xcd - r) * q) + off; }
        const int nig = WGM * nN, gid = wgid / nig, fm = gid * WGM, gsz = (nM - fm) < WGM ? (nM - fm) : WGM;
        u.pm = fm + ((wgid % nig) % gsz); u.pn = (wgid % nig) / gsz; u.k0 = 0; u.nt = 0; u.slice = -1; return true;
    }
    __device__ __forceinline__ void a_ready(const Unit&) const {}
    __device__ __forceinline__ void done(const Unit&) const {}
};

__device__ __forceinline__ unsigned cvt_pk_bf16(float lo, float hi) { unsigned r; asm volatile("v_cvt_pk_bf16_f32 %0, %1, %2" : "=v"(r) : "v"(lo), "v"(hi)); return r; }
typedef float f32x2 __attribute__((ext_vector_type(2)));
__device__ __forceinline__ f32x2 gelu_pk(f32x2 v) {
    const f32x2 av = __builtin_elementwise_abs(v), d = av * 0.2316418882f + 1.0f;
    f32x2 t; t.x = __builtin_amdgcn_rcpf(d.x); t.y = __builtin_amdgcn_rcpf(d.y);
    f32x2 q = t * 0.5307027145f + (-0.7265760135f); q = q * t + 0.7107068705f; q = q * t + (-0.142248368f); q = q * t + 0.127414796f; q = q * t;
    const f32x2 s = (v * v) * (-0.72134752044f);
    f32x2 e; e.x = __builtin_amdgcn_exp2f(s.x); e.y = __builtin_amdgcn_exp2f(s.y);
    const f32x2 m = v * (q * e), r = v - m;
    f32x2 o; o.x = v.x < 0.f ? m.x : r.x; o.y = v.y < 0.f ? m.y : r.y; return o;
}

template <int ACT  > struct EpiBf16 {
    static constexpr bool PERM = true, AFTER_DRAIN = false; static_assert(ACT == 0 || ACT == 1, "EpiBf16: ACT is 0 (none) or 1 (gelu_pk)");
    bf16_t* O; int ldc; const float* bias; int split_cols; size_t split_stride; float scale0;
    __device__ __forceinline__ void operator()(const f32x4 (&acc)[2][2][4][2], const Unit& u, int wr, int wc, int fr, int fq) const {
        const int row0 = u.pm * BM + wr * 64 + fr; int colt = u.pn * BM; bf16_t* base = O;
        float sc = 1.f; if (split_cols) { const int t = colt / split_cols; base += (size_t)t * split_stride; colt -= t * split_cols; if (t == 0) sc = scale0; }
        const int col0 = colt + wc * 32 + 8 * fq, bcol0 = u.pn * BM + wc * 32 + 8 * fq;
        f32x4 bv[2][2];
#pragma unroll
        for (int bj = 0; bj < 2; ++bj)
#pragma unroll
            for (int n = 0; n < 2; ++n) bv[bj][n] = bias ? *(const f32x4*)(bias + bcol0 + bj * HALF + 4 * n) : (f32x4){0.f, 0.f, 0.f, 0.f};
#pragma unroll
        for (int ai = 0; ai < 2; ++ai)
#pragma unroll
            for (int m = 0; m < 4; ++m) { bf16_t* rowp = base + (size_t)(row0 + ai * HALF + m * 16) * ldc + col0;
#pragma unroll
                for (int bj = 0; bj < 2; ++bj) { f32x4 v0 = acc[ai][bj][m][0] + bv[bj][0], v1 = acc[ai][bj][m][1] + bv[bj][1];
                    if (ACT == 1) { f32x2 a = gelu_pk((f32x2){v0[0], v0[1]}), b = gelu_pk((f32x2){v0[2], v0[3]}), c = gelu_pk((f32x2){v1[0], v1[1]}), d = gelu_pk((f32x2){v1[2], v1[3]});
                        v0 = (f32x4){a.x, a.y, b.x, b.y}; v1 = (f32x4){c.x, c.y, d.x, d.y}; }
                    v0 = v0 * sc; v1 = v1 * sc; u32x4 w; w.x = cvt_pk_bf16(v0[0], v0[1]); w.y = cvt_pk_bf16(v0[2], v0[3]); w.z = cvt_pk_bf16(v1[0], v1[1]); w.w = cvt_pk_bf16(v1[2], v1[3]);
                    *(u32x4*)(rowp + bj * HALF) = w; } }
    }
};
struct EpiRelu2 {
    static constexpr bool PERM = true, AFTER_DRAIN = false;
    bf16_t* O; int ldc;
    __device__ __forceinline__ void operator()(const f32x4 (&acc)[2][2][4][2], const Unit& u, int wr, int wc, int fr, int fq) const {
        const int row0 = u.pm * BM + wr * 64 + fr, col0 = u.pn * BM + wc * 32 + 8 * fq;
#pragma unroll
        for (int ai = 0; ai < 2; ++ai)
#pragma unroll
            for (int m = 0; m < 4; ++m) { bf16_t* rowp = O + (size_t)(row0 + ai * HALF + m * 16) * ldc + col0;
#pragma unroll
                for (int bj = 0; bj < 2; ++bj) { f32x4 v0 = acc[ai][bj][m][0], v1 = acc[ai][bj][m][1];
#pragma unroll
                    for (int e = 0; e < 4; ++e) { const float a = v0[e] > 0.f ? v0[e] : 0.f, b = v1[e] > 0.f ? v1[e] : 0.f; v0[e] = a * a; v1[e] = b * b; }
                    u32x4 w; w.x = cvt_pk_bf16(v0[0], v0[1]); w.y = cvt_pk_bf16(v0[2], v0[3]); w.z = cvt_pk_bf16(v1[0], v1[1]); w.w = cvt_pk_bf16(v1[2], v1[3]);
                    *(u32x4*)(rowp + bj * HALF) = w; } }
    }
};
struct EpiResid {
    static constexpr bool PERM = false, AFTER_DRAIN = false;
    const float* src_lat; const float* src_ctx; float* dst_lat; float* dst_ctx; const float* gate; float* slab;
    __device__ __forceinline__ void operator()(const f32x4 (&acc)[2][2][4][2], const Unit& u, int wr, int wc, int fr, int fq) const {
        if (u.slice >= 0) {
            float* sl = slab + ((size_t)u.slice * 512 + (size_t)(u.pm / 17) * 256) * 2048; const int r0s = wr * 64 + fr, c0s = u.pn * BM + wc * 32 + 4 * fq;
#pragma unroll
            for (int ai = 0; ai < 2; ++ai)
#pragma unroll
                for (int m = 0; m < 4; ++m) { float* rp = sl + (size_t)(r0s + ai * HALF + m * 16) * 2048 + c0s;
#pragma unroll
                    for (int bj = 0; bj < 2; ++bj)
#pragma unroll
                        for (int n = 0; n < 2; ++n) *(f32x4*)(rp + bj * HALF + n * 16) = acc[ai][bj][m][n]; }
            return;
        }
        const int b = u.pm / 17, j = u.pm % 17; const bool isctx = (j == 0);
        const float* src = isctx ? src_ctx + (size_t)b * 256 * 2048 : src_lat + ((size_t)b * 4096 + (size_t)(j - 1) * 256) * 2048;
        float* dst = isctx ? dst_ctx + (size_t)b * 256 * 2048 : dst_lat + ((size_t)b * 4096 + (size_t)(j - 1) * 256) * 2048;
        const float* g = gate + (isctx ? 2 : b) * 12288;
        const int r0 = wr * 64 + fr, col0 = u.pn * BM + wc * 32 + 4 * fq;
        f32x4 gv[2][2];
#pragma unroll
        for (int bj = 0; bj < 2; ++bj)
#pragma unroll
            for (int n = 0; n < 2; ++n) gv[bj][n] = *(const f32x4*)(g + col0 + bj * HALF + n * 16);
#pragma unroll
        for (int ai = 0; ai < 2; ++ai)
#pragma unroll
            for (int m = 0; m < 4; ++m) { const size_t roff = (size_t)(r0 + ai * HALF + m * 16) * 2048 + col0;
#pragma unroll
                for (int bj = 0; bj < 2; ++bj)
#pragma unroll
                    for (int n = 0; n < 2; ++n) { const f32x4 s = *(const f32x4*)(src + roff + bj * HALF + n * 16); *(f32x4*)(dst + roff + bj * HALF + n * 16) = s + gv[bj][n] * acc[ai][bj][m][n]; } }
    }
};
struct EpiLora {
    static constexpr bool PERM = true, AFTER_DRAIN = false;
    _Float16* oute; bf16_t* outa; const float* w0; const float* a0;
    __device__ __forceinline__ void operator()(const f32x4 (&acc)[2][2][4][2], const Unit& u, int wr, int wc, int fr, int fq) const {
        const int p = u.pn >> 2, rt = u.pm - 34 * p, ct = u.pn & 3;
        const int row0 = rt * BM + wr * 64 + fr, col0 = ct * BM + wc * 32 + 8 * fq;
        const float* bias = p < 2 ? w0 + p * 1024 : a0 + (p & 1) * 1024;
        f32x4 bv[2][2];
#pragma unroll
        for (int bj = 0; bj < 2; ++bj)
#pragma unroll
            for (int n = 0; n < 2; ++n) bv[bj][n] = p < 4 ? *(const f32x4*)(bias + col0 + bj * HALF + 4 * n) : (f32x4){0.f, 0.f, 0.f, 0.f};
        typedef _Float16 h16x8 __attribute__((ext_vector_type(8)));
#pragma unroll
        for (int ai = 0; ai < 2; ++ai)
#pragma unroll
            for (int m = 0; m < 4; ++m) { const size_t ro = (size_t)(row0 + ai * HALF + m * 16) * 1024 + col0;
#pragma unroll
                for (int bj = 0; bj < 2; ++bj) { f32x4 x0 = acc[ai][bj][m][0] + bv[bj][0], x1 = acc[ai][bj][m][1] + bv[bj][1];
                    if (p < 4) {
#pragma unroll
                        for (int q = 0; q < 4; ++q) { x0[q] = __builtin_amdgcn_rcpf(1.0f + __expf(-x0[q])); x1[q] = __builtin_amdgcn_rcpf(1.0f + __expf(-x1[q])); } }
                    if (p < 2) { const float c = 0.60653065971263342f;
                        *(h16x8*)(oute + (size_t)p * 8704 * 1024 + ro + bj * HALF) = (h16x8){(_Float16)(c * x0[0]), (_Float16)(c * x0[1]), (_Float16)(c * x0[2]), (_Float16)(c * x0[3]), (_Float16)(c * x1[0]), (_Float16)(c * x1[1]), (_Float16)(c * x1[2]), (_Float16)(c * x1[3])};
                    } else *(u32x4*)(outa + (size_t)(p - 2) * 8704 * 1024 + ro + bj * HALF) = (u32x4){cvt_pk_bf16(x0[0], x0[1]), cvt_pk_bf16(x0[2], x0[3]), cvt_pk_bf16(x1[0], x1[1]), cvt_pk_bf16(x1[2], x1[3])};
                } }
    }
};
struct RowMapOrder : StaticOrder {
    int skip, S, ntS, nLat, nNn;
    __device__ void init2(int N, int K, int G_, int c_, int skip_, int S_) { skip = skip_; S = S_; ntS = K / 64 / S_; nNn = N / BM; nLat = 32 * nNn; init(8192, N, G_, c_); }
    __device__ bool next(int i, Unit& u) const {
        const long L = (long)i * G + c;
        if (L < nLat) { StaticOrder::next(i, u); u.pm = u.pm + 1 + (u.pm >> 4); return true; }
        if (skip) return false;
        const int j = (int)(L - nLat); if (j >= 2 * nNn * S) return false;
        const int sl = j % S, cu = j / S; u.pm = 17 * (cu & 1); u.pn = cu >> 1;
        if (S > 1) { u.k0 = sl * ntS * 64; u.nt = ntS; u.slice = sl; } else { u.k0 = 0; u.nt = 0; u.slice = -1; }
        return true;
    }
};
struct LoraOrder {
    int G, c;
    __device__ bool next(int i, Unit& u) const { const int L = i * G + c; if (L >= 680) return false; const int p = L / 136, rem = L % 136; u.pm = 34 * p + rem % 34; u.pn = 4 * p + rem / 34; u.k0 = 0; u.nt = p < 4 ? 2 : 0; u.slice = -1; return true; }
    __device__ __forceinline__ void a_ready(const Unit&) const {}
    __device__ __forceinline__ void done(const Unit&) const {}
};
template <class Epi, class Sched, bool ALIGN_EPI = false, bool SP2 = false>
__device__ __forceinline__ void gemm_phase(PG8_LAS unsigned char* lds, const Gemm g, const Sched& S, const Epi& E, int tid_in) {
    int tid_ = tid_in; asm volatile("" : "+v"(tid_));
    const int tid = tid_, wid = __builtin_amdgcn_readfirstlane(tid >> 6), lane = tid & 63, wr = wid >> 2, wc = wid & 3, fr = lane & 15, fq = lane >> 4;
    const int K = g.K;
    unsigned voffA[2], voffB[2];
#pragma unroll
    for (int i = 0; i < 2; ++i) { int R, C; stage_rc(tid * 16 + i * 8192, R, C); const int Rb = Epi::PERM ? ((R & ~31) + perm32(R & 31)) : R;
        voffA[i] = (unsigned)(R * K + C) * 2u; voffB[i] = (unsigned)(Rb * K + C) * 2u; }
    const size_t kstep = (size_t)(BK * 2);
    const size_t hstep = (size_t)HALF * K * 2;
    const size_t tstep = 2 * hstep;
    const unsigned ldsw = (unsigned)wid * 1024u;
    const int aoff = lds_byte(wr * 64 + fr, fq * 8), boff = lds_byte(wc * 32 + fr, fq * 8);
#define PG8_SA(b, h) (((b) * 2 + (h)) * HTB)
#define PG8_SB(b, h) ((4 + (b) * 2 + (h)) * HTB)
#define PG8_STAGE(bufoff, gbase, voff) do { _Pragma("unroll") for (int _i = 0; _i < 2; ++_i) \
        __builtin_amdgcn_global_load_lds((const unsigned*)((const char*)(gbase) + (voff)[_i]), (PG8_LAS unsigned*)(lds + (bufoff) + ldsw + _i * 8192), 16, 0, 0); } while (0)
#define PG8_LDA(dst, b, h) do { _Pragma("unroll") for (int m = 0; m < 4; ++m) _Pragma("unroll") for (int k = 0; k < 2; ++k) dst[m][k] = *(const PG8_LAS bf16x8*)(lds + PG8_SA(b, h) + aoff + m * 2048 + k * 1024); } while (0)
#define PG8_LDB(dst, b, h) do { _Pragma("unroll") for (int n = 0; n < 2; ++n) _Pragma("unroll") for (int k = 0; k < 2; ++k) dst[n][k] = *(const PG8_LAS bf16x8*)(lds + PG8_SB(b, h) + boff + n * 2048 + k * 1024); } while (0)
#define PG8_MMA(ai, bj, At, Bt) do { __builtin_amdgcn_s_setprio(1); _Pragma("unroll") for (int m = 0; m < 4; ++m) _Pragma("unroll") for (int n = 0; n < 2; ++n) _Pragma("unroll") for (int k = 0; k < 2; ++k) \
        acc[ai][bj][m][n] = __builtin_amdgcn_mfma_f32_16x16x32_bf16(Bt[n][k], At[m][k], acc[ai][bj][m][n], 0, 0, 0); __builtin_amdgcn_s_setprio(0); } while (0)
#define PG8_WAIT_V(n) asm volatile("s_waitcnt vmcnt(" #n ")" ::: "memory")
#define PG8_WAIT_L(n) asm volatile("s_waitcnt lgkmcnt(" #n ")" ::: "memory")
#define PG8_BAR __builtin_amdgcn_s_barrier()
#define PG8_SCHED __builtin_amdgcn_sched_barrier(0)
    Unit cur, nxt; int ui = 0;
    if (!S.next(0, cur)) return;
    f32x4 acc[2][2][4][2];
#pragma unroll
    for (int a = 0; a < 2; ++a)
#pragma unroll
        for (int b = 0; b < 2; ++b)
#pragma unroll
            for (int m = 0; m < 4; ++m)
#pragma unroll
                for (int n = 0; n < 2; ++n) acc[a][b][m][n] = (f32x4){0.f, 0.f, 0.f, 0.f};
    bf16x8 At[4][2], B0[2][2], B1[2][2];
    const char* cA = (const char*)g.A + (size_t)cur.pm * tstep + (size_t)cur.k0 * 2; const char* cB = (const char*)g.Bt + (size_t)cur.pn * tstep + (size_t)cur.k0 * 2;
    int nt = cur.nt > 0 ? cur.nt : K / BK;
    S.a_ready(cur);
    if constexpr (SP2) {
        PG8_STAGE(PG8_SB(0, 0), cB, voffB); PG8_STAGE(PG8_SB(0, 1), cB + hstep, voffB); PG8_STAGE(PG8_SA(0, 0), cA, voffA); PG8_STAGE(PG8_SA(0, 1), cA + hstep, voffA);
        if (wr == 1) PG8_BAR;
        PG8_WAIT_V(2); PG8_BAR;
        PG8_STAGE(PG8_SB(1, 0), cB + kstep, voffB); PG8_STAGE(PG8_SA(1, 0), cA + kstep, voffA); PG8_STAGE(PG8_SB(1, 1), cB + hstep + kstep, voffB);
        PG8_WAIT_V(6); PG8_BAR;
    } else {
        PG8_STAGE(PG8_SB(0, 0), cB, voffB); PG8_STAGE(PG8_SA(0, 0), cA, voffA); PG8_STAGE(PG8_SB(0, 1), cB + hstep, voffB); PG8_STAGE(PG8_SA(0, 1), cA + hstep, voffA);
        if (wr == 1) PG8_BAR;
        PG8_WAIT_V(4); PG8_BAR;
        PG8_STAGE(PG8_SB(1, 0), cB + kstep, voffB); PG8_STAGE(PG8_SA(1, 0), cA + kstep, voffA); PG8_STAGE(PG8_SB(1, 1), cB + hstep + kstep, voffB);
        PG8_WAIT_V(6); PG8_BAR;
    }
    for (;;) {
        const bool has_next = S.next(ui + 1, nxt);
        const char* nA = has_next ? (const char*)g.A + (size_t)nxt.pm * tstep + (size_t)nxt.k0 * 2 : cA; const char* nB = has_next ? (const char*)g.Bt + (size_t)nxt.pn * tstep + (size_t)nxt.k0 * 2 : cB;
#pragma unroll 1
        for (int t = 0; t < nt; t += 2) {
            const bool last = (t == nt - 2);
            const char* a1 = cA + (size_t)(t + 1) * kstep;
            const char* a2 = last ? nA : cA + (size_t)(t + 2) * kstep; const char* b2 = last ? nB : cB + (size_t)(t + 2) * kstep;
            const char* a3 = a2 + kstep; const char* b3 = b2 + kstep;
            if (last && has_next) S.a_ready(nxt);
            if constexpr (SP2) {
            PG8_LDB(B0, 0, 0); PG8_LDB(B1, 0, 1); PG8_SCHED; PG8_LDA(At, 0, 0); PG8_STAGE(PG8_SA(1, 1), a1 + hstep, voffA);
            PG8_WAIT_V(8); PG8_WAIT_L(0); PG8_BAR; PG8_MMA(0, 0, At, B0); PG8_MMA(0, 1, At, B1); PG8_BAR; PG8_SCHED;
            PG8_LDA(At, 0, 1); PG8_STAGE(PG8_SB(0, 0), b2, voffB); PG8_STAGE(PG8_SB(0, 1), b2 + hstep, voffB); PG8_STAGE(PG8_SA(0, 0), a2, voffA);
            PG8_WAIT_V(8); PG8_WAIT_L(0); PG8_BAR; PG8_MMA(1, 0, At, B0); PG8_MMA(1, 1, At, B1); PG8_BAR; PG8_SCHED;
            PG8_LDB(B0, 1, 0); PG8_LDB(B1, 1, 1); PG8_SCHED; PG8_LDA(At, 1, 0); PG8_STAGE(PG8_SA(0, 1), a2 + hstep, voffA);
            PG8_WAIT_V(8); PG8_WAIT_L(0); PG8_BAR; PG8_MMA(0, 0, At, B0); PG8_MMA(0, 1, At, B1); PG8_BAR; PG8_SCHED;
            PG8_LDA(At, 1, 1); PG8_STAGE(PG8_SB(1, 0), b3, voffB); PG8_STAGE(PG8_SB(1, 1), b3 + hstep, voffB); PG8_STAGE(PG8_SA(1, 0), a3, voffA);
            PG8_WAIT_V(8); PG8_WAIT_L(0); PG8_BAR; PG8_MMA(1, 0, At, B0); PG8_MMA(1, 1, At, B1); PG8_BAR; PG8_SCHED;
            } else {
            PG8_LDB(B0, 0, 0); PG8_SCHED; PG8_LDA(At, 0, 0); PG8_STAGE(PG8_SA(1, 1), a1 + hstep, voffA);
            PG8_WAIT_L(8); PG8_BAR; PG8_WAIT_L(0); PG8_MMA(0, 0, At, B0); PG8_BAR; PG8_SCHED;
            PG8_LDB(B1, 0, 1); PG8_STAGE(PG8_SB(0, 0), b2, voffB);
            PG8_BAR; PG8_WAIT_L(0); PG8_MMA(0, 1, At, B1); PG8_BAR;
            PG8_LDA(At, 0, 1); PG8_STAGE(PG8_SA(0, 0), a2, voffA);
            PG8_BAR; PG8_WAIT_L(0); PG8_MMA(1, 0, At, B0); PG8_BAR; PG8_SCHED;
            PG8_STAGE(PG8_SB(0, 1), b2 + hstep, voffB);
            PG8_WAIT_V(6); PG8_BAR; PG8_MMA(1, 1, At, B1); PG8_BAR;
            PG8_LDB(B0, 1, 0); PG8_SCHED; PG8_LDA(At, 1, 0); PG8_STAGE(PG8_SA(0, 1), a2 + hstep, voffA);
            PG8_WAIT_L(8); PG8_BAR; PG8_WAIT_L(0); PG8_MMA(0, 0, At, B0); PG8_BAR; PG8_SCHED;
            PG8_LDB(B1, 1, 1); PG8_STAGE(PG8_SB(1, 0), b3, voffB);
            PG8_BAR; PG8_WAIT_L(0); PG8_MMA(0, 1, At, B1); PG8_BAR;
            PG8_LDA(At, 1, 1); PG8_STAGE(PG8_SA(1, 0), a3, voffA);
            PG8_BAR; PG8_WAIT_L(0); PG8_MMA(1, 0, At, B0); PG8_BAR; PG8_SCHED;
            PG8_STAGE(PG8_SB(1, 1), b3 + hstep, voffB);
            PG8_WAIT_V(6); PG8_BAR; PG8_MMA(1, 1, At, B1); PG8_BAR;
            }
        }
        if constexpr (ALIGN_EPI) { if (wr == 0) PG8_BAR; }
        if constexpr (!Epi::AFTER_DRAIN) { E(acc, cur, wr, wc, fr, fq); S.done(cur); }
        if (!has_next) break;
#pragma unroll
        for (int a = 0; a < 2; ++a)
#pragma unroll
            for (int b = 0; b < 2; ++b)
#pragma unroll
                for (int m = 0; m < 4; ++m)
#pragma unroll
                    for (int n = 0; n < 2; ++n) acc[a][b][m][n] = (f32x4){0.f, 0.f, 0.f, 0.f};
        cur = nxt; cA = nA; cB = nB; ++ui; nt = cur.nt > 0 ? cur.nt : K / BK;
        if constexpr (ALIGN_EPI) { if (wr == 1) PG8_BAR; }
    }
    PG8_WAIT_V(0);
    if constexpr (!ALIGN_EPI) { if (wr == 0) PG8_BAR; }
    PG8_BAR;
    if constexpr (Epi::AFTER_DRAIN) { E.fused(acc, cur, wr, wc, fr, fq, lds, wid, lane); S.done(cur); }
#undef PG8_SA
#undef PG8_SB
#undef PG8_STAGE
#undef PG8_LDA
#undef PG8_LDB
#undef PG8_MMA
#undef PG8_WAIT_V
#undef PG8_WAIT_L
#undef PG8_BAR
#undef PG8_SCHED
}
}
constexpr int NWAVES = 8;
constexpr int D = 2048, NB = 2, T = 4096, CT = 256, SU = T + CT  , M = NB * SU  , DEPTH = 4;
constexpr int NIN = 5248, NINP = 5376, BIN = 3712, FF = 8192, BW = 1024;
constexpr int PA_Q = 0, PA_K = 512, PA_V = 640, PB0 = 768, PC_Q = 4480, PC_K = 4992, PC_V = 5120;
constexpr int MODW = 6 * D;
#ifndef MK_PER_PHASE
#define MK_PER_PHASE 0
#endif
constexpr int PPL = 11, N_PHASES = 2 + PPL * DEPTH;
constexpr size_t MiB = 1u << 20;
constexpr size_t WS_CTL = 0, CTL_ZERO_BYTES = 32 * 1024;
constexpr size_t WS_MOD = 1 * MiB;
constexpr size_t WS_MODP = 2 * MiB;
constexpr size_t WS_ROPE = 10 * MiB;
constexpr size_t WS_WIN = 11 * MiB;
constexpr size_t WS_WOUT = WS_WIN + 84 * MiB;
constexpr size_t WS_W1 = WS_WOUT + 32 * MiB;
constexpr size_t WS_W2 = WS_W1 + 128 * MiB;
constexpr size_t WS_LW = WS_W2 + 128 * MiB;
constexpr size_t WS_HCTX = WS_LW + 10 * MiB;
constexpr size_t WS_U = WS_HCTX + 4 * MiB;
constexpr size_t WS_P = WS_U + 34 * MiB;
constexpr size_t WS_QA = WS_P + 90 * MiB;
constexpr size_t WS_KA = WS_QA + 9 * MiB;
constexpr size_t WS_QC = WS_KA + 3 * MiB;
constexpr size_t WS_KC = WS_QC + 9 * MiB;
constexpr size_t WS_LA = WS_KC + 3 * MiB;
constexpr size_t WS_MIX = WS_LA + 22 * MiB;
constexpr size_t WS_Y = WS_MIX + 34 * MiB;
constexpr size_t WS_LO = WS_Y + 68 * MiB;
constexpr size_t WS_AG = WS_LO + 68 * MiB;
constexpr size_t WS_STR = WS_LO + 170 * MiB;
constexpr size_t WS_RW = WS_STR + 136 * MiB;
constexpr size_t WS_SL = WS_RW + 204 * MiB;
constexpr size_t WS_END = WS_SL + 32 * MiB;
constexpr size_t WS_HID = WS_LO;
static_assert(WS_HID + (size_t)M * FF * 2 <= WS_RW, "hidden overlay");
constexpr int CW_TMO = 0, CW_BAR = 4096;
constexpr int RING_BYTES = 131072, LDSCTL_OFF = RING_BYTES, MISC_OFF = LDSCTL_OFF + 320, LDS_BYTES = 147456;

#define GAS __attribute__((address_space(1)))
#define LAS __attribute__((address_space(3)))
typedef unsigned short bf16;
typedef unsigned v4u __attribute__((ext_vector_type(4)));
typedef unsigned v2u __attribute__((ext_vector_type(2)));
typedef float f32x4 __attribute__((ext_vector_type(4)));
typedef GAS unsigned gu32;
#define RLX_AGENT __ATOMIC_RELAXED, __HIP_MEMORY_SCOPE_AGENT
#define LDS_WAIT() asm volatile("s_waitcnt lgkmcnt(0)" ::: "memory")
__device__ __forceinline__ unsigned f2bf(float f) { unsigned u = __builtin_bit_cast(unsigned, f); return (u + 0x7fffu + ((u >> 16) & 1u)) >> 16; }
__device__ __forceinline__ unsigned pk2(float lo, float hi) { return f2bf(lo) | (f2bf(hi) << 16); }
__device__ __forceinline__ float bf2f(bf16 x) { return __builtin_bit_cast(float, (unsigned)x << 16); }
struct Args { const float* in[28]; float* out; unsigned char* ws; int ph_lo, ph_hi; };
__device__ __forceinline__ int hw_lane() { int l_; asm volatile("v_mbcnt_lo_u32_b32 %0, -1, 0\n\tv_mbcnt_hi_u32_b32 %0, -1, %0" : "=&v"(l_)); return l_; }
#ifndef PROBE_PHASE
#define PROBE_PHASE -1
#endif
#define PB_BEGIN(j) const unsigned long long pt0_ = (PROBE_PHASE == (j)) ? __builtin_amdgcn_s_memrealtime() : 0ull
#define PB_END(j) do { if (PROBE_PHASE == (j)) { const unsigned long long d_ = __builtin_amdgcn_s_memrealtime() - pt0_, e_ = __builtin_amdgcn_s_memrealtime() + d_; while (__builtin_amdgcn_s_memrealtime() < e_) __builtin_amdgcn_s_sleep(8); } } while (0)
#define PBS(j) const unsigned long long ptq##j##_ = (PROBE_PHASE == (j)) ? __builtin_amdgcn_s_memrealtime() : 0ull
#define PBE(j) do { if (PROBE_PHASE == (j)) { const unsigned long long d_ = __builtin_amdgcn_s_memrealtime() - ptq##j##_, e_ = __builtin_amdgcn_s_memrealtime() + d_; while (__builtin_amdgcn_s_memrealtime() < e_) __builtin_amdgcn_s_sleep(8); } } while (0)
#include <hip/hip_bf16.h>
#include <cmath>
namespace attn_body {
using bf16=__hip_bfloat16;
using bf16x8=__attribute__((ext_vector_type(8)))short;
using s16x4=__attribute__((ext_vector_type(4)))short;
using f32x16=__attribute__((ext_vector_type(16)))float;
using u32x4=__attribute__((ext_vector_type(4)))unsigned;
constexpr int D=64,QP=512,KP=128,VP=5376,OP=2048;
constexpr int NW=8,QBLK=32,QB=QBLK*NW,KVBLK=64;
__device__ __forceinline__ int crow(int r,int hi){return (r&3)+8*(r>>2)+4*hi;}
#define SBAR() __builtin_amdgcn_sched_barrier(0)
#define ZC16 ((f32x16){0.f,0.f,0.f,0.f,0.f,0.f,0.f,0.f,0.f,0.f,0.f,0.f,0.f,0.f,0.f,0.f})
__device__ __forceinline__ void wmask(f32x16&p0,f32x16&p1,int kpos,int qpos,int hi){
  const float NEG=-INFINITY; const int kb=kpos+4*hi-qpos;
  #pragma unroll
  for(int r=0;r<16;++r){const int d=kb+(r&3)+8*(r>>2); if(d>128||d<-128)p0[r]=NEG; if(d+32>128||d+32<-128)p1[r]=NEG;}
}

constexpr int NSLOT=3, SLOTB=8192;
constexpr int LDS_K=0, LDS_V=NSLOT*SLOTB, LDS_WS=2*NSLOT*SLOTB, LDS_OST=LDS_WS+NW*64*4, LDS_BYTES=LDS_OST+NW*4096;
constexpr float C2=0.125f*1.4426950408889634f;
__device__ __forceinline__ void glds16(const void*gsrc,unsigned lds_dst){unsigned keep;
  asm volatile("s_mov_b32 %0, m0\n\ts_mov_b32 m0, %2\n\ts_nop 0\n\tglobal_load_lds_dwordx4 %1, off\n\ts_mov_b32 m0, %0":"=&s"(keep):"v"(gsrc),"s"(lds_dst):"memory");}
__device__ __forceinline__ float max3f(float a,float b,float c){float r;asm("v_max3_f32 %0, %1, %2, %3":"=v"(r):"v"(a),"v"(b),"v"(c));return r;}
__device__ __forceinline__ float max2f(float a,float b){float r;asm("v_max_f32_e32 %0, %1, %2":"=v"(r):"v"(a),"v"(b));return r;}
__device__ __forceinline__ float fadd_s(float a,float b){float r;asm("v_add_f32_e32 %0, %1, %2":"=v"(r):"v"(a),"v"(b));return r;}
__device__ __forceinline__ float fsub_s(float a,float b){float r;asm("v_sub_f32_e32 %0, %1, %2":"=v"(r):"v"(a),"v"(b));return r;}
typedef float f32x2_t __attribute__((ext_vector_type(2))); typedef __bf16 bf16x2_t __attribute__((ext_vector_type(2)));
__device__ __forceinline__ unsigned cvtpk_s(float lo,float hi){f32x2_t v={lo,hi};bf16x2_t b=__builtin_convertvector(v,bf16x2_t);return __builtin_bit_cast(unsigned,b);}
#define WAIT_BAR(N) asm volatile("s_waitcnt vmcnt(" #N ") lgkmcnt(0)\n\ts_barrier":::"memory")

__device__ __forceinline__ void qkt(f32x16&p0,f32x16&p1,const char*Kslot,const bf16x8*qr,const f32x16&negm,int r32,int hi){
  const char*kb=Kslot+hi*1024+r32*16;
  #pragma unroll
  for(int d0=0;d0<4;++d0){
    const bf16x8 b0=*reinterpret_cast<const bf16x8*>(kb+d0*2048);
    const bf16x8 b1=*reinterpret_cast<const bf16x8*>(kb+d0*2048+512);
    if(d0==0){p0=__builtin_amdgcn_mfma_f32_32x32x16_bf16(b0,qr[0],negm,0,0,0);p1=__builtin_amdgcn_mfma_f32_32x32x16_bf16(b1,qr[0],negm,0,0,0);}
    else{p0=__builtin_amdgcn_mfma_f32_32x32x16_bf16(b0,qr[d0],p0,0,0,0);p1=__builtin_amdgcn_mfma_f32_32x32x16_bf16(b1,qr[d0],p1,0,0,0);}}
}
typedef __attribute__((address_space(3))) const char* lds_cptr;
typedef short v4i16_t __attribute__((ext_vector_type(4)));
__device__ __forceinline__ void kload8(bf16x8*kf,lds_cptr kp){
  kf[0]=*(const __attribute__((address_space(3))) bf16x8*)(kp);      kf[1]=*(const __attribute__((address_space(3))) bf16x8*)(kp+512);
  kf[2]=*(const __attribute__((address_space(3))) bf16x8*)(kp+2048); kf[3]=*(const __attribute__((address_space(3))) bf16x8*)(kp+2560);
  kf[4]=*(const __attribute__((address_space(3))) bf16x8*)(kp+4096); kf[5]=*(const __attribute__((address_space(3))) bf16x8*)(kp+4608);
  kf[6]=*(const __attribute__((address_space(3))) bf16x8*)(kp+6144); kf[7]=*(const __attribute__((address_space(3))) bf16x8*)(kp+6656);
}
__device__ __forceinline__ void kload2(bf16x8*kf,lds_cptr kp,int j){ kf[2*j]=*(const __attribute__((address_space(3))) bf16x8*)(kp+j*2048); kf[2*j+1]=*(const __attribute__((address_space(3))) bf16x8*)(kp+j*2048+512); }
__device__ __forceinline__ s16x4 vtr(lds_cptr p){ return __builtin_bit_cast(s16x4,__builtin_amdgcn_ds_read_tr16_b64_v4i16((__attribute__((address_space(3))) v4i16_t*)p)); }
__device__ __forceinline__ float rowmax(const f32x16&p0,const f32x16&p1){
  float a=max3f(p0[0],p0[1],p1[0]),b=max3f(p0[2],p0[3],p1[1]);a=max3f(a,p1[2],p1[3]);
  #pragma unroll
  for(int r=4;r<16;r+=4){a=max3f(a,p0[r],p0[r+1]);b=max3f(b,p0[r+2],p0[r+3]);a=max3f(a,p1[r],p1[r+1]);b=max3f(b,p1[r+2],p1[r+3]);}
  const float m=max2f(a,b);
  auto rr=__builtin_amdgcn_permlane32_swap(__float_as_uint(m),__float_as_uint(m),false,false);
  return max2f(__uint_as_float(rr[0]),__uint_as_float(rr[1]));
}
__device__ __forceinline__ void pv(f32x16*o,int vb,bf16x8 pa0,bf16x8 pa1,bf16x8 pa2,bf16x8 pa3){
  #pragma unroll
  for(int d0=0;d0<2;++d0){s16x4 lo[4],hi[4];
    #pragma unroll
    for(int ks=0;ks<4;++ks){
      asm volatile("ds_read_b64_tr_b16 %0,%1 offset:%c2":"=&v"(lo[ks]):"v"(vb),"i"(d0*4096+ks*1024):"memory");
      asm volatile("ds_read_b64_tr_b16 %0,%1 offset:%c2":"=&v"(hi[ks]):"v"(vb),"i"(d0*4096+ks*1024+512):"memory");}
    asm volatile("s_waitcnt lgkmcnt(0)":::"memory");SBAR();
    #define PK(k) (bf16x8){lo[k][0],lo[k][1],lo[k][2],lo[k][3],hi[k][0],hi[k][1],hi[k][2],hi[k][3]}
    o[d0]=__builtin_amdgcn_mfma_f32_32x32x16_bf16(pa0,PK(0),o[d0],0,0,0);
    o[d0]=__builtin_amdgcn_mfma_f32_32x32x16_bf16(pa1,PK(1),o[d0],0,0,0);
    o[d0]=__builtin_amdgcn_mfma_f32_32x32x16_bf16(pa2,PK(2),o[d0],0,0,0);
    o[d0]=__builtin_amdgcn_mfma_f32_32x32x16_bf16(pa3,PK(3),o[d0],0,0,0);
    #undef PK
  }
}

#ifndef ATTN_STORE16
#define ATTN_STORE16(p,v) (*(u32x4*)(p)=(v))
#endif
struct AttnJob { const bf16* Qw0; const bf16* Kh; const bf16* Vh; unsigned o_off; int NT, lat_lo, qpos0, sidx; };
template<int MODE,int THRL> __device__ __forceinline__ void attn_unit(const AttnJob&J,const Args&A,char*shm,int wv){
  int tid_=wv*64+hw_lane(); asm volatile("":"+v"(tid_));
  const int tid=tid_,lane=tid&63,r32=lane&31,hi=lane>>5; const int wid=__builtin_amdgcn_readfirstlane(tid>>6);
  const int lat_lo=J.lat_lo;
  const bf16*Qw=J.Qw0+(long)(wid*QBLK)*QP;
  const bf16*Kh=J.Kh,*Vh=J.Vh;
  const unsigned lds0=(unsigned)(uintptr_t)shm;
  float*wsf=(float*)(shm+LDS_WS)+wid*64;
  const bf16*ksrc=Kh+(long)lane*KP+wid*8;
  const bf16*vsrc=Vh+(long)(16*(wid&3)+(lane>>2))*VP+(wid>>2)*32+(lane&3)*8;
  const unsigned kdst=lds0+LDS_K+wid*1024, vdst=lds0+LDS_V+wid*1024;
  #define TROW(t) ((long)KVBLK*((t)+(((t)>=4)?lat_lo:0)))
  #define DMA_K(t,slot) glds16(ksrc+TROW(t)*KP,(unsigned)__builtin_amdgcn_readfirstlane(kdst+(slot)))
  #define DMA_V(t,slot) glds16(vsrc+TROW(t)*VP,(unsigned)__builtin_amdgcn_readfirstlane(vdst+(slot)))
  const int vb0=(int)(lds0+LDS_V)+((lane>>4)&1)*32+(lane&3)*8+(4*hi+((lane&15)>>2))*64;
  const char*Kbase=shm+LDS_K; bf16x8 kf[8];
  const lds_cptr shm3=(lds_cptr)shm; const lds_cptr kp0=shm3+LDS_K+hi*1024+r32*16; const lds_cptr vp0=shm3+LDS_V+((lane>>4)&1)*32+(lane&3)*8+(4*hi+((lane&15)>>2))*64;
  const int NT=J.NT;
  DMA_K(0,0);DMA_V(0,0);DMA_K(1,SLOTB);
  bf16x8 qr[4];
  #pragma unroll
  for(int d0=0;d0<4;++d0)qr[d0]=*reinterpret_cast<const bf16x8*>(&Qw[(long)r32*QP+d0*16+hi*8]);
  float mhat=0.f,l_reg=0.f;f32x16 o[2],negm;
  #pragma unroll
  for(int r=0;r<16;++r){float z0,z1,z2;asm volatile("v_mov_b32 %0, 0\n\tv_mov_b32 %1, 0\n\tv_mov_b32 %2, 0":"=v"(z0),"=v"(z1),"=v"(z2));o[0][r]=z0;o[1][r]=z1;negm[r]=z2;}
  asm volatile("":"+v"(negm));
  const int qpos=J.qpos0+wid*QBLK+r32;
  #define CMASK(P0,P1,t) do{ if(MODE==1&&(t)>=4)wmask(P0,P1,KVBLK*(lat_lo+(t)-4),qpos,hi); }while(0)
  bool resc=false;
  #define START(P0,P1) do{ const float rm=rowmax(P0,P1); resc=false; \
    { const float dl=rm; mhat=fadd_s(mhat,dl); \
      _Pragma("unroll") for(int r=0;r<16;++r){P0[r]=fsub_s(P0[r],dl);P1[r]=fsub_s(P1[r],dl);} \
      _Pragma("unroll") for(int r=0;r<16;++r)negm[r]=-mhat; asm volatile("":"+v"(negm)); } \
    _Pragma("unroll") for(int r=0;r<16;++r)P0[r]=__builtin_amdgcn_exp2f(P0[r]); }while(0)
  #define RESC() do{ if(resc){ asm volatile("s_waitcnt lgkmcnt(0)":::"memory"); \
      _Pragma("unroll") for(int d_=0;d_<2;++d_) _Pragma("unroll") for(int r=0;r<16;++r)o[d_][r]*=wsf[crow(r,hi)]; } }while(0)
  f32x16 pA0,pA1,pB0,pB1;
  int sl_prev=0,sl_cur=0,sl_next=SLOTB;
  #define ROT() do{sl_prev=sl_cur;sl_cur=sl_next;sl_next=(sl_next==(NSLOT-1)*SLOTB)?0:sl_next+SLOTB;}while(0)
  DMA_K(2,2*SLOTB);
  WAIT_BAR(3);
  qkt(pA0,pA1,Kbase,qr,negm,r32,hi);asm volatile("s_nop 15\n\ts_nop 7":"+v"(pA0),"+v"(pA1));CMASK(pA0,pA1,0);
  START(pA0,pA1);
  _Pragma("unroll") for(int r=0;r<16;++r)pA1[r]=__builtin_amdgcn_exp2f(pA1[r]);
  WAIT_BAR(0);
  DMA_K(3,0);DMA_V(1,SLOTB);
  ROT();
  kload8(kf,kp0+sl_cur);
  WAIT_BAR(2);
  s16x4 vlo[8],vhi[8]; u32x4 pw0,pw1,pw2,pw3;
  #define PKW(P,B) cvtpk_s(P[B],P[B+1])
  #define PAF(k) __builtin_bit_cast(bf16x8,pw##k)
  #define VFR(i) (bf16x8){vlo[i][0],vlo[i][1],vlo[i][2],vlo[i][3],vhi[i][0],vhi[i][1],vhi[i][2],vhi[i][3]}
  #define PIN(x) asm volatile("":"+v"(x))
  #define MX3(a,b,c) __builtin_fmaxf(__builtin_fmaxf((a),(b)),(c))
  #define GAPA(MF,A0,A1,A2,A3,W0,W1,PW) do{ MF; sacc+=A0; sacc+=A1; sacc+=A2; sacc+=A3; PIN(sacc); W0; W1; PIN(PW); SBAR(); }while(0)
  #define EX(v) __builtin_amdgcn_exp2f(v)
  #define GAPB(MF,X,B) do{ MF; X[B]=EX(X[B]); X[B+1]=EX(X[B+1]); X[B+2]=EX(X[B+2]); X[B+3]=EX(X[B+3]); PIN(X); SBAR(); }while(0)
  #define VRD(i) do{ vlo[i]=vtr(vp_+(((i)>>2)*4096+((i)&3)*1024)); vhi[i]=vtr(vp_+(((i)>>2)*4096+((i)&3)*1024+512)); }while(0)
  #define KRD(G,j) do{ if(G){ kload2(kf,kp0+sl_next,j); SBAR(); } }while(0)
  #define STEP(C0,C1,P0,P1,t,GK,GV,GL) do{ SBAR(); \
    const lds_cptr vp_=vp0+sl_prev; \
    VRD(0); SBAR(); float sacc=(P0[0]+P0[1]); \
    GAPA(C0=__builtin_amdgcn_mfma_f32_32x32x16_bf16(kf[0],qr[0],negm,0,0,0), P0[2],P0[3],P0[4],P0[5],     pw0[0]=PKW(P0,0), pw0[1]=PKW(P0,2), pw0); \
    VRD(4); SBAR(); GAPA(C1=__builtin_amdgcn_mfma_f32_32x32x16_bf16(kf[1],qr[0],negm,0,0,0), P0[6],P0[7],P0[8],P0[9],     pw0[2]=PKW(P0,4), pw0[3]=PKW(P0,6), pw0); \
    VRD(1); SBAR(); GAPA(C0=__builtin_amdgcn_mfma_f32_32x32x16_bf16(kf[2],qr[1],C0,0,0,0),   P0[10],P0[11],P0[12],P0[13], pw1[0]=PKW(P0,8), pw1[1]=PKW(P0,10), pw1); \
    VRD(5); SBAR(); GAPA(C1=__builtin_amdgcn_mfma_f32_32x32x16_bf16(kf[3],qr[1],C1,0,0,0),   P0[14],P0[15],P1[0],P1[1],   pw1[2]=PKW(P0,12),pw1[3]=PKW(P0,14), pw1); \
    VRD(2); SBAR(); GAPA(C0=__builtin_amdgcn_mfma_f32_32x32x16_bf16(kf[4],qr[2],C0,0,0,0),   P1[2],P1[3],P1[4],P1[5],     pw2[0]=PKW(P1,0), pw2[1]=PKW(P1,2), pw2); \
    VRD(6); SBAR(); GAPA(C1=__builtin_amdgcn_mfma_f32_32x32x16_bf16(kf[5],qr[2],C1,0,0,0),   P1[6],P1[7],P1[8],P1[9],     pw2[2]=PKW(P1,4), pw2[3]=PKW(P1,6), pw2); \
    VRD(3); SBAR(); GAPA(C0=__builtin_amdgcn_mfma_f32_32x32x16_bf16(kf[6],qr[3],C0,0,0,0),   P1[10],P1[11],P1[12],P1[13], pw3[0]=PKW(P1,8), pw3[1]=PKW(P1,10), pw3); \
    VRD(7); SBAR(); GAPA(C1=__builtin_amdgcn_mfma_f32_32x32x16_bf16(kf[7],qr[3],C1,0,0,0),   P1[14],P1[15],0.f,0.f,       pw3[2]=PKW(P1,12),pw3[3]=PKW(P1,14), pw3); \
    l_reg+=sacc; \
    if(GK){DMA_K((t)+3,sl_cur);} if(GV){DMA_V((t)+1,sl_next);} \
    CMASK(C0,C1,t); \
    { float a=MX3(C0[0],C0[1],C1[0]),b=MX3(C0[2],C0[3],C1[1]); a=MX3(a,C1[2],C1[3]); \
      _Pragma("unroll") for(int r=4;r<16;r+=4){a=MX3(a,C0[r],C0[r+1]);b=MX3(b,C0[r+2],C0[r+3]);a=MX3(a,C1[r],C1[r+1]);b=MX3(b,C1[r+2],C1[r+3]);} \
      float rm=__builtin_fmaxf(a,b); { auto rr=__builtin_amdgcn_permlane32_swap(__float_as_uint(rm),__float_as_uint(rm),false,false); rm=__builtin_fmaxf(__uint_as_float(rr[0]),__uint_as_float(rr[1])); } \
      resc=false; \
      if(__builtin_expect(__any(rm>(float)THRL),0)){ const float dl=__builtin_fmaxf(rm,0.f); mhat+=dl; \
        _Pragma("unroll") for(int r=0;r<16;++r){C0[r]-=dl;C1[r]-=dl;} \
        _Pragma("unroll") for(int r=0;r<16;++r)negm[r]=-mhat; asm volatile("":"+v"(negm)); \
        const float f=__builtin_amdgcn_exp2f(-dl); l_reg*=f; if(hi==0)wsf[r32]=f; resc=true; } } \
    SBAR(); \
    GAPB(o[0]=__builtin_amdgcn_mfma_f32_32x32x16_bf16(PAF(0),VFR(0),o[0],0,0,0), C0,0); \
    GAPB(o[1]=__builtin_amdgcn_mfma_f32_32x32x16_bf16(PAF(0),VFR(4),o[1],0,0,0), C0,4); \
    KRD(GL,0); GAPB(o[0]=__builtin_amdgcn_mfma_f32_32x32x16_bf16(PAF(1),VFR(1),o[0],0,0,0), C0,8); \
    KRD(GL,1); GAPB(o[1]=__builtin_amdgcn_mfma_f32_32x32x16_bf16(PAF(1),VFR(5),o[1],0,0,0), C0,12); \
    KRD(GL,2); GAPB(o[0]=__builtin_amdgcn_mfma_f32_32x32x16_bf16(PAF(2),VFR(2),o[0],0,0,0), C1,0); \
    KRD(GL,3); GAPB(o[1]=__builtin_amdgcn_mfma_f32_32x32x16_bf16(PAF(2),VFR(6),o[1],0,0,0), C1,4); \
    GAPB(o[0]=__builtin_amdgcn_mfma_f32_32x32x16_bf16(PAF(3),VFR(3),o[0],0,0,0), C1,8); \
    GAPB(o[1]=__builtin_amdgcn_mfma_f32_32x32x16_bf16(PAF(3),VFR(7),o[1],0,0,0), C1,12); \
    }while(0)
  int t=1;
  for(;t+5<NT;t+=2){
    STEP(pB0,pB1,pA0,pA1,t,true,true,true);     WAIT_BAR(2); RESC(); ROT();
    STEP(pA0,pA1,pB0,pB1,t+1,true,true,true);   WAIT_BAR(2); RESC(); ROT();
  }
  #define ENDW(tt) do{ if((tt)+3<NT){WAIT_BAR(2);} else if((tt)+2<NT){WAIT_BAR(1);} else {WAIT_BAR(0);} }while(0)
  for(;t+1<NT;t+=2){
    STEP(pB0,pB1,pA0,pA1,t,(t+3<NT),(t+1<NT),(t+1<NT));       ENDW(t);   RESC(); ROT();
    STEP(pA0,pA1,pB0,pB1,t+1,(t+4<NT),(t+2<NT),(t+2<NT));     ENDW(t+1); RESC(); ROT();
  }
  STEP(pB0,pB1,pA0,pA1,NT-1,false,false,false); RESC();
  { float sacc=pB0[0]+pB0[1]; _Pragma("unroll") for(int r=2;r<16;++r)sacc+=pB0[r]; _Pragma("unroll") for(int r=0;r<16;++r)sacc+=pB1[r]; l_reg+=sacc;
    pw0=(u32x4){PKW(pB0,0),PKW(pB0,2),PKW(pB0,4),PKW(pB0,6)};pw1=(u32x4){PKW(pB0,8),PKW(pB0,10),PKW(pB0,12),PKW(pB0,14)};pw2=(u32x4){PKW(pB1,0),PKW(pB1,2),PKW(pB1,4),PKW(pB1,6)};pw3=(u32x4){PKW(pB1,8),PKW(pB1,10),PKW(pB1,12),PKW(pB1,14)};
    SBAR(); pv(o,vb0+sl_cur,PAF(0),PAF(1),PAF(2),PAF(3)); }
  #undef PKW
  #undef PAF
  #undef VFR
  #undef PIN
  #undef MX3
  #undef GAPA
  #undef GAPB
  #undef EX
  #undef VRD
  #undef KRD
  #undef STEP
  #undef ENDW
  {auto rr=__builtin_amdgcn_permlane32_swap(__float_as_uint(l_reg),__float_as_uint(l_reg),false,false);l_reg=__uint_as_float(rr[0])+__uint_as_float(rr[1]);}
  if(J.sidx>=0)l_reg+=__builtin_amdgcn_exp2f(A.in[11][J.sidx]*1.4426950408889634f-mhat);
  if(hi==0)wsf[32+r32]=l_reg;asm volatile("s_waitcnt lgkmcnt(0)":::"memory");
  float rli[16];
  #pragma unroll
  for(int r=0;r<16;++r)rli[r]=__builtin_amdgcn_rcpf(wsf[32+crow(r,hi)]);
  bf16*Ow=(bf16*)(A.ws+WS_MIX)+J.o_off+(long)(wid*QBLK)*OP;
  { bf16*stg=(bf16*)(shm+LDS_OST)+wid*2048;
    #pragma unroll
    for(int r=0;r<16;++r){const int orow=crow(r,hi);
      #pragma unroll
      for(int d0=0;d0<2;++d0)stg[orow*64+d0*32+r32]=__float2bfloat16(o[d0][r]*rli[r]);}
    asm volatile("s_waitcnt lgkmcnt(0)":::"memory");
    #pragma unroll
    for(int i=0;i<4;++i){const int row=i*8+(lane>>3),ch=lane&7; const u32x4 v=*(const u32x4*)(stg+row*64+ch*8); ATTN_STORE16(Ow+(long)row*OP+ch*8,v);} }
  asm volatile("s_waitcnt lgkmcnt(0)\n\ts_barrier":::"memory");
  #undef TROW
  #undef DMA_K
  #undef DMA_V
  #undef CMASK
  #undef START
  #undef RESC
  #undef ROT
}
constexpr int ATTN_LDS_BYTES=LDS_BYTES;
#undef SBAR
#undef WAIT_BAR
}
#define XB_TMO      128
#define XB_XCNT(j)  (256  + 64 * (j))
#define XB_XSUB(j)  (1280 + 64 * (j))
#define XB_XGEN(j)  (2304 + 64 * (j))
#define XB_TOP      3328
#define XB_TOPGEN   3392
#define XCD_BAR_WORDS 3456
#define XB_SPIN_CAP (1u << 18)

__device__ __forceinline__ unsigned xb_ld(unsigned* p)              { return __hip_atomic_load(p, __ATOMIC_RELAXED, __HIP_MEMORY_SCOPE_AGENT); }
__device__ __forceinline__ unsigned xb_add(unsigned* p, unsigned v) { return __hip_atomic_fetch_add(p, v, __ATOMIC_RELAXED, __HIP_MEMORY_SCOPE_AGENT); }
__device__ __forceinline__ unsigned xb_xcc_id() { return (unsigned)__builtin_amdgcn_s_getreg((3 << 11) | 20) & 0xFu; }
#define XB_SPIN(cond, bar) do { unsigned _sp = 0; while (cond) { __builtin_amdgcn_s_sleep(1); \
    if ((++_sp & 255u) == 0u) { if (xb_ld(&(bar)[XB_TMO])) break; if (_sp > XB_SPIN_CAP) { atomicAdd(&(bar)[XB_TMO], 1u); break; } } } } while (0)

struct XcdBarrier {
    unsigned* bar; unsigned x;
    volatile LAS unsigned* st;
};

__device__ __forceinline__ XcdBarrier xcd_barrier_post(unsigned* bar, volatile LAS unsigned* st, bool leader  ) {
    XcdBarrier b; b.bar = bar; b.x = xb_xcc_id(); b.st = st;
    if (leader) (void)xb_add(&bar[XB_XCNT(b.x)], 1u);
    return b;
}
__device__ __forceinline__ void xcd_barrier_complete(unsigned* bar, unsigned x, unsigned& nloc, unsigned& nx) {
    const unsigned G = gridDim.x * gridDim.y * gridDim.z;
    unsigned sum, cnt, mine, sp = 0u;
    for (;;) {
        sum = 0u; cnt = 0u; mine = 0u;
#pragma unroll
        for (unsigned j = 0; j < 16; ++j) { const unsigned c = xb_ld(&bar[XB_XCNT(j)]); sum += c; cnt += (c > 0u) ? 1u : 0u; mine = (j == x) ? c : mine; }
        if (sum == G) break;
        __builtin_amdgcn_s_sleep(1);
        if ((++sp & 255u) == 0u) { if (xb_ld(&bar[XB_TMO])) break; if (sp > XB_SPIN_CAP) { atomicAdd(&bar[XB_TMO], 1u); break; } }
    }
    nloc = mine > 0u ? mine : 1u; nx = cnt > 0u ? cnt : 1u;
}

__device__ __forceinline__ void xcd_barrier(const XcdBarrier& b, bool leader  ) {
    asm volatile("s_waitcnt vmcnt(0)" ::: "memory");
    __syncthreads();
    if (leader) {
        unsigned* bar = b.bar; asm volatile("" : "+s"(bar));
        __builtin_amdgcn_s_waitcnt(0);
        unsigned nloc = b.st[0], nx = b.st[1];
        if (nloc == 0u) { xcd_barrier_complete(bar, b.x, nloc, nx); b.st[0] = nloc; b.st[1] = nx; }
        const unsigned old = xb_add(&bar[XB_XSUB(b.x)], 1u);
        const unsigned gen = old / nloc;
        if (old + 1u == (gen + 1u) * nloc) {
            __builtin_amdgcn_fence(__ATOMIC_RELEASE, "agent");
            asm volatile("s_waitcnt vmcnt(0)" ::: "memory");
            const unsigned og = xb_add(&bar[XB_TOP], 1u);
            const unsigned tg = og / nx;
            if (og + 1u == (tg + 1u) * nx) xb_add(&bar[XB_TOPGEN], 1u);
            else XB_SPIN(xb_ld(&bar[XB_TOPGEN]) == tg, bar);
            __builtin_amdgcn_fence(__ATOMIC_ACQUIRE, "agent");
            xb_add(&bar[XB_XGEN(b.x)], 1u);
            asm volatile("s_waitcnt vmcnt(0)" ::: "memory");
        } else {
            XB_SPIN(xb_ld(&bar[XB_XGEN(b.x)]) == gen, bar);
            __builtin_amdgcn_fence(__ATOMIC_ACQUIRE, "agent");
            asm volatile("s_waitcnt vmcnt(0)" ::: "memory");
        }
    }
    __syncthreads();
}
struct Ctx { LAS unsigned char* lds; int tid, lane, wave, vcu, G, gw, NGW; };
__device__ __forceinline__ float lora_e(float x) { return 0.60653065971263342f / (1.0f + __expf(-x)); }
__device__ __forceinline__ float sigm(float x) { return 1.0f / (1.0f + __expf(-x)); }
#define DPP_ADD(v, ctrl) v += __builtin_bit_cast(float, __builtin_amdgcn_update_dpp(0, __builtin_bit_cast(int, v), ctrl, 0xF, 0xF, false))
__device__ __forceinline__ float wave_sum(float v) {
    DPP_ADD(v, 0xB1); DPP_ADD(v, 0x4E); DPP_ADD(v, 0x141); DPP_ADD(v, 0x140);
    const int iv = __builtin_bit_cast(int, v);
    const float a = __builtin_bit_cast(float, __builtin_amdgcn_readlane(iv, 0)), b = __builtin_bit_cast(float, __builtin_amdgcn_readlane(iv, 16)),
                c = __builtin_bit_cast(float, __builtin_amdgcn_readlane(iv, 32)), d = __builtin_bit_cast(float, __builtin_amdgcn_readlane(iv, 48));
    return (a + b) + (c + d);
}
__device__ __forceinline__ float swap32(float v, int lane) {
    const unsigned u = __builtin_bit_cast(unsigned, v); auto rr = __builtin_amdgcn_permlane32_swap(u, u, false, false);
    return __builtin_bit_cast(float, lane < 32 ? rr[1] : rr[0]);
}
__device__ __forceinline__ float dpp_xor_sum8(float v) {
    v += __builtin_bit_cast(float, __builtin_amdgcn_update_dpp(0, __builtin_bit_cast(int, v), 0xB1, 0xF, 0xF, false));
    v += __builtin_bit_cast(float, __builtin_amdgcn_update_dpp(0, __builtin_bit_cast(int, v), 0x4E, 0xF, 0xF, false));
    v += __builtin_bit_cast(float, __builtin_amdgcn_update_dpp(0, __builtin_bit_cast(int, v), 0x141, 0xF, 0xF, false));
    return v;
}
__device__ __forceinline__ void p0_transpose_item(const float* W, int K, int N, bf16* WT, LAS float* scr, int item, int lane) {
    const int nblk = N / 32, kb = item / nblk, nb = item % nblk, k0 = 64 * kb, n0 = 32 * nb;
#pragma unroll
    for (int i = 0; i < 8; ++i) { const int kk = 8 * i + (lane >> 3), c4 = (lane & 7) * 4;
        const f32x4 wv = *(const f32x4*)(W + (size_t)(k0 + kk) * N + n0 + c4);
        LAS float* d = scr + kk * 33 + c4; d[0] = wv.x; d[1] = wv.y; d[2] = wv.z; d[3] = wv.w; }
    LDS_WAIT(); asm volatile("" ::: "memory");
    const int c = lane & 7;
#pragma unroll
    for (int j = 0; j < 4; ++j) { const int n = (lane >> 3) + 8 * j; const LAS float* s = scr + (8 * c) * 33 + n;
        v4u o; o.x = pk2(s[0 * 33], s[1 * 33]); o.y = pk2(s[2 * 33], s[3 * 33]); o.z = pk2(s[4 * 33], s[5 * 33]); o.w = pk2(s[6 * 33], s[7 * 33]);
        *(v4u*)(WT + (size_t)(n0 + n) * K + k0 + 8 * c) = o; }
    LDS_WAIT(); asm volatile("" ::: "memory");
}
constexpr int CI_IN = 32 * (NIN / 32), CI_OUT = 32 * 64, CI_1 = 32 * 256, CI_2 = 128 * 64;
__device__ __forceinline__ void convert_items(const Ctx& F, const Args& A, int l, int mat, int it0, int it1, int w0, int nw) {
    LAS float* scr = (LAS float*)(F.lds + F.wave * 16384);
    for (int it = it0 + w0; it < it1; it += nw) {
        if (mat == 0) p0_transpose_item((A.in[8]) + (size_t)l * D * NIN, D, NIN, ((bf16*)(A.ws + WS_WIN)) + (size_t)l * NINP * D, scr, it, F.lane);
        else if (mat == 1) p0_transpose_item((A.in[25]) + (size_t)l * D * D, D, D, ((bf16*)(A.ws + WS_WOUT)) + (size_t)l * D * D, scr, it, F.lane);
        else if (mat == 2) p0_transpose_item((A.in[26]) + (size_t)l * D * FF, D, FF, ((bf16*)(A.ws + WS_W1)) + (size_t)l * FF * D, scr, it, F.lane);
        else p0_transpose_item((A.in[27]) + (size_t)l * FF * D, FF, D, ((bf16*)(A.ws + WS_W2)) + (size_t)l * D * FF, scr, it, F.lane);
    }
}
__device__ __forceinline__ void p0_prologue(const Ctx& F, const Args& A) {
    LAS float* sil = (LAS float*)F.lds;
    for (int i = F.tid; i < 3 * D; i += NWAVES * 64) { const int v = i / D, k = i % D; const float xv = v < 2 ? (A.in[1])[v * D + k] : (A.in[3])[k]; sil[i] = xv / (1.0f + __expf(-xv)); }
    __syncthreads();
    for (int it = F.gw; it < DEPTH * 48 * 8; it += F.NGW) {
        const int l = it / 384, r = it % 384, nb = r >> 3, ks = r & 7;
        const float* W = (A.in[4]) + ((size_t)l * D + (size_t)ks * 256) * MODW + nb * 256 + F.lane * 4;
        f32x4 a0 = {0.f, 0.f, 0.f, 0.f}, a1 = a0, a2 = a0;
#pragma unroll 8
        for (int k = 0; k < 256; ++k) { const f32x4 w = *(const f32x4*)(W + (size_t)k * MODW); const int kk = ks * 256 + k; a0 += sil[kk] * w; a1 += sil[D + kk] * w; a2 += sil[2 * D + kk] * w; }
        float* o = ((float*)(A.ws + WS_MODP)) + ((size_t)ks * 12 + l * 3) * MODW + nb * 256 + F.lane * 4;
        *(f32x4*)o = a0; *(f32x4*)(o + MODW) = a1; *(f32x4*)(o + 2 * MODW) = a2;
    }
    __syncthreads();
    if (F.G == 256) convert_items(F, A, 0, 0, 0, CI_IN, F.gw, F.NGW);
    else for (int l2 = 0; l2 < DEPTH; ++l2) { convert_items(F, A, l2, 0, 0, CI_IN, F.gw, F.NGW); convert_items(F, A, l2, 1, 0, CI_OUT, F.gw, F.NGW); convert_items(F, A, l2, 2, 0, CI_1, F.gw, F.NGW); convert_items(F, A, l2, 3, 0, CI_2, F.gw, F.NGW); }
    const int gt = F.gw * 64 + F.lane, NGT = F.NGW * 64;
    for (int i = gt; i < DEPTH * 128 * 256; i += NGT) {
        const int l = i / (128 * 256), r = i % (128 * 256);
        *(v4u*)(((bf16*)(A.ws + WS_WIN)) + ((size_t)l * NINP + NIN) * D + (size_t)r * 8) = (v4u){0u, 0u, 0u, 0u};
    }
    for (int i = gt; i < DEPTH * 5 * 1024 * 32; i += NGT) {
        const int n = i & 1023, k0 = ((i >> 10) & 31) * 8, lp = i >> 15, p = lp % 5, l = lp / 5;
        float v[8];
#pragma unroll
        for (int e = 0; e < 8; ++e) { const int k = k0 + e;
            v[e] = p < 2 ? (k < 96 ? (A.in[16])[((size_t)(l * 2 + p) * 96 + k) * BW + n] : 0.f) : p < 4 ? (k < 96 ? (A.in[18])[((size_t)(l * 2 + (p - 2)) * 96 + k) * BW + n] : 0.f) : (A.in[19])[((size_t)l * 256 + k) * BW + n]; }
        *(v4u*)(((bf16*)(A.ws + WS_LW)) + ((size_t)lp * 1024 + n) * 256 + k0) = (v4u){pk2(v[0], v[1]), pk2(v[2], v[3]), pk2(v[4], v[5]), pk2(v[6], v[7])};
    }
    for (int i = gt; i < T * 32; i += NGT) {
        const int t = i >> 5, j = i & 31, pos = j < 16 ? (t >> 6) : (t & 63);
        const float inv = (float)pow(10000.0, -(double)(j & 15) / 16.0), ang = (float)pos * inv;
        ((float*)(A.ws + WS_ROPE))[i] = (float)cos((double)ang); ((float*)(A.ws + WS_ROPE))[T * 32 + i] = (float)sin((double)ang);
    }
}
__device__ __forceinline__ void p0b_mods(const Ctx& F, const Args& A) {
    const int gt = F.gw * 64 + F.lane, NGT = F.NGW * 64;
    for (int i = gt; i < DEPTH * 3 * MODW; i += NGT) { const int l = i / (3 * MODW), n = i % MODW; float s = (A.in[5])[l * MODW + n];
#pragma unroll
        for (int ks = 0; ks < 8; ++ks) s += ((float*)(A.ws + WS_MODP))[(size_t)ks * 12 * MODW + i];
        ((float*)(A.ws + WS_MOD))[i] = s; }
}
__device__ __forceinline__ const float* norm_src(const Args& A, int l, int which, int m) {
    const int b = m / SU, s = m % SU;
    return s < CT ? (l == 0 ? (A.in[2]) : ((float*)(A.ws + WS_HCTX))) + ((size_t)b * CT + s) * D : (l == 0 && !which ? (A.in[0]) : (A.out)) + ((size_t)b * T + (s - CT)) * D;
}
__device__ __forceinline__ void norm_row(const Ctx& F, const Args& A, int l, int which, int m, f32x4 (&v)[8], const float* gain) {
    const int b = m / SU, s = m % SU; const bool isctx = s < CT;
    const float* mod = ((float*)(A.ws + WS_MOD)) + ((size_t)l * 3 + (isctx ? 2 : b)) * MODW + which * 3 * D;
    float ss = 0.f;
    if (isctx && (which ? true : l > 0)) {
        const float* sl = ((const float*)(A.ws + WS_SL)) + ((size_t)b * CT + s) * D + F.lane * 8;
        const float* gt = ((float*)(A.ws + WS_MOD)) + ((size_t)(which ? l : l - 1) * 3 + 2) * MODW + (which ? 2 : 5) * D + F.lane * 8;
        float* hw = ((float*)(A.ws + WS_HCTX)) + ((size_t)b * CT + s) * D + F.lane * 8;
#pragma unroll
        for (int j = 0; j < 8; ++j) { const int co = 512 * (j >> 1) + 4 * (j & 1); f32x4 a = *(const f32x4*)(sl + co);
#pragma unroll
            for (int q = 1; q < 8; ++q) a += *(const f32x4*)(sl + (size_t)q * 512 * D + co);
            v[j] += *(const f32x4*)(gt + co) * a; *(f32x4*)(hw + co) = v[j]; }
    }
#pragma unroll
    for (int j = 0; j < 8; ++j) ss += (v[j].x * v[j].x + v[j].y * v[j].y) + (v[j].z * v[j].z + v[j].w * v[j].w);
    const float rstd = 1.0f / sqrtf(wave_sum(ss) * (1.0f / D) + 1e-6f);
    bf16* o = ((bf16*)(A.ws + WS_U)) + (size_t)m * D;
    const LAS float* tg = (const LAS float*)F.lds + (isctx ? 2 : b) * 2 * D;
#pragma unroll
    for (int j2 = 0; j2 < 4; ++j2) { const int col = F.lane * 8 + 512 * j2;
        const f32x4 g0 = *(const LAS f32x4*)(tg + col), g1 = *(const LAS f32x4*)(tg + col + 4), s0 = *(const LAS f32x4*)(tg + D + col), s1 = *(const LAS f32x4*)(tg + D + col + 4);
        const f32x4 y0 = (v[2 * j2] * rstd) * g0 + s0, y1 = (v[2 * j2 + 1] * rstd) * g1 + s1;
        *(v4u*)(o + col) = (v4u){pk2(y0.x, y0.y), pk2(y0.z, y0.w), pk2(y1.x, y1.y), pk2(y1.z, y1.w)}; }
}
__device__ __forceinline__ void ph_norm(const Ctx& F, const Args& A, int l, int which) {
    const float* gain = (which ? (A.in[7]) : (A.in[6])) + l * D;
    const bool last = (l == DEPTH - 1);
    {
        LAS float* tb = (LAS float*)F.lds;
        for (int i = F.tid; i < 3 * (D / 4); i += NWAVES * 64) { const int v = i / (D / 4), col = (i % (D / 4)) * 4;
            const float* mod = ((float*)(A.ws + WS_MOD)) + ((size_t)l * 3 + v) * MODW + which * 3 * D;
            const f32x4 g = *(const f32x4*)(gain + col), sh = *(const f32x4*)(mod + col), sc = *(const f32x4*)(mod + D + col);
            *(LAS f32x4*)(tb + v * 2 * D + col) = g * (1.0f + sc); *(LAS f32x4*)(tb + v * 2 * D + D + col) = sh; }
        __syncthreads();
    }
    const bool even = (NB * T) % F.NGW == 0 && F.NGW % (NB * CT) == 0; const int cstep = even ? F.NGW / (NB * CT) : 1, nlat = (NB * T) / F.NGW;
    if (!even) {
        for (int m = F.gw; m < M; m += F.NGW) { if ((m % SU) < CT && last && which) continue; f32x4 v[8]; const float* row = norm_src(A, l, which, m);
#pragma unroll
            for (int j = 0; j < 8; ++j) v[j] = *(const f32x4*)(row + F.lane * 8 + 512 * (j >> 1) + 4 * (j & 1));
            norm_row(F, A, l, which, m, v, gain); }
        return;
    }
    f32x4 vn[8];
    { const int vi = F.gw; const float* row = norm_src(A, l, which, (vi / T) * SU + CT + (vi % T));
#pragma unroll
      for (int j = 0; j < 8; ++j) vn[j] = *(const f32x4*)(row + F.lane * 8 + 512 * (j >> 1) + 4 * (j & 1)); }
    for (int it = 0; it < nlat; ++it) {
        const int vi = it * F.NGW + F.gw, m = (vi / T) * SU + CT + (vi % T);
        f32x4 v[8];
#pragma unroll
        for (int j = 0; j < 8; ++j) v[j] = vn[j];
        if (it + 1 < nlat) { const int vj = vi + F.NGW; const float* row = norm_src(A, l, which, (vj / T) * SU + CT + (vj % T));
#pragma unroll
            for (int j = 0; j < 8; ++j) vn[j] = *(const f32x4*)(row + F.lane * 8 + 512 * (j >> 1) + 4 * (j & 1)); }
        norm_row(F, A, l, which, m, v, gain);
    }
    if (!(last && which) && F.gw % cstep == 0) {
        const int c = F.gw / cstep, m = (c / CT) * SU + (c % CT); f32x4 v[8]; const float* row = norm_src(A, l, which, m);
#pragma unroll
        for (int j = 0; j < 8; ++j) v[j] = *(const f32x4*)(row + F.lane * 8 + 512 * (j >> 1) + 4 * (j & 1));
        norm_row(F, A, l, which, m, v, gain);
    }
}
__device__ __forceinline__ void ph_prep(const Ctx& F, const Args& A, int l) {
    const int lane = F.lane, g8 = lane & 7, hd = lane >> 3;
    constexpr float C2 = 0.125f * 1.4426950408889634f;
    bf16* R = ((bf16*)(A.ws + WS_STR)); bf16* KS = R + (size_t)M * BW; bf16* VS = R + 2 * (size_t)M * BW; bf16* KK = R + 3 * (size_t)M * BW;
    const float* ROPE = (const float*)(A.ws + WS_ROPE); bf16* LA = (bf16*)(A.ws + WS_LA);
    LAS float* const mu0b = (LAS float*)F.lds; LAS float* mu0 = mu0b; LAS float* mu1 = mu0 + BIN; LAS float* kkw = mu1 + BIN; LAS float* gwt = kkw + BW;
    for (int i = F.tid; i < 2 * BIN; i += NWAVES * 64) mu0[i] = (A.in[14])[(size_t)(l * 2) * BIN + i];
    for (int i = F.tid; i < BW; i += NWAVES * 64) kkw[i] = (A.in[20])[l * BW + i];
    if (F.tid < 256) { const int q = F.tid >> 6, j = F.tid & 63; gwt[F.tid] = (q == 0 ? (A.in[9]) : q == 1 ? (A.in[10]) : q == 2 ? (A.in[12]) : (A.in[13]))[l * 64 + j]; }
    __syncthreads();
    for (int m = F.gw; m < M; m += F.NGW) {
        const int s = m % SU; const bool isctx = s < CT; const int t = isctx ? 0 : s - CT;
        const bf16* prow = ((bf16*)(A.ws + WS_P)) + (size_t)m * NINP;
        { unsigned ob_ = 0; asm volatile("" : "+v"(ob_)); mu0 = mu0b + ob_; mu1 = mu0 + BIN; kkw = mu1 + BIN; gwt = kkw + BW; }
        const bool hasp = (s != 0 && s != CT), hasn = (s != CT - 1 && s != SU - 1);
        v4u rc[8], rp[8], rn[8];
#pragma unroll
        for (int pass = 0; pass < 8; ++pass) { const int c0 = pass * 512 + lane * 8; const bool on = pass < 7 || lane < 16;
            rc[pass] = on ? *(const v4u*)(prow + PB0 + c0) : (v4u){0u, 0u, 0u, 0u};
            rp[pass] = (on && hasp) ? *(const v4u*)(prow + PB0 + c0 - NINP) : (v4u){0u, 0u, 0u, 0u};
            rn[pass] = (on && hasn) ? *(const v4u*)(prow + PB0 + c0 + NINP) : (v4u){0u, 0u, 0u, 0u}; }
        f32x4 cs = {1.f, 1.f, 1.f, 1.f}, sn = {0.f, 0.f, 0.f, 0.f};
        if (!isctx) { cs = *(const f32x4*)(ROPE + t * 32 + 4 * g8); sn = *(const f32x4*)(ROPE + T * 32 + t * 32 + 4 * g8); }
#pragma unroll
        for (int pass = 0; pass < 3; ++pass) {
            const int part = pass < 2 ? pass : ((hd >> 1) & 1), hs = pass < 2 ? hd : (hd & 1);
            const int src = (pass < 2 ? (part ? PC_Q : PA_Q) : (part ? PC_K : PA_K)) + hs * 64 + 4 * g8;
            const LAS float* gw = gwt + (pass < 2 ? (part ? 2 : 0) : (part ? 3 : 1)) * 64 + 4 * g8;
            const v2u a = *(const v2u*)(prow + src), b = *(const v2u*)(prow + src + 32);
            float x1[4] = {__builtin_bit_cast(float, a.x << 16), __builtin_bit_cast(float, a.x & 0xffff0000u), __builtin_bit_cast(float, a.y << 16), __builtin_bit_cast(float, a.y & 0xffff0000u)};
            float x2[4] = {__builtin_bit_cast(float, b.x << 16), __builtin_bit_cast(float, b.x & 0xffff0000u), __builtin_bit_cast(float, b.y << 16), __builtin_bit_cast(float, b.y & 0xffff0000u)};
            float ss = 0.f;
#pragma unroll
            for (int e = 0; e < 4; ++e) ss += x1[e] * x1[e] + x2[e] * x2[e];
            const float rs = (1.0f / sqrtf(dpp_xor_sum8(ss) * (1.0f / 64.0f) + 1e-6f)) * (pass < 2 ? C2 : 1.0f);
            const f32x4 g1 = *(const LAS f32x4*)gw, g2 = *(const LAS f32x4*)(gw + 32);
            float o1[4], o2[4];
#pragma unroll
            for (int e = 0; e < 4; ++e) { const float y1 = x1[e] * rs * g1[e], y2 = x2[e] * rs * g2[e]; o1[e] = y1 * cs[e] - y2 * sn[e]; o2[e] = y1 * sn[e] + y2 * cs[e]; }
            bf16* dst = pass < 2 ? (part ? ((bf16*)(A.ws + WS_QC)) : ((bf16*)(A.ws + WS_QA))) + (size_t)m * 512 + hs * 64 + 4 * g8
                                 : (part ? ((bf16*)(A.ws + WS_KC)) : ((bf16*)(A.ws + WS_KA))) + (size_t)m * 128 + hs * 64 + 4 * g8;
            if (pass < 2 || hd < 4) { *(v2u*)dst = (v2u){pk2(o1[0], o1[1]), pk2(o1[2], o1[3])}; *(v2u*)(dst + 32) = (v2u){pk2(o2[0], o2[1]), pk2(o2[2], o2[3])}; }
        }
#pragma unroll
        for (int pass = 0; pass < 8; ++pass) {
            const int c0 = pass * 512 + lane * 8;
            if (pass == 7 && lane >= 16) break;
            const v4u pc = rc[pass], pp = rp[pass], pn = rn[pass];
            const f32x4 m0a = *(const LAS f32x4*)(mu0 + c0), m0b = *(const LAS f32x4*)(mu0 + c0 + 4), m1a = *(const LAS f32x4*)(mu1 + c0), m1b = *(const LAS f32x4*)(mu1 + c0 + 4);
            float xs[8];
#pragma unroll
            for (int e = 0; e < 8; ++e) { const unsigned wc = pc[e >> 1], wp = pp[e >> 1], wn = pn[e >> 1];
                const float p = __builtin_bit_cast(float, (e & 1) ? (wc & 0xffff0000u) : (wc << 16)), pv = __builtin_bit_cast(float, (e & 1) ? (wp & 0xffff0000u) : (wp << 16)), nx = __builtin_bit_cast(float, (e & 1) ? (wn & 0xffff0000u) : (wn << 16));
                const float a0 = e < 4 ? m0a[e] : m0b[e - 4], a1 = e < 4 ? m1a[e] : m1b[e - 4];
                xs[e] = p + a0 * (pv - p) + a1 * (nx - p); }
            if (pass < 6) {
                bf16* dst = (pass < 2 ? R : pass < 4 ? KS : VS) + (size_t)m * BW + (c0 & 1023);
                *(v4u*)dst = (v4u){pk2(xs[0], xs[1]), pk2(xs[2], xs[3]), pk2(xs[4], xs[5]), pk2(xs[6], xs[7])};
                if (pass == 2 || pass == 3) {
                    const int cc = c0 - BW; const f32x4 ka = *(const LAS f32x4*)(kkw + cc), kb = *(const LAS f32x4*)(kkw + cc + 4);
                    float z[8], n2 = 0.f;
#pragma unroll
                    for (int e = 0; e < 8; ++e) { z[e] = xs[e] * (e < 4 ? ka[e] : kb[e - 4]); n2 += z[e] * z[e]; }
                    const float inv = 1.0f / fmaxf(sqrtf(dpp_xor_sum8(n2)), 1e-12f);
                    *(v4u*)(KK + (size_t)m * BW + cc) = (v4u){pk2(z[0] * inv, z[1] * inv), pk2(z[2] * inv, z[3] * inv), pk2(z[4] * inv, z[5] * inv), pk2(z[6] * inv, z[7] * inv)};
                }
            } else {
                const int cl = c0 - 3 * BW, p2 = cl < 384 ? cl / 96 : 4, off = cl < 384 ? cl - 96 * p2 : cl - 384;
                float v[8];
#pragma unroll
                for (int e = 0; e < 8; ++e) { const float ex = __expf(p2 < 2 ? 2.0f * xs[e] : -xs[e]), rc = 1.0f / (1.0f + ex); v[e] = p2 < 2 ? 1.0f - 2.0f * rc : (p2 < 4 ? xs[e] : rc); }
                *(v4u*)(LA + ((size_t)p2 * M + m) * 256 + off) = (v4u){pk2(v[0], v[1]), pk2(v[2], v[3]), pk2(v[4], v[5]), pk2(v[6], v[7])};
            }
        }
        for (int i = lane; i < 80; i += 64) { const int p2 = i / 20, j = i % 20; *(v4u*)(LA + ((size_t)p2 * M + m) * 256 + 96 + 8 * j) = (v4u){0u, 0u, 0u, 0u}; }
    }
}
__device__ __forceinline__ void ph_readout(const Ctx& F, const Args& A, int l) {
    const int lane = F.lane; const bool last = (l == DEPTH - 1);
    const bf16* R = ((bf16*)(A.ws + WS_STR)); const bf16* KS = R + (size_t)M * BW; const bf16* VS = R + 2 * (size_t)M * BW;
    const bf16* Y0 = ((bf16*)(A.ws + WS_Y)); const bf16* Y1 = Y0 + (size_t)M * BW; const bf16* AG = ((bf16*)(A.ws + WS_AG));
    const bf16* A0 = AG; const bf16* A1 = AG + (size_t)M * BW; const bf16* Gt = AG + (size_t)2 * M * BW;
    const float* gng = (A.in[23]) + l * BW; const float* gnb = (A.in[24]) + l * BW; const float* kaw = (A.in[21]) + l * BW; const float* rkw = (A.in[22]) + l * BW;
    const int nrow = (M - F.gw + F.NGW - 1) / F.NGW, nit = 2 * nrow;
    v4u rw[8];
#define RO_LOAD(it_) do { const int m_ = F.gw + F.NGW * ((it_) >> 1); const size_t a_ = (size_t)m_ * BW + ((it_) & 1) * 512 + lane * 8; \
        rw[0] = *(const v4u*)(Y0 + a_); rw[1] = *(const v4u*)(Y1 + a_); rw[2] = *(const v4u*)(R + a_); rw[3] = *(const v4u*)(KS + a_); rw[4] = *(const v4u*)(VS + a_); \
        rw[5] = *(const v4u*)(A0 + a_); rw[6] = *(const v4u*)(A1 + a_); rw[7] = *(const v4u*)(Gt + a_); } while (0)
#define UB8(dst, u_) do { _Pragma("unroll") for (int e_ = 0; e_ < 8; ++e_) dst[e_] = __builtin_bit_cast(float, (e_ & 1) ? (u_[e_ >> 1] & 0xffff0000u) : (u_[e_ >> 1] << 16)); } while (0)
#define LD8(dst, ptr) do { const f32x4 u0_ = *(const f32x4*)(ptr), u1_ = *(const f32x4*)((ptr) + 4); dst[0] = u0_.x; dst[1] = u0_.y; dst[2] = u0_.z; dst[3] = u0_.w; dst[4] = u1_.x; dst[5] = u1_.y; dst[6] = u1_.z; dst[7] = u1_.w; } while (0)
    float qg[2][8], qb[2][8], qk[2][8], qr[2][8];
#pragma unroll
    for (int hh = 0; hh < 2; ++hh) { LD8(qg[hh], gng + hh * 512 + lane * 8); LD8(qb[hh], gnb + hh * 512 + lane * 8); LD8(qk[hh], kaw + hh * 512 + lane * 8); LD8(qr[hh], rkw + hh * 512 + lane * 8); }
    if (nit > 0) RO_LOAD(0);
    for (int it0 = 0; it0 < nit; it0 += 2)
#pragma unroll
    for (int hh2 = 0; hh2 < 2; ++hh2) {
        const int it = it0 + hh2; const int m = F.gw + F.NGW * (it >> 1), c0 = hh2 * 512 + lane * 8;
        float y[8], r[8], k[8], v[8], a0[8], a1[8], g[8], pg[8], pb[8], pk[8], pr[8];
        UB8(y, rw[0]); UB8(r, rw[1]);
#pragma unroll
        for (int e = 0; e < 8; ++e) y[e] += r[e];
        UB8(r, rw[2]); UB8(k, rw[3]); UB8(v, rw[4]); UB8(a0, rw[5]); UB8(a1, rw[6]); UB8(g, rw[7]);
        if (it + 1 < nit) RO_LOAD(it + 1);
        if (last && (m % SU) < CT) continue;
#pragma unroll
        for (int e = 0; e < 8; ++e) { pg[e] = qg[hh2][e]; pb[e] = qb[hh2][e]; pk[e] = qk[hh2][e]; pr[e] = qr[hh2][e]; }
        float sy = 0.f, sb = 0.f;
#pragma unroll
        for (int e = 0; e < 8; ++e) { sy += y[e]; sb += r[e] * (k[e] * (2.0f + (a0[e] + a1[e] - 2.0f) * pk[e])) * pr[e]; }
        const float mu = dpp_xor_sum8(sy) * (1.0f / 64.0f), bon = dpp_xor_sum8(sb);
        float sv = 0.f;
#pragma unroll
        for (int e = 0; e < 8; ++e) { y[e] -= mu; sv += y[e] * y[e]; }
        const float rstd = 1.0f / sqrtf(dpp_xor_sum8(sv) * (1.0f / 64.0f) + 64e-5f);
        float o[8];
#pragma unroll
        for (int e = 0; e < 8; ++e) o[e] = (y[e] * rstd * pg[e] + pb[e] + bon * v[e]) * g[e];
        *(v4u*)(((bf16*)(A.ws + WS_MIX)) + (size_t)m * D + 512 + c0) = (v4u){pk2(o[0], o[1]), pk2(o[2], o[3]), pk2(o[4], o[5]), pk2(o[6], o[7])};
    }
#undef RO_LOAD
#undef UB8
#undef LD8
}
namespace wk {
typedef short bf16x8 __attribute__((ext_vector_type(8)));
typedef short s16x4 __attribute__((ext_vector_type(4)));
typedef float f32x16 __attribute__((ext_vector_type(16)));
typedef float f32x4 __attribute__((ext_vector_type(4)));
typedef unsigned u32x4 __attribute__((ext_vector_type(4)));
typedef unsigned u32x2 __attribute__((ext_vector_type(2)));
#define WK_LAS __attribute__((address_space(3)))
#define WK_MFMA(a, b, c) __builtin_amdgcn_mfma_f32_32x32x16_bf16((a), (b), (c), 0, 0, 0)
constexpr int IMG = 16384;
constexpr int O_I0 = 0, O_I1 = IMG, O_I2 = 2 * IMG, O_I3 = 3 * IMG, O_I4 = 4 * IMG, O_I5 = 5 * IMG, O_I6 = 6 * IMG, O_NF = 7 * IMG, O_GAM = 6 * IMG + 8192, O_PART = O_GAM + 256;
constexpr int R1_LDS = 8 * IMG;
constexpr int UNIT_GF = 0, UNIT_RF = 8192, UNIT_HT = 16384, UNIT_Y0 = 24576, UNIT_BYTES = 32768;
__device__ __forceinline__ unsigned off_b(unsigned row, unsigned ch) { return 256u * row + 16u * (ch ^ (((row & 3u) << 2) | ((row >> 2) & 3u))); }
__device__ __forceinline__ int crow(int reg, int h) { return (reg & 3) + 8 * (reg >> 2) + 4 * h; }
__device__ __forceinline__ bf16x8 frag_row(const WK_LAS unsigned char* img, int c, int rb, int ks, int lane) {
    return *(const WK_LAS bf16x8*)(img + off_b(32 * rb + (lane & 31), 8 * c + 2 * ks + (lane >> 5)));
}
__device__ __forceinline__ bf16x8 frag_tr(const WK_LAS unsigned char* img, int c, int cb, int ks, int lane) {
    const unsigned h = lane >> 5, blk = (lane >> 4) & 1, q = (lane & 15) >> 2, p = lane & 3, ch = 4 * (2 * c + cb) + 2 * blk + (p >> 1);
    const s16x4 lo = __builtin_bit_cast(s16x4, __builtin_amdgcn_ds_read_tr16_b64_v4i16((WK_LAS s16x4*)(img + off_b(16 * ks + 8 * h + q, ch) + 8 * (p & 1))));
    const s16x4 hi = __builtin_bit_cast(s16x4, __builtin_amdgcn_ds_read_tr16_b64_v4i16((WK_LAS s16x4*)(img + off_b(16 * ks + 8 * h + 4 + q, ch) + 8 * (p & 1))));
    return (bf16x8){lo[0], lo[1], lo[2], lo[3], hi[0], hi[1], hi[2], hi[3]};
}
typedef float f32x2_t __attribute__((ext_vector_type(2))); typedef __bf16 bf16x2_t __attribute__((ext_vector_type(2)));
__device__ __forceinline__ unsigned pkbf(float lo, float hi) { const f32x2_t v = {lo, hi}; return __builtin_bit_cast(unsigned, __builtin_convertvector(v, bf16x2_t)); }
__device__ __forceinline__ void store_T(WK_LAS unsigned char* img, int c, int mb, int nb, const f32x16& a, int lane) {
    const unsigned row = 32 * nb + (lane & 31), h = lane >> 5;
#pragma unroll
    for (int g = 0; g < 4; ++g) *(WK_LAS u32x2*)(img + off_b(row, 8 * c + 4 * mb + g) + 8 * h) = (u32x2){pkbf(a[4 * g], a[4 * g + 1]), pkbf(a[4 * g + 2], a[4 * g + 3])};
}
template <bool STRICT> __device__ __forceinline__ void mask_diag(f32x16& a, int lane) {
    const int n = lane & 31, h = lane >> 5;
#pragma unroll
    for (int r = 0; r < 16; ++r) { const int m = crow(r, h); if (STRICT ? !(m < n) : !(m <= n)) a[r] = 0.f; }
}
__device__ __forceinline__ bf16x8 pack8(const f32x16& a, int s) { u32x4 p; p[0] = pkbf(a[8 * s], a[8 * s + 1]); p[1] = pkbf(a[8 * s + 2], a[8 * s + 3]); p[2] = pkbf(a[8 * s + 4], a[8 * s + 5]); p[3] = pkbf(a[8 * s + 6], a[8 * s + 7]); return __builtin_bit_cast(bf16x8, p); }
__device__ __forceinline__ f32x16 zero16() { f32x16 z;
#pragma unroll
    for (int i = 0; i < 16; ++i) z[i] = 0.f;
    return z; }
template <bool AT, bool BT> __device__ __forceinline__ void prod(f32x16& acc, const WK_LAS unsigned char* ia, int ca, int ba, const WK_LAS unsigned char* ib, int cbh, int bb, int lane) {
#pragma unroll
    for (int ks = 0; ks < 4; ++ks) {
        const bf16x8 a = AT ? frag_tr(ia, ca, ba, ks, lane) : frag_row(ia, ca, ba, ks, lane);
        const bf16x8 b = BT ? frag_tr(ib, cbh, bb, ks, lane) : frag_row(ib, cbh, bb, ks, lane);
        acc = WK_MFMA(a, b, acc);
    }
}
__device__ __forceinline__ void store_tile_f32(float* dst, const f32x16& a, int lane) {
#pragma unroll
    for (int q = 0; q < 4; ++q) *(f32x4*)(dst + (q * 64 + lane) * 4) = (f32x4){a[4 * q], a[4 * q + 1], a[4 * q + 2], a[4 * q + 3]};
}
__device__ __forceinline__ void store_tile_bf16(unsigned char* dst, const f32x16& a, int lane) {
#pragma unroll
    for (int q2 = 0; q2 < 2; ++q2) *(u32x4*)(dst + (q2 * 64 + lane) * 16) = (u32x4){pkbf(a[8 * q2], a[8 * q2 + 1]), pkbf(a[8 * q2 + 2], a[8 * q2 + 3]), pkbf(a[8 * q2 + 4], a[8 * q2 + 5]), pkbf(a[8 * q2 + 6], a[8 * q2 + 7])};
}
__device__ __forceinline__ void unpack_tile_bf16(f32x16& o, const u32x4& lo, const u32x4& hi) {
#pragma unroll
    for (int e = 0; e < 4; ++e) { o[2 * e] = __builtin_bit_cast(float, lo[e] << 16); o[2 * e + 1] = __builtin_bit_cast(float, lo[e] & 0xffff0000u); o[8 + 2 * e] = __builtin_bit_cast(float, hi[e] << 16); o[8 + 2 * e + 1] = __builtin_bit_cast(float, hi[e] & 0xffff0000u); }
}
struct R1In { const unsigned short *R, *KS, *VS, *KK, *Aa; const _Float16* E; const float* ka; };
struct R1Pre { u32x4 x[6]; };
__device__ __forceinline__ void r1_load(R1Pre& P, const R1In& in, int row0, int rstep, int col0, int tid) {
    const unsigned off = (unsigned)((row0 + rstep * (tid >> 3)) * BW + col0 + 8 * (tid & 7));
    P.x[0] = *(const u32x4*)(in.KK + off); P.x[1] = *(const u32x4*)(in.Aa + off); P.x[2] = *(const u32x4*)(in.KS + off);
    P.x[3] = *(const u32x4*)(in.R + off);  P.x[4] = *(const u32x4*)(in.VS + off); P.x[5] = *(const u32x4*)((const unsigned short*)in.E + off);
}
__device__ __forceinline__ void wkv_r1_unit(WK_LAS unsigned char* L, const R1In& in, R1Pre& P, int col0, unsigned char* urec, int tid, bool has_next, const R1In& inN, int row0N, int rstepN, int col0N) {
    int lane = tid & 63; const int w = __builtin_amdgcn_readfirstlane(tid >> 6); int h = lane >> 5;
#define WK_OPQ() do { asm volatile("" : "+v"(lane)); h = lane >> 5; } while (0)
    WK_LAS unsigned char* I0 = L + O_I0; WK_LAS unsigned char* I1 = L + O_I1; WK_LAS unsigned char* I2 = L + O_I2; WK_LAS unsigned char* I3 = L + O_I3;
    WK_LAS unsigned char* I4 = L + O_I4; WK_LAS unsigned char* I5 = L + O_I5; WK_LAS unsigned char* I6 = L + O_I6;
    WK_OPQ();
    WK_LAS float* NF = (WK_LAS float*)(L + O_NF); WK_LAS float* GAM = (WK_LAS float*)(L + O_GAM); WK_LAS float* PART = (WK_LAS float*)(L + O_PART);
    { PB_BEGIN(30); PBS(36);
        WK_LAS unsigned char* ST = L + O_I3;
#pragma unroll
        for (int a = 0; a < 6; ++a) *(WK_LAS u32x4*)(ST + a * 8192 + tid * 16) = P.x[a];
        if (has_next) r1_load(P, inN, row0N, rstepN, col0N, tid);
        __syncthreads();
        float e[8], kk[8], aa[8], kv[8], rr[8]; unsigned short vraw[8];
        const float ka = in.ka[col0 + lane];
#pragma unroll
        for (int i = 0; i < 8; ++i) { const WK_LAS unsigned short* sp = (const WK_LAS unsigned short*)ST + (8 * w + i) * 64 + lane;
            kk[i] = bf2f(sp[0]); aa[i] = bf2f(sp[4096]); kv[i] = bf2f(sp[2 * 4096]); rr[i] = bf2f(sp[3 * 4096]); vraw[i] = sp[4 * 4096]; e[i] = (float)*(const WK_LAS _Float16*)(sp + 5 * 4096); }
        float run = 0.f;
#pragma unroll
        for (int i = 0; i < 8; ++i) run += e[i];
        PART[w * 64 + lane] = run;
        PBE(36);
        __syncthreads();
        PBS(37);
        float offs = 0.f, tot = 0.f;
#pragma unroll
        for (int w2 = 0; w2 < 8; ++w2) { const float pv = PART[w2 * 64 + lane]; tot += pv; if (w2 < w) offs += pv; }
        if (w == 0) GAM[lane] = __expf(-tot);
        float cum = offs, gprev = __expf(-offs);
#pragma unroll
        for (int i = 0; i < 8; ++i) {
            const int p = 8 * w + i; cum += e[i];
            const float g = __expf(-cum), ginv = __builtin_amdgcn_rcpf(g), a = aa[i];
            const float al = kk[i] * gprev, be = kk[i] * a * ginv, kp = kv[i] * (1.0f + (a - 1.0f) * ka) * ginv, rh = rr[i] * g;
            const unsigned o0 = off_b(p, lane >> 3) + 2 * (lane & 7), o1 = off_b(p, 8 + (lane >> 3)) + 2 * (lane & 7);
            const unsigned c01 = pkbf(al, be), c23 = pkbf(kp, rh);
            *(WK_LAS unsigned short*)(I0 + o0) = (unsigned short)c01; *(WK_LAS unsigned short*)(I0 + o1) = (unsigned short)(c01 >> 16);
            *(WK_LAS unsigned short*)(I1 + o0) = (unsigned short)c23; *(WK_LAS unsigned short*)(I1 + o1) = (unsigned short)(c23 >> 16);
            *(WK_LAS unsigned short*)(I2 + o0) = vraw[i];
            gprev = g;
        }
      PBE(37); PB_END(30); }
    __syncthreads();
    WK_OPQ();
    PBS(31);
#pragma unroll
    for (int q = 0; q < 2; ++q) {
        const int id = 2 * w + q, pr = id >> 2, mb = (id >> 1) & 1, nb = id & 1;
        f32x16 acc = zero16();
        if (pr == 0) {
            if (!(mb == 0 && nb == 1)) { prod<false, false>(acc, I0, 0, mb, I0, 1, nb, lane);
                if (mb == nb) {
#pragma unroll
                    for (int r = 0; r < 16; ++r) if (!((lane & 31) < crow(r, h))) acc[r] = 0.f; } }
#pragma unroll
            for (int g = 0; g < 4; ++g) *(WK_LAS f32x4*)(NF + (32 * nb + (lane & 31)) * 64 + 32 * mb + 8 * g + 4 * h) = (f32x4){acc[4 * g], acc[4 * g + 1], acc[4 * g + 2], acc[4 * g + 3]};
        } else if (pr == 1) {
            if (!(mb == 1 && nb == 0)) { prod<false, false>(acc, I1, 0, mb, I0, 0, nb, lane); if (mb == nb) mask_diag<true>(acc, lane); }
            store_T(I3, 0, mb, nb, acc, lane);
        } else if (pr == 2) {
            if (!(mb == 1 && nb == 0)) { prod<false, false>(acc, I1, 0, mb, I1, 1, nb, lane); if (mb == nb) mask_diag<false>(acc, lane); }
            store_T(I4, 0, mb, nb, acc, lane);
        } else {
            if (!(mb == 1 && nb == 0)) { prod<false, false>(acc, I0, 1, mb, I1, 1, nb, lane); if (mb == nb) mask_diag<false>(acc, lane); }
            store_T(I4, 1, mb, nb, acc, lane);
        }
    }
    PBE(31);
    __syncthreads();
    WK_OPQ();
    PBS(32);
    f32x16 accA = zero16(), accB = zero16(), accC = zero16();
    const int omb = (w >> 1) & 1, onb = w & 1;
    if (w == 0) {
        typedef float f32x2v __attribute__((ext_vector_type(2)));
        f32x2v mm[16];
        const int tt = lane & 31; const WK_LAS float* nrow = NF + (32 * h) * 64 + 32 * h;
#pragma unroll
        for (int k = 0; k < 16; ++k) mm[k] = (f32x2v){0.f, 0.f};
#pragma unroll
        for (int s = 31; s >= 0; --s) {
            float acc = (s == tt) ? 1.f : 0.f; f32x2v a01 = {0.f, 0.f}, a23 = {0.f, 0.f};
            const WK_LAS float* pr = nrow + s * 64;
            if (s < 28) { const float dep_ = ((s + 4) & 1) ? mm[(s + 4) >> 1].y : mm[(s + 4) >> 1].x; asm volatile("" : "+v"(pr) : "v"(dep_)); }
#pragma unroll
            for (int r4 = ((s + 1) & ~3); r4 < 32; r4 += 4) { const f32x4 nv = *(const WK_LAS f32x4*)(pr + r4);
                if (r4 > s) { a01 -= (f32x2v){nv.x, nv.y} * mm[r4 >> 1]; a23 -= (f32x2v){nv.z, nv.w} * mm[(r4 >> 1) + 1]; }
                else { if (r4 + 1 > s) acc -= nv.y * mm[r4 >> 1].y; if (r4 + 2 > s) acc -= nv.z * mm[(r4 >> 1) + 1].x; if (r4 + 3 > s) acc -= nv.w * mm[(r4 >> 1) + 1].y; } }
            acc += (a01.x + a01.y) + (a23.x + a23.y);
            if (s & 1) mm[s >> 1].y = acc; else mm[s >> 1].x = acc;
        }
        float m[32];
#pragma unroll
        for (int s = 0; s < 32; ++s) m[s] = (s & 1) ? mm[s >> 1].y : mm[s >> 1].x;
        const unsigned row = 32 * h + tt;
#pragma unroll
        for (int c4 = 0; c4 < 4; ++c4) {
            *(WK_LAS u32x4*)(I2 + off_b(row, 8 + 4 * h + c4)) = (u32x4){pkbf(m[8 * c4], m[8 * c4 + 1]), pkbf(m[8 * c4 + 2], m[8 * c4 + 3]), pkbf(m[8 * c4 + 4], m[8 * c4 + 5]), pkbf(m[8 * c4 + 6], m[8 * c4 + 7])};
            if (h == 0) *(WK_LAS u32x4*)(I2 + off_b(row, 8 + 4 + c4)) = (u32x4){0u, 0u, 0u, 0u};
        }
    } else if (w < 4) {
        prod<false, true>(accA, I4, 0, omb, I2, 0, onb, lane);
        if (w == 1) prod<false, true>(accC, I4, 0, 0, I2, 0, 0, lane);
    } else {
        prod<true, true>(accA, I1, 0, omb, I2, 0, onb, lane);
        f32x16 q = zero16(); prod<true, false>(q, I2, 0, omb, I3, 0, onb, lane); store_T(I3, 1, omb, onb, q, lane);
    }
    WK_OPQ();
    if (w == 0) {
        f32x16 t1 = zero16();
#pragma unroll
        for (int ks = 0; ks < 2; ++ks) {
            const WK_LAS float* np = NF + (lane & 31) * 64 + 32 + 16 * ks + 8 * h; const f32x4 n0 = *(const WK_LAS f32x4*)np, n1 = *(const WK_LAS f32x4*)(np + 4);
            const bf16x8 a = __builtin_bit_cast(bf16x8, (u32x4){pkbf(n0.x, n0.y), pkbf(n0.z, n0.w), pkbf(n1.x, n1.y), pkbf(n1.z, n1.w)});
            t1 = WK_MFMA(a, frag_row(I2, 1, 1, 2 + ks, lane), t1);
        }
        store_T(I6, 0, 0, 0, t1, lane);
        f32x16 m01 = zero16();
#pragma unroll
        for (int ks = 0; ks < 2; ++ks) m01 = WK_MFMA(frag_tr(I2, 1, 0, ks, lane), frag_row(I6, 0, 0, ks, lane), m01);
#pragma unroll
        for (int r = 0; r < 16; ++r) m01[r] = -m01[r];
        store_T(I2, 1, 0, 1, m01, lane);
    }
    PBE(32);
    __syncthreads();
    WK_OPQ();
    PBS(33);
    {
        f32x16 acc = zero16();
        if (w < 4) { prod<true, false>(acc, I0, 0, omb, I2, 1, onb, lane); store_T(I5, 0, omb, onb, acc, lane); }
        else       { prod<true, false>(acc, I3, 1, omb, I2, 1, onb, lane); store_T(I5, 1, omb, onb, acc, lane); }
    }
    PBE(33);
    __syncthreads();
    WK_OPQ();
#pragma unroll
    for (int a = 0; a < 6; ++a) asm volatile("" :: "v"(P.x[a]));
    PBS(34);
    if (w < 4) {
        f32x16 acc = zero16();
        prod<true, false>(acc, I5, 0, omb, I4, 1, onb, lane);
        { const unsigned row = 32 * onb + (lane & 31);
#pragma unroll
            for (int g = 0; g < 4; ++g) { const u32x2 rv = *(const WK_LAS u32x2*)(I1 + off_b(row, 8 + 4 * omb + g) + 8 * h);
                acc[4 * g] = __builtin_bit_cast(float, rv.x << 16) - acc[4 * g]; acc[4 * g + 1] = __builtin_bit_cast(float, rv.x & 0xffff0000u) - acc[4 * g + 1];
                acc[4 * g + 2] = __builtin_bit_cast(float, rv.y << 16) - acc[4 * g + 2]; acc[4 * g + 3] = __builtin_bit_cast(float, rv.y & 0xffff0000u) - acc[4 * g + 3]; } }
#pragma unroll
        for (int s = 0; s < 2; ++s) *(bf16x8*)(urec + UNIT_RF + (((omb * 2 + onb) * 2 + s) * 64 + lane) * 16) = pack8(acc, s);
        if (w >= 1) {
            prod<false, true>(accB, I4, 1, omb, I5, 1, onb, lane);
#pragma unroll
            for (int r = 0; r < 16; ++r) accA[r] -= accB[r];
            store_tile_bf16(urec + UNIT_Y0 + (omb * 2 + onb) * 2048, accA, lane);
            if (w == 1) { f32x16 b2 = zero16(); prod<false, true>(b2, I4, 1, 0, I5, 1, 0, lane);
#pragma unroll
                for (int r = 0; r < 16; ++r) accC[r] -= b2[r];
                store_tile_bf16(urec + UNIT_Y0, accC, lane); }
        }
    } else {
        f32x16 x = zero16();
        prod<true, true>(x, I5, 0, omb, I0, 1, onb, lane);
        const float gj = GAM[32 * onb + (lane & 31)];
#pragma unroll
        for (int r = 0; r < 16; ++r) x[r] = gj * (((32 * omb + crow(r, h)) == (32 * onb + (lane & 31)) ? 1.f : 0.f) - x[r]);
#pragma unroll
        for (int s = 0; s < 2; ++s) *(bf16x8*)(urec + UNIT_GF + (((omb * 2 + onb) * 2 + s) * 64 + lane) * 16) = pack8(x, s);
        prod<true, true>(accB, I0, 1, omb, I5, 1, onb, lane);
#pragma unroll
        for (int g = 0; g < 4; ++g) { const f32x4 gv = *(const WK_LAS f32x4*)(GAM + 32 * omb + 8 * g + 4 * h);
            accA[4 * g] = gv.x * (accA[4 * g] - accB[4 * g]); accA[4 * g + 1] = gv.y * (accA[4 * g + 1] - accB[4 * g + 1]); accA[4 * g + 2] = gv.z * (accA[4 * g + 2] - accB[4 * g + 2]); accA[4 * g + 3] = gv.w * (accA[4 * g + 3] - accB[4 * g + 3]); }
        store_tile_bf16(urec + UNIT_HT + (omb * 2 + onb) * 2048, accA, lane);
    }
    PBE(34);
    __syncthreads();
#undef WK_OPQ
}
constexpr int R2_NS = 8, R2_CTL = R2_NS * 4096;
struct R2Gh { bf16x8 g[4]; u32x4 h[2]; };
__device__ __forceinline__ void r2_ld_gh(R2Gh& X, const unsigned char* u, int vb, int jb, int lane) {
#pragma unroll
    for (int ib = 0; ib < 2; ++ib)
#pragma unroll
        for (int s = 0; s < 2; ++s) X.g[ib * 2 + s] = *(const bf16x8*)(u + UNIT_GF + ((((ib * 2 + jb) * 2 + s) * 64) + lane) * 16);
#pragma unroll
    for (int q = 0; q < 2; ++q) X.h[q] = *(const u32x4*)(u + UNIT_HT + (jb * 2 + vb) * 2048 + (q * 64 + lane) * 16);
}
__device__ __forceinline__ void r2_step_a(f32x16& S, R2Gh& X, const unsigned char* unext, WK_LAS unsigned char* L, int ci, int vb, int jb, int lane) {
    volatile WK_LAS unsigned* ctl = (volatile WK_LAS unsigned*)(L + R2_CTL);
    if (ci >= R2_NS) { unsigned sp_ = 0; while (((int)ctl[1] < ci - R2_NS + 1 || (int)ctl[2] < ci - R2_NS + 1) && ++sp_ < (1u << 22)) __builtin_amdgcn_s_sleep(1); }
    const bf16x8 own0 = pack8(S, 0), own1 = pack8(S, 1);
    WK_LAS bf16x8* slot = (WK_LAS bf16x8*)(L + (ci % R2_NS) * 4096) + lane;
    slot[128 * jb] = own0; slot[128 * jb + 64] = own1;
    asm volatile("s_waitcnt lgkmcnt(0)" ::: "memory");
    if (lane == 0) ctl[jb ? 3 : 0] = (unsigned)(ci + 1);
    { unsigned sp_ = 0; while ((int)ctl[jb ? 0 : 3] < ci + 1 && ++sp_ < (1u << 22)) __builtin_amdgcn_s_sleep(1); }
    asm volatile("" ::: "memory");
    const bf16x8 oth0 = slot[128 * (1 - jb)], oth1 = slot[128 * (1 - jb) + 64];
    const bf16x8 s00 = jb ? oth0 : own0, s01 = jb ? oth1 : own1, s10 = jb ? own0 : oth0, s11 = jb ? own1 : oth1;
    f32x16 h; unpack_tile_bf16(h, X.h[0], X.h[1]);
    h = WK_MFMA(X.g[0], s00, h); h = WK_MFMA(X.g[1], s01, h); h = WK_MFMA(X.g[2], s10, h); h = WK_MFMA(X.g[3], s11, h);
    S = h;
    r2_ld_gh(X, unext, vb, jb, lane);
}
struct R2Rh { bf16x8 r[4]; u32x4 y[2]; };
__device__ __forceinline__ void r2_ld_rh(R2Rh& X, const unsigned char* u, int vb, int tb, int lane) {
#pragma unroll
    for (int ib = 0; ib < 2; ++ib)
#pragma unroll
        for (int s = 0; s < 2; ++s) X.r[ib * 2 + s] = *(const bf16x8*)(u + UNIT_RF + ((((ib * 2 + tb) * 2 + s) * 64) + lane) * 16);
#pragma unroll
    for (int q = 0; q < 2; ++q) X.y[q] = *(const u32x4*)(u + UNIT_Y0 + (tb * 2 + vb) * 2048 + (q * 64 + lane) * 16);
}
__device__ __forceinline__ void r2_step_b(R2Rh& X, const unsigned char* unext, WK_LAS unsigned char* L, int ci, unsigned short* Yo, int brow0, int dir, int col0, int vb, int tb, int lane) {
    volatile WK_LAS unsigned* ctl = (volatile WK_LAS unsigned*)(L + R2_CTL);
    { unsigned sp_ = 0; while (((int)ctl[0] < ci + 1 || (int)ctl[3] < ci + 1) && ++sp_ < (1u << 22)) __builtin_amdgcn_s_sleep(1); }
    asm volatile("" ::: "memory");
    const WK_LAS bf16x8* slot = (const WK_LAS bf16x8*)(L + (ci % R2_NS) * 4096) + lane;
    const bf16x8 s00 = slot[0], s01 = slot[64], s10 = slot[128], s11 = slot[192];
    f32x16 yo; unpack_tile_bf16(yo, X.y[0], X.y[1]);
    yo = WK_MFMA(X.r[0], s00, yo); yo = WK_MFMA(X.r[1], s01, yo); yo = WK_MFMA(X.r[2], s10, yo); yo = WK_MFMA(X.r[3], s11, yo);
    asm volatile("s_waitcnt lgkmcnt(0)" ::: "memory");
    if (lane == 0) ctl[1 + tb] = (unsigned)(ci + 1);
    r2_ld_rh(X, unext, vb, tb, lane);
    const int uc = dir == 0 ? ci : (ci < 4 ? 3 - ci : 71 - ci);
    int lo_ = lane; asm volatile("" : "+v"(lo_));
    WK_LAS unsigned short* ys = (WK_LAS unsigned short*)(L + R2_CTL + 256 + tb * 2048);
    const int n_ = lo_ & 31, h_ = lo_ >> 5;
#pragma unroll
    for (int r = 0; r < 16; r += 2) { const unsigned pr_ = pkbf(yo[r], yo[r + 1]);
        ys[((r & 3) + 8 * (r >> 2) + 4 * h_) * 32 + n_] = (unsigned short)pr_; ys[(((r + 1) & 3) + 8 * ((r + 1) >> 2) + 4 * h_) * 32 + n_] = (unsigned short)(pr_ >> 16); }
    asm volatile("s_waitcnt lgkmcnt(0)" ::: "memory");
#pragma unroll
    for (int k = 0; k < 2; ++k) { const int pl = 16 * k + (lo_ >> 2), pos = 32 * tb + pl; const u32x4 v = *(const WK_LAS u32x4*)((const WK_LAS unsigned char*)ys + pl * 64 + (lo_ & 3) * 16);
        *(u32x4*)(Yo + (size_t)(brow0 + 64 * uc + (dir ? 63 - pos : pos)) * BW + col0 + 32 * vb + (lo_ & 3) * 8) = v; }
    asm volatile("s_waitcnt lgkmcnt(0)" ::: "memory");
}
__device__ __forceinline__ void wkv_r2_chain(const unsigned char* urec0, unsigned short* Yo, int brow0, int dir, int col0, int vb, int lane, int role, WK_LAS unsigned char* L) {
#define R2_U(ci_) (urec0 + (size_t)((ci_) < 68 ? (ci_) : 67) * UNIT_BYTES)
    if (role == 0 || role == 3) {
        const int jb = role ? 1 : 0;
        f32x16 S = zero16();
        R2Gh X0, X1, X2, X3; r2_ld_gh(X0, R2_U(0), vb, jb, lane); r2_ld_gh(X1, R2_U(1), vb, jb, lane); r2_ld_gh(X2, R2_U(2), vb, jb, lane); r2_ld_gh(X3, R2_U(3), vb, jb, lane);
        for (int ci = 0; ci < 68; ci += 4) {
            r2_step_a(S, X0, R2_U(ci + 4), L, ci, vb, jb, lane);
            r2_step_a(S, X1, R2_U(ci + 5), L, ci + 1, vb, jb, lane);
            r2_step_a(S, X2, R2_U(ci + 6), L, ci + 2, vb, jb, lane);
            r2_step_a(S, X3, R2_U(ci + 7), L, ci + 3, vb, jb, lane);
        }
    } else {
        const int tb = role - 1;
        R2Rh X0, X1, X2, X3; r2_ld_rh(X0, R2_U(0), vb, tb, lane); r2_ld_rh(X1, R2_U(1), vb, tb, lane); r2_ld_rh(X2, R2_U(2), vb, tb, lane); r2_ld_rh(X3, R2_U(3), vb, tb, lane);
        for (int ci = 0; ci < 68; ci += 4) {
            r2_step_b(X0, R2_U(ci + 4), L, ci, Yo, brow0, dir, col0, vb, tb, lane);
            r2_step_b(X1, R2_U(ci + 5), L, ci + 1, Yo, brow0, dir, col0, vb, tb, lane);
            r2_step_b(X2, R2_U(ci + 6), L, ci + 2, Yo, brow0, dir, col0, vb, tb, lane);
            r2_step_b(X3, R2_U(ci + 7), L, ci + 3, Yo, brow0, dir, col0, vb, tb, lane);
        }
    }
#undef R2_U
}
#undef WK_LAS
#undef WK_MFMA
}
__device__ __forceinline__ void ph_wkv_r1(const Ctx& F, const Args& A, int l) {
    const bf16* STR = (const bf16*)(A.ws + WS_STR);
#define R1_UNIT_SETUP(u_, in_, row0_, rstep_, col0_) do { const int ci_ = (u_) % 68, hd_ = ((u_) / 68) & 15, dir_ = ((u_) / (68 * 16)) & 1, b_ = (u_) / (68 * 32); \
        const int uc_ = dir_ == 0 ? ci_ : (ci_ < 4 ? 3 - ci_ : 71 - ci_); \
        in_.R = STR; in_.KS = STR + (size_t)M * BW; in_.VS = STR + 2 * (size_t)M * BW; in_.KK = STR + 3 * (size_t)M * BW; \
        in_.E = (const _Float16*)(A.ws + WS_LO) + (size_t)dir_ * M * BW; in_.Aa = (const bf16*)(A.ws + WS_AG) + (size_t)dir_ * M * BW; in_.ka = A.in[21] + l * BW; \
        row0_ = b_ * SU + 64 * uc_ + (dir_ ? 63 : 0); rstep_ = dir_ ? -1 : 1; col0_ = 64 * hd_; } while (0)
    constexpr int NU = 2 * 2 * 16 * 68;
    wk::R1Pre P; wk::R1In in, inN; int row0, rstep, col0, row0N = 0, rstepN = 1, col0N = 0;
    int u = F.vcu;
    if (u < NU) { R1_UNIT_SETUP(u, in, row0, rstep, col0); wk::r1_load(P, in, row0, rstep, col0, F.tid); }
    for (; u < NU; u += F.G) {
        const bool hn = (u + F.G) < NU; inN = in;
        if (hn) R1_UNIT_SETUP(u + F.G, inN, row0N, rstepN, col0N);
        wk::wkv_r1_unit(F.lds, in, P, col0, A.ws + WS_RW + (size_t)u * wk::UNIT_BYTES, F.tid, hn, inN, row0N, rstepN, col0N);
        in = inN; col0 = col0N;
    }
#undef R1_UNIT_SETUP
}
__device__ __forceinline__ void ph_attn(const Ctx& F, const Args& A, int l, char* ldsg) {
    const bool last = (l == DEPTH - 1);
    typedef attn_body::bf16 abf;
    for (int i = 0;; ++i) {
        int u;
        if (F.G == 256) { if (i == 0) u = F.vcu; else if (F.vcu < 128 || i > 3) break; else if (i < 3) u = 256 + 2 * (F.vcu - 128) + (i - 1); else { if (last || F.vcu >= 160) break; u = 512 + (F.vcu - 128); } }
        else { u = i * F.G + F.vcu; if (u >= (last ? 512 : 544)) break; }
        attn_body::AttnJob J;
        if (u < 256) {
            const int b = u >> 7, h = (u >> 4) & 7, qb = u & 15; const size_t r0 = (size_t)b * SU, q0 = r0 + CT + (size_t)qb * 256;
            J.Qw0 = (const abf*)(((bf16*)(A.ws + WS_QC)) + q0 * 512 + h * 64); J.Kh = (const abf*)(((bf16*)(A.ws + WS_KC)) + r0 * 128 + (h >> 2) * 64); J.Vh = (const abf*)(((bf16*)(A.ws + WS_P)) + r0 * NINP + PC_V + (h >> 2) * 64);
            J.o_off = (unsigned)(q0 * D + 1536 + h * 64); J.NT = 68; J.lat_lo = 0; J.qpos0 = 0; J.sidx = -1;
            attn_body::attn_unit<0, 8>(J, A, ldsg, F.wave);
        } else if (u < 512) {
            const int w = u - 256, b = w >> 7, h = (w >> 4) & 7, qb = w & 15; const size_t r0 = (size_t)b * SU, q0 = r0 + CT + (size_t)qb * 256;
            const int lo = (4 * qb - 2) < 0 ? 0 : 4 * qb - 2, hi = (4 * qb + 5) > 63 ? 63 : 4 * qb + 5;
            J.Qw0 = (const abf*)(((bf16*)(A.ws + WS_QA)) + q0 * 512 + h * 64); J.Kh = (const abf*)(((bf16*)(A.ws + WS_KA)) + r0 * 128 + (h >> 2) * 64); J.Vh = (const abf*)(((bf16*)(A.ws + WS_P)) + r0 * NINP + PA_V + (h >> 2) * 64);
            J.o_off = (unsigned)(q0 * D + h * 64); J.NT = 4 + (hi - lo + 1); J.lat_lo = lo; J.qpos0 = qb * 256; J.sidx = l * 8 + h;
            attn_body::attn_unit<1, 8>(J, A, ldsg, F.wave);
        } else {
            const int c = u - 512, part = c >> 4, b = (c >> 3) & 1, h = c & 7; const size_t r0 = (size_t)b * SU;
            J.Qw0 = (const abf*)((part ? ((bf16*)(A.ws + WS_QC)) : ((bf16*)(A.ws + WS_QA))) + r0 * 512 + h * 64); J.Kh = (const abf*)((part ? ((bf16*)(A.ws + WS_KC)) : ((bf16*)(A.ws + WS_KA))) + r0 * 128 + (h >> 2) * 64);
            J.Vh = (const abf*)(((bf16*)(A.ws + WS_P)) + r0 * NINP + (part ? PC_V : PA_V) + (h >> 2) * 64); J.o_off = (unsigned)(r0 * D + (part ? 1536 : 0) + h * 64);
            J.NT = 4; J.lat_lo = 0; J.qpos0 = 0; J.sidx = part ? -1 : l * 8 + h;
            attn_body::attn_unit<0, 8>(J, A, ldsg, F.wave);
        }
    }
    if (F.tid < 4) ((volatile LAS unsigned*)(F.lds + wk::R2_CTL))[F.tid] = 0u;
    __syncthreads();
    { PB_BEGIN(12);
      for (int hc = F.vcu; hc < 128; hc += F.G) if (F.wave < 4) {
          const int ch = hc >> 1, b = ch >> 5, hd = (ch >> 1) & 15, dir = ch & 1;
          wk::wkv_r2_chain(A.ws + WS_RW + (size_t)(((b * 2 + dir) * 16 + hd) * 68) * wk::UNIT_BYTES, (bf16*)(A.ws + WS_Y) + (size_t)dir * M * BW, b * SU, dir, 64 * hd, hc & 1, F.lane, F.wave, F.lds);
      }
      PB_END(12); }
}
#define MKARGS() const __attribute__((address_space(4))) Args* ap_ = (const __attribute__((address_space(4))) Args*)__builtin_amdgcn_kernarg_segment_ptr(); asm volatile("" : "+s"(ap_)); const Args& A = *(const Args*)ap_
#define MKCTX() MKARGS(); Ctx F; { int t_ = wv * 64 + hw_lane(); asm volatile("" : "+v"(t_)); F.lds = ldsb; F.tid = t_; F.lane = t_ & 63; F.wave = __builtin_amdgcn_readfirstlane(t_ >> 6); F.G = gridDim.x; \
        { const int bx = blockIdx.x; F.vcu = (F.G % 8 == 0) ? (bx % 8) * (F.G / 8) + bx / 8 : bx; } F.gw = F.vcu * NWAVES + F.wave; F.NGW = F.G * NWAVES; }
#ifndef ONLY_PHASE
#define ONLY_PHASE -1
#endif
#define EN(j) (ONLY_PHASE < 0 || ONLY_PHASE == (j))
#define IN(k) (lo <= (k) && (k) < hi)
#define SEAM(k) do { if (IN((k) + 1)) { if (MK_PER_PHASE) { if (wv == 0 && hw_lane() == 0) __hip_atomic_store(ctl + CW_TMO, 0xBADBA0u, RLX_AGENT); } else { xcd_barrier(bar, wv == 0 && hw_lane() == 0); if (PROBE_PHASE == 20) xcd_barrier(bar, wv == 0 && hw_lane() == 0); } } } while (0)
template <int l> __device__ __forceinline__ void layer_phases(int wv, int lo, int hi, const XcdBarrier& bar, gu32* ctl, LAS unsigned char* const ldsb, unsigned char* lds_raw) {
        const int pb = 2 + PPL * l; const bool last = (l == DEPTH - 1);
        if (EN(2) && IN(pb + 0)) { MKCTX(); PB_BEGIN(2); ph_norm(F, A, l, 0); PB_END(2); SEAM(pb + 0); }
        if (EN(3) && IN(pb + 1)) {
            MKARGS();
            pg8::Gemm g{((bf16*)(A.ws + WS_U)), ((bf16*)(A.ws + WS_WIN)) + (size_t)l * NINP * D, M, NINP, D}; pg8::StaticOrder S; S.init(M, NINP, (int)gridDim.x, (int)blockIdx.x);
            pg8::EpiBf16<0> E{((bf16*)(A.ws + WS_P)), NINP, nullptr, 0, 0, 1.f};
            PB_BEGIN(3);
            pg8::gemm_phase<pg8::EpiBf16<0>, pg8::StaticOrder, true, true>(ldsb, g, S, E, wv * 64 + hw_lane());
            if ((int)gridDim.x == 256 && (int)blockIdx.x >= 202) { MKCTX(); convert_items(F, A, l, 1, 0, CI_OUT, ((int)blockIdx.x - 202) * NWAVES + F.wave, 54 * NWAVES); }
            PB_END(3);
            SEAM(pb + 1);
        }
        if (EN(4) && IN(pb + 2)) { MKCTX(); PB_BEGIN(4); ph_prep(F, A, l); PB_END(4); SEAM(pb + 2); }
        if (EN(5) && IN(pb + 3)) {
            MKARGS();
            pg8::Gemm g{((bf16*)(A.ws + WS_LA)), ((bf16*)(A.ws + WS_LW)) + (size_t)l * 5 * 1024 * 256, 5 * M, 5 * 1024, 256}; pg8::LoraOrder S{(int)gridDim.x, (int)blockIdx.x};
            pg8::EpiLora E{((_Float16*)(A.ws + WS_LO)), (bf16*)(A.ws + WS_AG), (A.in[15]) + (size_t)l * 2 * BW, (A.in[17]) + (size_t)l * 2 * BW};
            PB_BEGIN(5);
            pg8::gemm_phase<pg8::EpiLora, pg8::LoraOrder, true, true>(ldsb, g, S, E, wv * 64 + hw_lane());
            PB_END(5);
            SEAM(pb + 3);
        }
        if (EN(13) && IN(pb + 4)) { MKCTX(); PB_BEGIN(13); ph_wkv_r1(F, A, l); PB_END(13); SEAM(pb + 4); }
        if (EN(6) && IN(pb + 5)) { MKCTX(); PB_BEGIN(6); ph_attn(F, A, l, (char*)lds_raw); PB_END(6); SEAM(pb + 5); }
        if (EN(7) && IN(pb + 6)) { MKCTX(); PB_BEGIN(7); ph_readout(F, A, l); PB_END(7); SEAM(pb + 6); }
        if (EN(8) && IN(pb + 7)) {
            MKARGS();
            pg8::Gemm g{((bf16*)(A.ws + WS_MIX)), ((bf16*)(A.ws + WS_WOUT)) + (size_t)l * D * D, M, D, D}; pg8::RowMapOrder S; S.init2(D, D, (int)gridDim.x, (int)blockIdx.x, last ? 1 : 0, 8);
            pg8::EpiResid E{l == 0 ? (A.in[0]) : (A.out), l == 0 ? (A.in[2]) : ((float*)(A.ws + WS_HCTX)), (A.out), ((float*)(A.ws + WS_HCTX)), ((float*)(A.ws + WS_MOD)) + (size_t)l * 3 * MODW + 2 * D, (float*)(A.ws + WS_SL)};
            PB_BEGIN(8);
            pg8::gemm_phase<pg8::EpiResid, pg8::RowMapOrder, true, true>(ldsb, g, S, E, wv * 64 + hw_lane());
            if (!last && (int)gridDim.x == 256 && (int)blockIdx.x >= 128) { MKCTX(); const int w0_ = ((int)blockIdx.x - 128) * NWAVES + F.wave, nw_ = 128 * NWAVES;
                convert_items(F, A, l, 2, 0, CI_1, w0_, nw_); convert_items(F, A, 3, 3, l * (CI_2 / 3 + 1), (l + 1) * (CI_2 / 3 + 1) < CI_2 ? (l + 1) * (CI_2 / 3 + 1) : CI_2, w0_, nw_); }
            PB_END(8);
            SEAM(pb + 7);
        }
        if (EN(9) && IN(pb + 8)) { MKCTX(); PB_BEGIN(9); ph_norm(F, A, l, 1); PB_END(9); SEAM(pb + 8); }
        if (EN(10) && IN(pb + 9)) {
            MKARGS();
            pg8::Gemm g{((bf16*)(A.ws + WS_U)), ((bf16*)(A.ws + WS_W1)) + (size_t)l * FF * D, M, FF, D}; pg8::RowMapOrder S; S.init2(FF, D, (int)gridDim.x, (int)blockIdx.x, last ? 1 : 0, 1);
            pg8::EpiRelu2 E{((bf16*)(A.ws + WS_HID)), FF};
            PB_BEGIN(10);
            pg8::gemm_phase<pg8::EpiRelu2, pg8::RowMapOrder, true, true>(ldsb, g, S, E, wv * 64 + hw_lane());
            if (!last && (int)gridDim.x == 256 && (int)blockIdx.x >= 64) { MKCTX(); const int w0_ = ((int)blockIdx.x - 64) * NWAVES + F.wave, nw_ = 192 * NWAVES;
                convert_items(F, A, l, 3, 0, CI_2, w0_, nw_); convert_items(F, A, 3, 2, l * (CI_1 / 3 + 1), (l + 1) * (CI_1 / 3 + 1) < CI_1 ? (l + 1) * (CI_1 / 3 + 1) : CI_1, w0_, nw_); }
            PB_END(10);
            SEAM(pb + 9);
        }
        if (EN(11) && IN(pb + 10)) {
            MKARGS();
            pg8::Gemm g{((bf16*)(A.ws + WS_HID)), ((bf16*)(A.ws + WS_W2)) + (size_t)l * D * FF, M, D, FF}; pg8::RowMapOrder S; S.init2(D, FF, (int)gridDim.x, (int)blockIdx.x, last ? 1 : 0, 8);
            pg8::EpiResid E{(A.out), ((float*)(A.ws + WS_HCTX)), (A.out), ((float*)(A.ws + WS_HCTX)), ((float*)(A.ws + WS_MOD)) + (size_t)l * 3 * MODW + 5 * D, (float*)(A.ws + WS_SL)};
            PB_BEGIN(11);
            pg8::gemm_phase<pg8::EpiResid, pg8::RowMapOrder, true, true>(ldsb, g, S, E, wv * 64 + hw_lane());
            if (!last && (int)gridDim.x == 256 && (int)blockIdx.x >= 128) { MKCTX(); convert_items(F, A, l + 1, 0, 0, CI_IN, ((int)blockIdx.x - 128) * NWAVES + F.wave, 128 * NWAVES); }
            PB_END(11);
            SEAM(pb + 10);
        }
}
__global__ void __launch_bounds__(NWAVES * 64, 2) fwd(Args args) {
    extern __shared__ __attribute__((aligned(16))) unsigned char lds_raw[];
    LAS unsigned char* const ldsb = (LAS unsigned char*)lds_raw;
    unsigned char* ws = args.ws;
    const int wv = __builtin_amdgcn_readfirstlane((int)threadIdx.x >> 6);
    for (int u = wv * 64 + hw_lane(); u < (LDS_BYTES - LDSCTL_OFF) / 4; u += NWAVES * 64) ((LAS unsigned*)(ldsb + LDSCTL_OFF))[u] = 0u;
    __syncthreads();
    gu32* ctl = (gu32*)(ws + WS_CTL);
    XcdBarrier bar; bar.bar = (unsigned*)(ctl + CW_BAR); bar.x = 0; bar.st = nullptr;
    if (!MK_PER_PHASE) bar = xcd_barrier_post((unsigned*)(ctl + CW_BAR), (volatile LAS unsigned*)(ldsb + MISC_OFF) + 8, wv == 0 && hw_lane() == 0);
    const int lo = args.ph_lo, hi = args.ph_hi;
    if (EN(0) && IN(0)) { MKCTX(); PB_BEGIN(0); p0_prologue(F, A); PB_END(0); SEAM(0); }
    if (EN(1) && IN(1)) { MKCTX(); PB_BEGIN(1); p0b_mods(F, A); PB_END(1); SEAM(1); }
    layer_phases<0>(wv, lo, hi, bar, ctl, ldsb, lds_raw); layer_phases<1>(wv, lo, hi, bar, ctl, ldsb, lds_raw); layer_phases<2>(wv, lo, hi, bar, ctl, ldsb, lds_raw); layer_phases<3>(wv, lo, hi, bar, ctl, ldsb, lds_raw);
#undef IN
#undef SEAM
}
extern "C" void kernel_launch(void* const* d_in, const int* in_sizes, int n_in, void* d_out, int out_size, void* d_ws, size_t ws_size, hipStream_t stream) {
    static int grid = 0;
    if (grid == 0) {
        if (n_in != 28 || out_size != NB * T * D || ws_size < WS_END) { fprintf(stderr, "kernel_launch: unexpected shapes (n_in %d, out %d, ws %zu < %zu)\n", n_in, out_size, ws_size, (size_t)WS_END); grid = -1; return; }
        int dev = 0, cus = 0, per_cu = 0;
        if (hipGetDevice(&dev) != hipSuccess || hipDeviceGetAttribute(&cus, hipDeviceAttributeMultiprocessorCount, dev) != hipSuccess) { grid = -1; return; }
        if (hipFuncSetAttribute((const void*)fwd, hipFuncAttributeMaxDynamicSharedMemorySize, LDS_BYTES) != hipSuccess) { fprintf(stderr, "kernel_launch: hipFuncSetAttribute failed\n"); grid = -1; return; }
        if (hipOccupancyMaxActiveBlocksPerMultiprocessor(&per_cu, (const void*)fwd, NWAVES * 64, LDS_BYTES) != hipSuccess || per_cu < 1) fprintf(stderr, "kernel_launch: occupancy query reports %d\n", per_cu);
        (void)hipGetLastError();
        grid = cus;
    }
    if (grid < 0) return;
    if (hipMemsetAsync((char*)d_ws + WS_CTL, 0, CTL_ZERO_BYTES, stream) != hipSuccess) return;
    Args a{};
    for (int i = 0; i < 28; ++i) a.in[i] = (const float*)d_in[i];
    a.out = (float*)d_out; a.ws = (unsigned char*)d_ws;
#if MK_PER_PHASE
    for (int p = 0; p < N_PHASES; ++p) { a.ph_lo = p; a.ph_hi = p + 1; hipLaunchKernelGGL(fwd, dim3(grid), dim3(NWAVES * 64), LDS_BYTES, stream, a); }
#else
    a.ph_lo = 0; a.ph_hi = N_PHASES;
    hipLaunchKernelGGL(fwd, dim3(grid), dim3(NWAVES * 64), LDS_BYTES, stream, a);
#endif
    const hipError_t le = hipPeekAtLastError();
    if (le != hipSuccess) fprintf(stderr, "kernel_launch: launch failed: %s\n", hipGetErrorName(le));
}
```

```cpp
#include <hip/hip_runtime.h>
#include <cstdio>
#include <cstdint>
namespace pg8 {
#define PG8_LAS __attribute__((address_space(3)))
typedef unsigned short bf16_t;
typedef short bf16x8 __attribute__((ext_vector_type(8)));
typedef float f32x4 __attribute__((ext_vector_type(4)));
typedef unsigned u32x4 __attribute__((ext_vector_type(4)));
constexpr int BM = 256, BK = 64, HALF = 128, HTB = HALF * BK * 2  , STAGE_BYTES = 8 * HTB, NXCD = 8, WGM = 8;

__host__ __device__ __forceinline__ int lds_byte(int r, int c) { const int st = (r >> 4) * 2 + (c >> 5), rr = r & 15, cc = c & 31, ob = rr * 64 + cc * 2; return st * 1024 + (ob ^ (((ob >> 9) & 1) << 5)); }
__host__ __device__ __forceinline__ void stage_rc(int b, int& R, int& C) { const int st = b / 1024, sb = b % 1024, swz = sb ^ (((sb >> 9) & 1) << 5); R = (st >> 1) * 16 + swz / 64; C = (st & 1) * 32 + (swz % 64) / 2; }
__host__ __device__ __forceinline__ int perm32(int rho) { const int n = rho >> 4, i = rho & 15; return 8 * (i >> 2) + 4 * n + (i & 3); }

struct Unit { int pm, pn, k0, nt, slice; };
struct Gemm { const bf16_t* A; const bf16_t* Bt; int M, N, K; };

struct StaticOrder {
    int nM, nN, nwg, G, c;
    __host__ __device__ void init(int M, int N, int G_, int c_) { nM = M / BM; nN = N / BM; nwg = nM * nN; G = G_; c = c_; }
    __host__ __device__ bool next(int i, Unit& u) const {
        const long L = (long)i * G + c; if (L >= nwg) return false;
        int wgid = (int)L; { const int q = nwg / NXCD, r = nwg % NXCD, xcd = wgid % NXCD, off = wgid / NXCD; wgid = (xcd < r ? xcd * (q + 1) : r * (q + 1) + (xcd - r) * q) + off; }
        const int nig = WGM * nN, gid = wgid / nig, fm = gid * WGM, gsz = (nM - fm) < WGM ? (nM - fm) : WGM;
        u.pm = fm + ((wgid % nig) % gsz); u.pn = (wgid % nig) / gsz; u.k0 = 0; u.nt = 0; u.slice = -1; return true;
    }
    __device__ __forceinline__ void a_ready(const Unit&) const {}
    __device__ __forceinline__ void done(const Unit&) const {}
};

__device__ __forceinline__ unsigned cvt_pk_bf16(float lo, float hi) { unsigned r; asm volatile("v_cvt_pk_bf16_f32 %0, %1, %2" : "=v"(r) : "v"(lo), "v"(hi)); return r; }
typedef float f32x2 __attribute__((ext_vector_type(2)));
__device__ __forceinline__ f32x2 gelu_pk(f32x2 v) {
    const f32x2 av = __builtin_elementwise_abs(v), d = av * 0.2316418882f + 1.0f;
    f32x2 t; t.x = __builtin_amdgcn_rcpf(d.x); t.y = __builtin_amdgcn_rcpf(d.y);
    f32x2 q = t * 0.5307027145f + (-0.7265760135f); q = q * t + 0.7107068705f; q = q * t + (-0.142248368f); q = q * t + 0.127414796f; q = q * t;
    const f32x2 s = (v * v) * (-0.72134752044f);
    f32x2 e; e.x = __builtin_amdgcn_exp2f(s.x); e.y = __builtin_amdgcn_exp2f(s.y);
    const f32x2 m = v * (q * e), r = v - m;
    f32x2 o; o.x = v.x < 0.f ? m.x : r.x; o.y = v.y < 0.f ? m.y : r.y; return o;
}

template <int ACT  > struct EpiBf16 {
    static constexpr bool PERM = true, AFTER_DRAIN = false; static_assert(ACT == 0 || ACT == 1, "EpiBf16: ACT is 0 (none) or 1 (gelu_pk)");
    bf16_t* O; int ldc; const float* bias; int split_cols; size_t split_stride; float scale0;
    __device__ __forceinline__ void operator()(const f32x4 (&acc)[2][2][4][2], const Unit& u, int wr, int wc, int fr, int fq) const {
        const int row0 = u.pm * BM + wr * 64 + fr; int colt = u.pn * BM; bf16_t* base = O;
        float sc = 1.f; if (split_cols) { const int t = colt / split_cols; base += (size_t)t * split_stride; colt -= t * split_cols; if (t == 0) sc = scale0; }
        const int col0 = colt + wc * 32 + 8 * fq, bcol0 = u.pn * BM + wc * 32 + 8 * fq;
        f32x4 bv[2][2];
#pragma unroll
        for (int bj = 0; bj < 2; ++bj)
#pragma unroll
            for (int n = 0; n < 2; ++n) bv[bj][n] = bias ? *(const f32x4*)(bias + bcol0 + bj * HALF + 4 * n) : (f32x4){0.f, 0.f, 0.f, 0.f};
#pragma unroll
        for (int ai = 0; ai < 2; ++ai)
#pragma unroll
            for (int m = 0; m < 4; ++m) { bf16_t* rowp = base + (size_t)(row0 + ai * HALF + m * 16) * ldc + col0;
#pragma unroll
                for (int bj = 0; bj < 2; ++bj) { f32x4 v0 = acc[ai][bj][m][0] + bv[bj][0], v1 = acc[ai][bj][m][1] + bv[bj][1];
                    if (ACT == 1) { f32x2 a = gelu_pk((f32x2){v0[0], v0[1]}), b = gelu_pk((f32x2){v0[2], v0[3]}), c = gelu_pk((f32x2){v1[0], v1[1]}), d = gelu_pk((f32x2){v1[2], v1[3]});
                        v0 = (f32x4){a.x, a.y, b.x, b.y}; v1 = (f32x4){c.x, c.y, d.x, d.y}; }
                    v0 = v0 * sc; v1 = v1 * sc; u32x4 w; w.x = cvt_pk_bf16(v0[0], v0[1]); w.y = cvt_pk_bf16(v0[2], v0[3]); w.z = cvt_pk_bf16(v1[0], v1[1]); w.w = cvt_pk_bf16(v1[2], v1[3]);
                    *(u32x4*)(rowp + bj * HALF) = w; } }
    }
};
struct EpiRelu2 {
    static constexpr bool PERM = true, AFTER_DRAIN = false;
    bf16_t* O; int ldc;
    __device__ __forceinline__ void operator()(const f32x4 (&acc)[2][2][4][2], const Unit& u, int wr, int wc, int fr, int fq) const {
        const int row0 = u.pm * BM + wr * 64 + fr, col0 = u.pn * BM + wc * 32 + 8 * fq;
#pragma unroll
        for (int ai = 0; ai < 2; ++ai)
#pragma unroll
            for (int m = 0; m < 4; ++m) { bf16_t* rowp = O + (size_t)(row0 + ai * HALF + m * 16) * ldc + col0;
#pragma unroll
                for (int bj = 0; bj < 2; ++bj) { f32x4 v0 = acc[ai][bj][m][0], v1 = acc[ai][bj][m][1];
#pragma unroll
                    for (int e = 0; e < 4; ++e) { const float a = v0[e] > 0.f ? v0[e] : 0.f, b = v1[e] > 0.f ? v1[e] : 0.f; v0[e] = a * a; v1[e] = b * b; }
                    u32x4 w; w.x = cvt_pk_bf16(v0[0], v0[1]); w.y = cvt_pk_bf16(v0[2], v0[3]); w.z = cvt_pk_bf16(v1[0], v1[1]); w.w = cvt_pk_bf16(v1[2], v1[3]);
                    *(u32x4*)(rowp + bj * HALF) = w; } }
    }
};
struct EpiResid {
    static constexpr bool PERM = false, AFTER_DRAIN = false;
    const float* src_lat; const float* src_ctx; float* dst_lat; float* dst_ctx; const float* gate; float* slab;
    __device__ __forceinline__ void operator()(const f32x4 (&acc)[2][2][4][2], const Unit& u, int wr, int wc, int fr, int fq) const {
        if (u.slice >= 0) {
            float* sl = slab + ((size_t)u.slice * 512 + (size_t)(u.pm / 17) * 256) * 2048; const int r0s = wr * 64 + fr, c0s = u.pn * BM + wc * 32 + 4 * fq;
#pragma unroll
            for (int ai = 0; ai < 2; ++ai)
#pragma unroll
                for (int m = 0; m < 4; ++m) { float* rp = sl + (size_t)(r0s + ai * HALF + m * 16) * 2048 + c0s;
#pragma unroll
                    for (int bj = 0; bj < 2; ++bj)
#pragma unroll
                        for (int n = 0; n < 2; ++n) *(f32x4*)(rp + bj * HALF + n * 16) = acc[ai][bj][m][n]; }
            return;
        }
        const int b = u.pm / 17, j = u.pm % 17; const bool isctx = (j == 0);
        const float* src = isctx ? src_ctx + (size_t)b * 256 * 2048 : src_lat + ((size_t)b * 4096 + (size_t)(j - 1) * 256) * 2048;
        float* dst = isctx ? dst_ctx + (size_t)b * 256 * 2048 : dst_lat + ((size_t)b * 4096 + (size_t)(j - 1) * 256) * 2048;
        const float* g = gate + (isctx ? 2 : b) * 12288;
        const int r0 = wr * 64 + fr, col0 = u.pn * BM + wc * 32 + 4 * fq;
        f32x4 gv[2][2];
#pragma unroll
        for (int bj = 0; bj < 2; ++bj)
#pragma unroll
            for (int n = 0; n < 2; ++n) gv[bj][n] = *(const f32x4*)(g + col0 + bj * HALF + n * 16);
#pragma unroll
        for (int ai = 0; ai < 2; ++ai)
#pragma unroll
            for (int m = 0; m < 4; ++m) { const size_t roff = (size_t)(r0 + ai * HALF + m * 16) * 2048 + col0;
#pragma unroll
                for (int bj = 0; bj < 2; ++bj)
#pragma unroll
                    for (int n = 0; n < 2; ++n) { const f32x4 s = *(const f32x4*)(src + roff + bj * HALF + n * 16); *(f32x4*)(dst + roff + bj * HALF + n * 16) = s + gv[bj][n] * acc[ai][bj][m][n]; } }
    }
};
struct EpiLora {
    static constexpr bool PERM = true, AFTER_DRAIN = false;
    _Float16* oute; bf16_t* outa; const float* w0; const float* a0;
    __device__ __forceinline__ void operator()(const f32x4 (&acc)[2][2][4][2], const Unit& u, int wr, int wc, int fr, int fq) const {
        const int p = u.pn >> 2, rt = u.pm - 34 * p, ct = u.pn & 3;
        const int row0 = rt * BM + wr * 64 + fr, col0 = ct * BM + wc * 32 + 8 * fq;
        const float* bias = p < 2 ? w0 + p * 1024 : a0 + (p & 1) * 1024;
        f32x4 bv[2][2];
#pragma unroll
        for (int bj = 0; bj < 2; ++bj)
#pragma unroll
            for (int n = 0; n < 2; ++n) bv[bj][n] = p < 4 ? *(const f32x4*)(bias + col0 + bj * HALF + 4 * n) : (f32x4){0.f, 0.f, 0.f, 0.f};
        typedef _Float16 h16x8 __attribute__((ext_vector_type(8)));
#pragma unroll
        for (int ai = 0; ai < 2; ++ai)
#pragma unroll
            for (int m = 0; m < 4; ++m) { const size_t ro = (size_t)(row0 + ai * HALF + m * 16) * 1024 + col0;
#pragma unroll
                for (int bj = 0; bj < 2; ++bj) { f32x4 x0 = acc[ai][bj][m][0] + bv[bj][0], x1 = acc[ai][bj][m][1] + bv[bj][1];
                    if (p < 4) {
#pragma unroll
                        for (int q = 0; q < 4; ++q) { x0[q] = __builtin_amdgcn_rcpf(1.0f + __expf(-x0[q])); x1[q] = __builtin_amdgcn_rcpf(1.0f + __expf(-x1[q])); } }
                    if (p < 2) { const float c = 0.60653065971263342f;
                        *(h16x8*)(oute + (size_t)p * 8704 * 1024 + ro + bj * HALF) = (h16x8){(_Float16)(c * x0[0]), (_Float16)(c * x0[1]), (_Float16)(c * x0[2]), (_Float16)(c * x0[3]), (_Float16)(c * x1[0]), (_Float16)(c * x1[1]), (_Float16)(c * x1[2]), (_Float16)(c * x1[3])};
                    } else *(u32x4*)(outa + (size_t)(p - 2) * 8704 * 1024 + ro + bj * HALF) = (u32x4){cvt_pk_bf16(x0[0], x0[1]), cvt_pk_bf16(x0[2], x0[3]), cvt_pk_bf16(x1[0], x1[1]), cvt_pk_bf16(x1[2], x1[3])};
                } }
    }
};
struct RowMapOrder : StaticOrder {
    int skip, S, ntS, nLat, nNn;
    __device__ void init2(int N, int K, int G_, int c_, int skip_, int S_) { skip = skip_; S = S_; ntS = K / 64 / S_; nNn = N / BM; nLat = 32 * nNn; init(8192, N, G_, c_); }
    __device__ bool next(int i, Unit& u) const {
        const long L = (long)i * G + c;
        if (L < nLat) { StaticOrder::next(i, u); u.pm = u.pm + 1 + (u.pm >> 4); return true; }
        if (skip) return false;
        const int j = (int)(L - nLat); if (j >= 2 * nNn * S) return false;
        const int sl = j % S, cu = j / S; u.pm = 17 * (cu & 1); u.pn = cu >> 1;
        if (S > 1) { u.k0 = sl * ntS * 64; u.nt = ntS; u.slice = sl; } else { u.k0 = 0; u.nt = 0; u.slice = -1; }
        return true;
    }
};
struct LoraOrder {
    int G, c;
    __device__ bool next(int i, Unit& u) const { const int L = i * G + c; if (L >= 680) return false; const int p = L / 136, rem = L % 136; u.pm = 34 * p + rem % 34; u.pn = 4 * p + rem / 34; u.k0 = 0; u.nt = p < 4 ? 2 : 0; u.slice = -1; return true; }
    __device__ __forceinline__ void a_ready(const Unit&) const {}
    __device__ __forceinline__ void done(const Unit&) const {}
};
template <class Epi, class Sched, bool ALIGN_EPI = false, bool SP2 = false>
__device__ __forceinline__ void gemm_phase(PG8_LAS unsigned char* lds, const Gemm g, const Sched& S, const Epi& E, int tid_in) {
    int tid_ = tid_in; asm volatile("" : "+v"(tid_));
    const int tid = tid_, wid = __builtin_amdgcn_readfirstlane(tid >> 6), lane = tid & 63, wr = wid >> 2, wc = wid & 3, fr = lane & 15, fq = lane >> 4;
    const int K = g.K;
    unsigned voffA[2], voffB[2];
#pragma unroll
    for (int i = 0; i < 2; ++i) { int R, C; stage_rc(tid * 16 + i * 8192, R, C); const int Rb = Epi::PERM ? ((R & ~31) + perm32(R & 31)) : R;
        voffA[i] = (unsigned)(R * K + C) * 2u; voffB[i] = (unsigned)(Rb * K + C) * 2u; }
    const size_t kstep = (size_t)(BK * 2);
    const size_t hstep = (size_t)HALF * K * 2;
    const size_t tstep = 2 * hstep;
    const unsigned ldsw = (unsigned)wid * 1024u;
    const int aoff = lds_byte(wr * 64 + fr, fq * 8), boff = lds_byte(wc * 32 + fr, fq * 8);
#define PG8_SA(b, h) (((b) * 2 + (h)) * HTB)
#define PG8_SB(b, h) ((4 + (b) * 2 + (h)) * HTB)
#define PG8_STAGE(bufoff, gbase, voff) do { _Pragma("unroll") for (int _i = 0; _i < 2; ++_i) \
        __builtin_amdgcn_global_load_lds((const unsigned*)((const char*)(gbase) + (voff)[_i]), (PG8_LAS unsigned*)(lds + (bufoff) + ldsw + _i * 8192), 16, 0, 0); } while (0)
#define PG8_LDA(dst, b, h) do { _Pragma("unroll") for (int m = 0; m < 4; ++m) _Pragma("unroll") for (int k = 0; k < 2; ++k) dst[m][k] = *(const PG8_LAS bf16x8*)(lds + PG8_SA(b, h) + aoff + m * 2048 + k * 1024); } while (0)
#define PG8_LDB(dst, b, h) do { _Pragma("unroll") for (int n = 0; n < 2; ++n) _Pragma("unroll") for (int k = 0; k < 2; ++k) dst[n][k] = *(const PG8_LAS bf16x8*)(lds + PG8_SB(b, h) + boff + n * 2048 + k * 1024); } while (0)
#define PG8_MMA(ai, bj, At, Bt) do { __builtin_amdgcn_s_setprio(1); _Pragma("unroll") for (int m = 0; m < 4; ++m) _Pragma("unroll") for (int n = 0; n < 2; ++n) _Pragma("unroll") for (int k = 0; k < 2; ++k) \
        acc[ai][bj][m][n] = __builtin_amdgcn_mfma_f32_16x16x32_bf16(Bt[n][k], At[m][k], acc[ai][bj][m][n], 0, 0, 0); __builtin_amdgcn_s_setprio(0); } while (0)
#define PG8_WAIT_V(n) asm volatile("s_waitcnt vmcnt(" #n ")" ::: "memory")
#define PG8_WAIT_L(n) asm volatile("s_waitcnt lgkmcnt(" #n ")" ::: "memory")
#define PG8_BAR __builtin_amdgcn_s_barrier()
#define PG8_SCHED __builtin_amdgcn_sched_barrier(0)
    Unit cur, nxt; int ui = 0;
    if (!S.next(0, cur)) return;
    f32x4 acc[2][2][4][2];
#pragma unroll
    for (int a = 0; a < 2; ++a)
#pragma unroll
        for (int b = 0; b < 2; ++b)
#pragma unroll
            for (int m = 0; m < 4; ++m)
#pragma unroll
                for (int n = 0; n < 2; ++n) acc[a][b][m][n] = (f32x4){0.f, 0.f, 0.f, 0.f};
    bf16x8 At[4][2], B0[2][2], B1[2][2];
    const char* cA = (const char*)g.A + (size_t)cur.pm * tstep + (size_t)cur.k0 * 2; const char* cB = (const char*)g.Bt + (size_t)cur.pn * tstep + (size_t)cur.k0 * 2;
    int nt = cur.nt > 0 ? cur.nt : K / BK;
    S.a_ready(cur);
    if constexpr (SP2) {
        PG8_STAGE(PG8_SB(0, 0), cB, voffB); PG8_STAGE(PG8_SB(0, 1), cB + hstep, voffB); PG8_STAGE(PG8_SA(0, 0), cA, voffA); PG8_STAGE(PG8_SA(0, 1), cA + hstep, voffA);
        if (wr == 1) PG8_BAR;
        PG8_WAIT_V(2); PG8_BAR;
        PG8_STAGE(PG8_SB(1, 0), cB + kstep, voffB); PG8_STAGE(PG8_SA(1, 0), cA + kstep, voffA); PG8_STAGE(PG8_SB(1, 1), cB + hstep + kstep, voffB);
        PG8_WAIT_V(6); PG8_BAR;
    } else {
        PG8_STAGE(PG8_SB(0, 0), cB, voffB); PG8_STAGE(PG8_SA(0, 0), cA, voffA); PG8_STAGE(PG8_SB(0, 1), cB + hstep, voffB); PG8_STAGE(PG8_SA(0, 1), cA + hstep, voffA);
        if (wr == 1) PG8_BAR;
        PG8_WAIT_V(4); PG8_BAR;
        PG8_STAGE(PG8_SB(1, 0), cB + kstep, voffB); PG8_STAGE(PG8_SA(1, 0), cA + kstep, voffA); PG8_STAGE(PG8_SB(1, 1), cB + hstep + kstep, voffB);
        PG8_WAIT_V(6); PG8_BAR;
    }
    for (;;) {
        const bool has_next = S.next(ui + 1, nxt);
        const char* nA = has_next ? (const char*)g.A + (size_t)nxt.pm * tstep + (size_t)nxt.k0 * 2 : cA; const char* nB = has_next ? (const char*)g.Bt + (size_t)nxt.pn * tstep + (size_t)nxt.k0 * 2 : cB;
#pragma unroll 1
        for (int t = 0; t < nt; t += 2) {
            const bool last = (t == nt - 2);
            const char* a1 = cA + (size_t)(t + 1) * kstep;
            const char* a2 = last ? nA : cA + (size_t)(t + 2) * kstep; const char* b2 = last ? nB : cB + (size_t)(t + 2) * kstep;
            const char* a3 = a2 + kstep; const char* b3 = b2 + kstep;
            if (last && has_next) S.a_ready(nxt);
            if constexpr (SP2) {
            PG8_LDB(B0, 0, 0); PG8_LDB(B1, 0, 1); PG8_SCHED; PG8_LDA(At, 0, 0); PG8_STAGE(PG8_SA(1, 1), a1 + hstep, voffA);
            PG8_WAIT_V(8); PG8_WAIT_L(0); PG8_BAR; PG8_MMA(0, 0, At, B0); PG8_MMA(0, 1, At, B1); PG8_BAR; PG8_SCHED;
            PG8_LDA(At, 0, 1); PG8_STAGE(PG8_SB(0, 0), b2, voffB); PG8_STAGE(PG8_SB(0, 1), b2 + hstep, voffB); PG8_STAGE(PG8_SA(0, 0), a2, voffA);
            PG8_WAIT_V(8); PG8_WAIT_L(0); PG8_BAR; PG8_MMA(1, 0, At, B0); PG8_MMA(1, 1, At, B1); PG8_BAR; PG8_SCHED;
            PG8_LDB(B0, 1, 0); PG8_LDB(B1, 1, 1); PG8_SCHED; PG8_LDA(At, 1, 0); PG8_STAGE(PG8_SA(0, 1), a2 + hstep, voffA);
            PG8_WAIT_V(8); PG8_WAIT_L(0); PG8_BAR; PG8_MMA(0, 0, At, B0); PG8_MMA(0, 1, At, B1); PG8_BAR; PG8_SCHED;
            PG8_LDA(At, 1, 1); PG8_STAGE(PG8_SB(1, 0), b3, voffB); PG8_STAGE(PG8_SB(1, 1), b3 + hstep, voffB); PG8_STAGE(PG8_SA(1, 0), a3, voffA);
            PG8_WAIT_V(8); PG8_WAIT_L(0); PG8_BAR; PG8_MMA(1, 0, At, B0); PG8_MMA(1, 1, At, B1); PG8_BAR; PG8_SCHED;
            } else {
            PG8_LDB(B0, 0, 0); PG8_SCHED; PG8_LDA(At, 0, 0); PG8_STAGE(PG8_SA(1, 1), a1 + hstep, voffA);
            PG8_WAIT_L(8); PG8_BAR; PG8_WAIT_L(0); PG8_MMA(0, 0, At, B0); PG8_BAR; PG8_SCHED;
            PG8_LDB(B1, 0, 1); PG8_STAGE(PG8_SB(0, 0), b2, voffB);
            PG8_BAR; PG8_WAIT_L(0); PG8_MMA(0, 1, At, B1); PG8_BAR;
            PG8_LDA(At, 0, 1); PG8_STAGE(PG8_SA(0, 0), a2, voffA);
            PG8_BAR; PG8_WAIT_L(0); PG8_MMA(1, 0, At, B0); PG8_BAR; PG8_SCHED;
            PG8_STAGE(PG8_SB(0, 1), b2 + hstep, voffB);
            PG8_WAIT_V(6); PG8_BAR; PG8_MMA(1, 1, At, B1); PG8_BAR;
            PG8_LDB(B0, 1, 0); PG8_SCHED; PG8_LDA(At, 1, 0); PG8_STAGE(PG8_SA(0, 1), a2 + hstep, voffA);
            PG8_WAIT_L(8); PG8_BAR; PG8_WAIT_L(0); PG8_MMA(0, 0, At, B0); PG8_BAR; PG8_SCHED;
            PG8_LDB(B1, 1, 1); PG8_STAGE(PG8_SB(1, 0), b3, voffB);
            PG8_BAR; PG8_WAIT_L(0); PG8_MMA(0, 1, At, B1); PG8_BAR;
            PG8_LDA(At, 1, 1); PG8_STAGE(PG8_SA(1, 0), a3, voffA);
            PG8_BAR; PG8_WAIT_L(0); PG8_MMA(1, 0, At, B0); PG8_BAR; PG8_SCHED;
            PG8_STAGE(PG8_SB(1, 1), b3 + hstep, voffB);
            PG8_WAIT_V(6); PG8_BAR; PG8_MMA(1, 1, At, B1); PG8_BAR;
            }
        }
        if constexpr (ALIGN_EPI) { if (wr == 0) PG8_BAR; }
        if constexpr (!Epi::AFTER_DRAIN) { E(acc, cur, wr, wc, fr, fq); S.done(cur); }
        if (!has_next) break;
#pragma unroll
        for (int a = 0; a < 2; ++a)
#pragma unroll
            for (int b = 0; b < 2; ++b)
#pragma unroll
                for (int m = 0; m < 4; ++m)
#pragma unroll
                    for (int n = 0; n < 2; ++n) acc[a][b][m][n] = (f32x4){0.f, 0.f, 0.f, 0.f};
        cur = nxt; cA = nA; cB = nB; ++ui; nt = cur.nt > 0 ? cur.nt : K / BK;
        if constexpr (ALIGN_EPI) { if (wr == 1) PG8_BAR; }
    }
    PG8_WAIT_V(0);
    if constexpr (!ALIGN_EPI) { if (wr == 0) PG8_BAR; }
    PG8_BAR;
    if constexpr (Epi::AFTER_DRAIN) { E.fused(acc, cur, wr, wc, fr, fq, lds, wid, lane); S.done(cur); }
#undef PG8_SA
#undef PG8_SB
#undef PG8_STAGE
#undef PG8_LDA
#undef PG8_LDB
#undef PG8_MMA
#undef PG8_WAIT_V
#undef PG8_WAIT_L
#undef PG8_BAR
#undef PG8_SCHED
}
}
constexpr int NWAVES = 8;
constexpr int D = 2048, NB = 2, T = 4096, CT = 256, SU = T + CT  , M = NB * SU  , DEPTH = 4;
constexpr int NIN = 5248, NINP = 5376, BIN = 3712, FF = 8192, BW = 1024;
constexpr int PA_Q = 0, PA_K = 512, PA_V = 640, PB0 = 768, PC_Q = 4480, PC_K = 4992, PC_V = 5120;
constexpr int MODW = 6 * D;
#ifndef MK_PER_PHASE
#define MK_PER_PHASE 0
#endif
constexpr int PPL = 11, N_PHASES = 2 + PPL * DEPTH;
constexpr size_t MiB = 1u << 20;
constexpr size_t WS_CTL = 0, CTL_ZERO_BYTES = 32 * 1024;
constexpr size_t WS_MOD = 1 * MiB;
constexpr size_t WS_MODP = 2 * MiB;
constexpr size_t WS_ROPE = 10 * MiB;
constexpr size_t WS_WIN = 11 * MiB;
constexpr size_t WS_WOUT = WS_WIN + 84 * MiB;
constexpr size_t WS_W1 = WS_WOUT + 32 * MiB;
constexpr size_t WS_W2 = WS_W1 + 128 * MiB;
constexpr size_t WS_LW = WS_W2 + 128 * MiB;
constexpr size_t WS_HCTX = WS_LW + 10 * MiB;
constexpr size_t WS_U = WS_HCTX + 4 * MiB;
constexpr size_t WS_P = WS_U + 34 * MiB;
constexpr size_t WS_QA = WS_P + 90 * MiB;
constexpr size_t WS_KA = WS_QA + 9 * MiB;
constexpr size_t WS_QC = WS_KA + 3 * MiB;
constexpr size_t WS_KC = WS_QC + 9 * MiB;
constexpr size_t WS_LA = WS_KC + 3 * MiB;
constexpr size_t WS_MIX = WS_LA + 22 * MiB;
constexpr size_t WS_Y = WS_MIX + 34 * MiB;
constexpr size_t WS_LO = WS_Y + 68 * MiB;
constexpr size_t WS_AG = WS_LO + 68 * MiB;
constexpr size_t WS_STR = WS_LO + 170 * MiB;
constexpr size_t WS_RW = WS_STR + 136 * MiB;
constexpr size_t WS_SL = WS_RW + 204 * MiB;
constexpr size_t WS_END = WS_SL + 32 * MiB;
constexpr size_t WS_HID = WS_LO;
static_assert(WS_HID + (size_t)M * FF * 2 <= WS_RW, "hidden overlay");
constexpr int CW_TMO = 0, CW_BAR = 4096;
constexpr int RING_BYTES = 131072, LDSCTL_OFF = RING_BYTES, MISC_OFF = LDSCTL_OFF + 320, LDS_BYTES = 147456;

#define GAS __attribute__((address_space(1)))
#define LAS __attribute__((address_space(3)))
typedef unsigned short bf16;
typedef unsigned v4u __attribute__((ext_vector_type(4)));
typedef unsigned v2u __attribute__((ext_vector_type(2)));
typedef float f32x4 __attribute__((ext_vector_type(4)));
typedef GAS unsigned gu32;
#define RLX_AGENT __ATOMIC_RELAXED, __HIP_MEMORY_SCOPE_AGENT
#define LDS_WAIT() asm volatile("s_waitcnt lgkmcnt(0)" ::: "memory")
__device__ __forceinline__ unsigned f2bf(float f) { unsigned u = __builtin_bit_cast(unsigned, f); return (u + 0x7fffu + ((u >> 16) & 1u)) >> 16; }
__device__ __forceinline__ unsigned pk2(float lo, float hi) { return f2bf(lo) | (f2bf(hi) << 16); }
__device__ __forceinline__ float bf2f(bf16 x) { return __builtin_bit_cast(float, (unsigned)x << 16); }
struct Args { const float* in[28]; float* out; unsigned char* ws; int ph_lo, ph_hi; };
__device__ __forceinline__ int hw_lane() { int l_; asm volatile("v_mbcnt_lo_u32_b32 %0, -1, 0\n\tv_mbcnt_hi_u32_b32 %0, -1, %0" : "=&v"(l_)); return l_; }
#ifndef PROBE_PHASE
#define PROBE_PHASE -1
#endif
#define PB_BEGIN(j) const unsigned long long pt0_ = (PROBE_PHASE == (j)) ? __builtin_amdgcn_s_memrealtime() : 0ull
#define PB_END(j) do { if (PROBE_PHASE == (j)) { const unsigned long long d_ = __builtin_amdgcn_s_memrealtime() - pt0_, e_ = __builtin_amdgcn_s_memrealtime() + d_; while (__builtin_amdgcn_s_memrealtime() < e_) __builtin_amdgcn_s_sleep(8); } } while (0)
#define PBS(j) const unsigned long long ptq##j##_ = (PROBE_PHASE == (j)) ? __builtin_amdgcn_s_memrealtime() : 0ull
#define PBE(j) do { if (PROBE_PHASE == (j)) { const unsigned long long d_ = __builtin_amdgcn_s_memrealtime() - ptq##j##_, e_ = __builtin_amdgcn_s_memrealtime() + d_; while (__builtin_amdgcn_s_memrealtime() < e_) __builtin_amdgcn_s_sleep(8); } } while (0)
#include <hip/hip_bf16.h>
#include <cmath>
namespace attn_body {
using bf16=__hip_bfloat16;
using bf16x8=__attribute__((ext_vector_type(8)))short;
using s16x4=__attribute__((ext_vector_type(4)))short;
using f32x16=__attribute__((ext_vector_type(16)))float;
using u32x4=__attribute__((ext_vector_type(4)))unsigned;
constexpr int D=64,QP=512,KP=128,VP=5376,OP=2048;
constexpr int NW=8,QBLK=32,QB=QBLK*NW,KVBLK=64;
__device__ __forceinline__ int crow(int r,int hi){return (r&3)+8*(r>>2)+4*hi;}
#define SBAR() __builtin_amdgcn_sched_barrier(0)
#define ZC16 ((f32x16){0.f,0.f,0.f,0.f,0.f,0.f,0.f,0.f,0.f,0.f,0.f,0.f,0.f,0.f,0.f,0.f})
__device__ __forceinline__ void wmask(f32x16&p0,f32x16&p1,int kpos,int qpos,int hi){
  const float NEG=-INFINITY; const int kb=kpos+4*hi-qpos;
  #pragma unroll
  for(int r=0;r<16;++r){const int d=kb+(r&3)+8*(r>>2); if(d>128||d<-128)p0[r]=NEG; if(d+32>128||d+32<-128)p1[r]=NEG;}
}

constexpr int NSLOT=3, SLOTB=8192;
constexpr int LDS_K=0, LDS_V=NSLOT*SLOTB, LDS_WS=2*NSLOT*SLOTB, LDS_OST=LDS_WS+NW*64*4, LDS_BYTES=LDS_OST+NW*4096;
constexpr float C2=0.125f*1.4426950408889634f;
__device__ __forceinline__ void glds16(const void*gsrc,unsigned lds_dst){unsigned keep;
  asm volatile("s_mov_b32 %0, m0\n\ts_mov_b32 m0, %2\n\ts_nop 0\n\tglobal_load_lds_dwordx4 %1, off\n\ts_mov_b32 m0, %0":"=&s"(keep):"v"(gsrc),"s"(lds_dst):"memory");}
__device__ __forceinline__ float max3f(float a,float b,float c){float r;asm("v_max3_f32 %0, %1, %2, %3":"=v"(r):"v"(a),"v"(b),"v"(c));return r;}
__device__ __forceinline__ float max2f(float a,float b){float r;asm("v_max_f32_e32 %0, %1, %2":"=v"(r):"v"(a),"v"(b));return r;}
__device__ __forceinline__ float fadd_s(float a,float b){float r;asm("v_add_f32_e32 %0, %1, %2":"=v"(r):"v"(a),"v"(b));return r;}
__device__ __forceinline__ float fsub_s(float a,float b){float r;asm("v_sub_f32_e32 %0, %1, %2":"=v"(r):"v"(a),"v"(b));return r;}
typedef float f32x2_t __attribute__((ext_vector_type(2))); typedef __bf16 bf16x2_t __attribute__((ext_vector_type(2)));
__device__ __forceinline__ unsigned cvtpk_s(float lo,float hi){f32x2_t v={lo,hi};bf16x2_t b=__builtin_convertvector(v,bf16x2_t);return __builtin_bit_cast(unsigned,b);}
#define WAIT_BAR(N) asm volatile("s_waitcnt vmcnt(" #N ") lgkmcnt(0)\n\ts_barrier":::"memory")

__device__ __forceinline__ void qkt(f32x16&p0,f32x16&p1,const char*Kslot,const bf16x8*qr,const f32x16&negm,int r32,int hi){
  const char*kb=Kslot+hi*1024+r32*16;
  #pragma unroll
  for(int d0=0;d0<4;++d0){
    const bf16x8 b0=*reinterpret_cast<const bf16x8*>(kb+d0*2048);
    const bf16x8 b1=*reinterpret_cast<const bf16x8*>(kb+d0*2048+512);
    if(d0==0){p0=__builtin_amdgcn_mfma_f32_32x32x16_bf16(b0,qr[0],negm,0,0,0);p1=__builtin_amdgcn_mfma_f32_32x32x16_bf16(b1,qr[0],negm,0,0,0);}
    else{p0=__builtin_amdgcn_mfma_f32_32x32x16_bf16(b0,qr[d0],p0,0,0,0);p1=__builtin_amdgcn_mfma_f32_32x32x16_bf16(b1,qr[d0],p1,0,0,0);}}
}
typedef __attribute__((address_space(3))) const char* lds_cptr;
typedef short v4i16_t __attribute__((ext_vector_type(4)));
__device__ __forceinline__ void kload8(bf16x8*kf,lds_cptr kp){
  kf[0]=*(const __attribute__((address_space(3))) bf16x8*)(kp);      kf[1]=*(const __attribute__((address_space(3))) bf16x8*)(kp+512);
  kf[2]=*(const __attribute__((address_space(3))) bf16x8*)(kp+2048); kf[3]=*(const __attribute__((address_space(3))) bf16x8*)(kp+2560);
  kf[4]=*(const __attribute__((address_space(3))) bf16x8*)(kp+4096); kf[5]=*(const __attribute__((address_space(3))) bf16x8*)(kp+4608);
  kf[6]=*(const __attribute__((address_space(3))) bf16x8*)(kp+6144); kf[7]=*(const __attribute__((address_space(3))) bf16x8*)(kp+6656);
}
__device__ __forceinline__ void kload2(bf16x8*kf,lds_cptr kp,int j){ kf[2*j]=*(const __attribute__((address_space(3))) bf16x8*)(kp+j*2048); kf[2*j+1]=*(const __attribute__((address_space(3))) bf16x8*)(kp+j*2048+512); }
__device__ __forceinline__ s16x4 vtr(lds_cptr p){ return __builtin_bit_cast(s16x4,__builtin_amdgcn_ds_read_tr16_b64_v4i16((__attribute__((address_space(3))) v4i16_t*)p)); }
__device__ __forceinline__ float rowmax(const f32x16&p0,const f32x16&p1){
  float a=max3f(p0[0],p0[1],p1[0]),b=max3f(p0[2],p0[3],p1[1]);a=max3f(a,p1[2],p1[3]);
  #pragma unroll
  for(int r=4;r<16;r+=4){a=max3f(a,p0[r],p0[r+1]);b=max3f(b,p0[r+2],p0[r+3]);a=max3f(a,p1[r],p1[r+1]);b=max3f(b,p1[r+2],p1[r+3]);}
  const float m=max2f(a,b);
  auto rr=__builtin_amdgcn_permlane32_swap(__float_as_uint(m),__float_as_uint(m),false,false);
  return max2f(__uint_as_float(rr[0]),__uint_as_float(rr[1]));
}
__device__ __forceinline__ void pv(f32x16*o,int vb,bf16x8 pa0,bf16x8 pa1,bf16x8 pa2,bf16x8 pa3){
  #pragma unroll
  for(int d0=0;d0<2;++d0){s16x4 lo[4],hi[4];
    #pragma unroll
    for(int ks=0;ks<4;++ks){
      asm volatile("ds_read_b64_tr_b16 %0,%1 offset:%c2":"=&v"(lo[ks]):"v"(vb),"i"(d0*4096+ks*1024):"memory");
      asm volatile("ds_read_b64_tr_b16 %0,%1 offset:%c2":"=&v"(hi[ks]):"v"(vb),"i"(d0*4096+ks*1024+512):"memory");}
    asm volatile("s_waitcnt lgkmcnt(0)":::"memory");SBAR();
    #define PK(k) (bf16x8){lo[k][0],lo[k][1],lo[k][2],lo[k][3],hi[k][0],hi[k][1],hi[k][2],hi[k][3]}
    o[d0]=__builtin_amdgcn_mfma_f32_32x32x16_bf16(pa0,PK(0),o[d0],0,0,0);
    o[d0]=__builtin_amdgcn_mfma_f32_32x32x16_bf16(pa1,PK(1),o[d0],0,0,0);
    o[d0]=__builtin_amdgcn_mfma_f32_32x32x16_bf16(pa2,PK(2),o[d0],0,0,0);
    o[d0]=__builtin_amdgcn_mfma_f32_32x32x16_bf16(pa3,PK(3),o[d0],0,0,0);
    #undef PK
  }
}

#ifndef ATTN_STORE16
#define ATTN_STORE16(p,v) (*(u32x4*)(p)=(v))
#endif
struct AttnJob { const bf16* Qw0; const bf16* Kh; const bf16* Vh; unsigned o_off; int NT, lat_lo, qpos0, sidx; };
template<int MODE,int THRL> __device__ __forceinline__ void attn_unit(const AttnJob&J,const Args&A,char*shm,int wv){
  int tid_=wv*64+hw_lane(); asm volatile("":"+v"(tid_));
  const int tid=tid_,lane=tid&63,r32=lane&31,hi=lane>>5; const int wid=__builtin_amdgcn_readfirstlane(tid>>6);
  const int lat_lo=J.lat_lo;
  const bf16*Qw=J.Qw0+(long)(wid*QBLK)*QP;
  const bf16*Kh=J.Kh,*Vh=J.Vh;
  const unsigned lds0=(unsigned)(uintptr_t)shm;
  float*wsf=(float*)(shm+LDS_WS)+wid*64;
  const bf16*ksrc=Kh+(long)lane*KP+wid*8;
  const bf16*vsrc=Vh+(long)(16*(wid&3)+(lane>>2))*VP+(wid>>2)*32+(lane&3)*8;
  const unsigned kdst=lds0+LDS_K+wid*1024, vdst=lds0+LDS_V+wid*1024;
  #define TROW(t) ((long)KVBLK*((t)+(((t)>=4)?lat_lo:0)))
  #define DMA_K(t,slot) glds16(ksrc+TROW(t)*KP,(unsigned)__builtin_amdgcn_readfirstlane(kdst+(slot)))
  #define DMA_V(t,slot) glds16(vsrc+TROW(t)*VP,(unsigned)__builtin_amdgcn_readfirstlane(vdst+(slot)))
  const int vb0=(int)(lds0+LDS_V)+((lane>>4)&1)*32+(lane&3)*8+(4*hi+((lane&15)>>2))*64;
  const char*Kbase=shm+LDS_K; bf16x8 kf[8];
  const lds_cptr shm3=(lds_cptr)shm; const lds_cptr kp0=shm3+LDS_K+hi*1024+r32*16; const lds_cptr vp0=shm3+LDS_V+((lane>>4)&1)*32+(lane&3)*8+(4*hi+((lane&15)>>2))*64;
  const int NT=J.NT;
  DMA_K(0,0);DMA_V(0,0);DMA_K(1,SLOTB);
  bf16x8 qr[4];
  #pragma unroll
  for(int d0=0;d0<4;++d0)qr[d0]=*reinterpret_cast<const bf16x8*>(&Qw[(long)r32*QP+d0*16+hi*8]);
  float mhat=0.f,l_reg=0.f;f32x16 o[2],negm;
  #pragma unroll
  for(int r=0;r<16;++r){float z0,z1,z2;asm volatile("v_mov_b32 %0, 0\n\tv_mov_b32 %1, 0\n\tv_mov_b32 %2, 0":"=v"(z0),"=v"(z1),"=v"(z2));o[0][r]=z0;o[1][r]=z1;negm[r]=z2;}
  asm volatile("":"+v"(negm));
  const int qpos=J.qpos0+wid*QBLK+r32;
  #define CMASK(P0,P1,t) do{ if(MODE==1&&(t)>=4)wmask(P0,P1,KVBLK*(lat_lo+(t)-4),qpos,hi); }while(0)
  bool resc=false;
  #define START(P0,P1) do{ const float rm=rowmax(P0,P1); resc=false; \
    { const float dl=rm; mhat=fadd_s(mhat,dl); \
      _Pragma("unroll") for(int r=0;r<16;++r){P0[r]=fsub_s(P0[r],dl);P1[r]=fsub_s(P1[r],dl);} \
      _Pragma("unroll") for(int r=0;r<16;++r)negm[r]=-mhat; asm volatile("":"+v"(negm)); } \
    _Pragma("unroll") for(int r=0;r<16;++r)P0[r]=__builtin_amdgcn_exp2f(P0[r]); }while(0)
  #define RESC() do{ if(resc){ asm volatile("s_waitcnt lgkmcnt(0)":::"memory"); \
      _Pragma("unroll") for(int d_=0;d_<2;++d_) _Pragma("unroll") for(int r=0;r<16;++r)o[d_][r]*=wsf[crow(r,hi)]; } }while(0)
  f32x16 pA0,pA1,pB0,pB1;
  int sl_prev=0,sl_cur=0,sl_next=SLOTB;
  #define ROT() do{sl_prev=sl_cur;sl_cur=sl_next;sl_next=(sl_next==(NSLOT-1)*SLOTB)?0:sl_next+SLOTB;}while(0)
  DMA_K(2,2*SLOTB);
  WAIT_BAR(3);
  qkt(pA0,pA1,Kbase,qr,negm,r32,hi);asm volatile("s_nop 15\n\ts_nop 7":"+v"(pA0),"+v"(pA1));CMASK(pA0,pA1,0);
  START(pA0,pA1);
  _Pragma("unroll") for(int r=0;r<16;++r)pA1[r]=__builtin_amdgcn_exp2f(pA1[r]);
  WAIT_BAR(0);
  DMA_K(3,0);DMA_V(1,SLOTB);
  ROT();
  kload8(kf,kp0+sl_cur);
  WAIT_BAR(2);
  s16x4 vlo[8],vhi[8]; u32x4 pw0,pw1,pw2,pw3;
  #define PKW(P,B) cvtpk_s(P[B],P[B+1])
  #define PAF(k) __builtin_bit_cast(bf16x8,pw##k)
  #define VFR(i) (bf16x8){vlo[i][0],vlo[i][1],vlo[i][2],vlo[i][3],vhi[i][0],vhi[i][1],vhi[i][2],vhi[i][3]}
  #define PIN(x) asm volatile("":"+v"(x))
  #define MX3(a,b,c) __builtin_fmaxf(__builtin_fmaxf((a),(b)),(c))
  #define GAPA(MF,A0,A1,A2,A3,W0,W1,PW) do{ MF; sacc+=A0; sacc+=A1; sacc+=A2; sacc+=A3; PIN(sacc); W0; W1; PIN(PW); SBAR(); }while(0)
  #define EX(v) __builtin_amdgcn_exp2f(v)
  #define GAPB(MF,X,B) do{ MF; X[B]=EX(X[B]); X[B+1]=EX(X[B+1]); X[B+2]=EX(X[B+2]); X[B+3]=EX(X[B+3]); PIN(X); SBAR(); }while(0)
  #define VRD(i) do{ vlo[i]=vtr(vp_+(((i)>>2)*4096+((i)&3)*1024)); vhi[i]=vtr(vp_+(((i)>>2)*4096+((i)&3)*1024+512)); }while(0)
  #define KRD(G,j) do{ if(G){ kload2(kf,kp0+sl_next,j); SBAR(); } }while(0)
  #define STEP(C0,C1,P0,P1,t,GK,GV,GL) do{ SBAR(); \
    const lds_cptr vp_=vp0+sl_prev; \
    VRD(0); SBAR(); float sacc=(P0[0]+P0[1]); \
    GAPA(C0=__builtin_amdgcn_mfma_f32_32x32x16_bf16(kf[0],qr[0],negm,0,0,0), P0[2],P0[3],P0[4],P0[5],     pw0[0]=PKW(P0,0), pw0[1]=PKW(P0,2), pw0); \
    VRD(4); SBAR(); GAPA(C1=__builtin_amdgcn_mfma_f32_32x32x16_bf16(kf[1],qr[0],negm,0,0,0), P0[6],P0[7],P0[8],P0[9],     pw0[2]=PKW(P0,4), pw0[3]=PKW(P0,6), pw0); \
    VRD(1); SBAR(); GAPA(C0=__builtin_amdgcn_mfma_f32_32x32x16_bf16(kf[2],qr[1],C0,0,0,0),   P0[10],P0[11],P0[12],P0[13], pw1[0]=PKW(P0,8), pw1[1]=PKW(P0,10), pw1); \
    VRD(5); SBAR(); GAPA(C1=__builtin_amdgcn_mfma_f32_32x32x16_bf16(kf[3],qr[1],C1,0,0,0),   P0[14],P0[15],P1[0],P1[1],   pw1[2]=PKW(P0,12),pw1[3]=PKW(P0,14), pw1); \
    VRD(2); SBAR(); GAPA(C0=__builtin_amdgcn_mfma_f32_32x32x16_bf16(kf[4],qr[2],C0,0,0,0),   P1[2],P1[3],P1[4],P1[5],     pw2[0]=PKW(P1,0), pw2[1]=PKW(P1,2), pw2); \
    VRD(6); SBAR(); GAPA(C1=__builtin_amdgcn_mfma_f32_32x32x16_bf16(kf[5],qr[2],C1,0,0,0),   P1[6],P1[7],P1[8],P1[9],     pw2[2]=PKW(P1,4), pw2[3]=PKW(P1,6), pw2); \
    VRD(3); SBAR(); GAPA(C0=__builtin_amdgcn_mfma_f32_32x32x16_bf16(kf[6],qr[3],C0,0,0,0),   P1[10],P1[11],P1[12],P1[13], pw3[0]=PKW(P1,8), pw3[1]=PKW(P1,10), pw3); \
    VRD(7); SBAR(); GAPA(C1=__builtin_amdgcn_mfma_f32_32x32x16_bf16(kf[7],qr[3],C1,0,0,0),   P1[14],P1[15],0.f,0.f,       pw3[2]=PKW(P1,12),pw3[3]=PKW(P1,14), pw3); \
    l_reg+=sacc; \
    if(GK){DMA_K((t)+3,sl_cur);} if(GV){DMA_V((t)+1,sl_next);} \
    CMASK(C0,C1,t); \
    { float a=MX3(C0[0],C0[1],C1[0]),b=MX3(C0[2],C0[3],C1[1]); a=MX3(a,C1[2],C1[3]); \
      _Pragma("unroll") for(int r=4;r<16;r+=4){a=MX3(a,C0[r],C0[r+1]);b=MX3(b,C0[r+2],C0[r+3]);a=MX3(a,C1[r],C1[r+1]);b=MX3(b,C1[r+2],C1[r+3]);} \
      float rm=__builtin_fmaxf(a,b); { auto rr=__builtin_amdgcn_permlane32_swap(__float_as_uint(rm),__float_as_uint(rm),false,false); rm=__builtin_fmaxf(__uint_as_float(rr[0]),__uint_as_float(rr[1])); } \
      resc=false; \
      if(__builtin_expect(__any(rm>(float)THRL),0)){ const float dl=__builtin_fmaxf(rm,0.f); mhat+=dl; \
        _Pragma("unroll") for(int r=0;r<16;++r){C0[r]-=dl;C1[r]-=dl;} \
        _Pragma("unroll") for(int r=0;r<16;++r)negm[r]=-mhat; asm volatile("":"+v"(negm)); \
        const float f=__builtin_amdgcn_exp2f(-dl); l_reg*=f; if(hi==0)wsf[r32]=f; resc=true; } } \
    SBAR(); \
    GAPB(o[0]=__builtin_amdgcn_mfma_f32_32x32x16_bf16(PAF(0),VFR(0),o[0],0,0,0), C0,0); \
    GAPB(o[1]=__builtin_amdgcn_mfma_f32_32x32x16_bf16(PAF(0),VFR(4),o[1],0,0,0), C0,4); \
    KRD(GL,0); GAPB(o[0]=__builtin_amdgcn_mfma_f32_32x32x16_bf16(PAF(1),VFR(1),o[0],0,0,0), C0,8); \
    KRD(GL,1); GAPB(o[1]=__builtin_amdgcn_mfma_f32_32x32x16_bf16(PAF(1),VFR(5),o[1],0,0,0), C0,12); \
    KRD(GL,2); GAPB(o[0]=__builtin_amdgcn_mfma_f32_32x32x16_bf16(PAF(2),VFR(2),o[0],0,0,0), C1,0); \
    KRD(GL,3); GAPB(o[1]=__builtin_amdgcn_mfma_f32_32x32x16_bf16(PAF(2),VFR(6),o[1],0,0,0), C1,4); \
    GAPB(o[0]=__builtin_amdgcn_mfma_f32_32x32x16_bf16(PAF(3),VFR(3),o[0],0,0,0), C1,8); \
    GAPB(o[1]=__builtin_amdgcn_mfma_f32_32x32x16_bf16(PAF(3),VFR(7),o[1],0,0,0), C1,12); \
    }while(0)
  int t=1;
  for(;t+5<NT;t+=2){
    STEP(pB0,pB1,pA0,pA1,t,true,true,true);     WAIT_BAR(2); RESC(); ROT();
    STEP(pA0,pA1,pB0,pB1,t+1,true,true,true);   WAIT_BAR(2); RESC(); ROT();
  }
  #define ENDW(tt) do{ if((tt)+3<NT){WAIT_BAR(2);} else if((tt)+2<NT){WAIT_BAR(1);} else {WAIT_BAR(0);} }while(0)
  for(;t+1<NT;t+=2){
    STEP(pB0,pB1,pA0,pA1,t,(t+3<NT),(t+1<NT),(t+1<NT));       ENDW(t);   RESC(); ROT();
    STEP(pA0,pA1,pB0,pB1,t+1,(t+4<NT),(t+2<NT),(t+2<NT));     ENDW(t+1); RESC(); ROT();
  }
  STEP(pB0,pB1,pA0,pA1,NT-1,false,false,false); RESC();
  { float sacc=pB0[0]+pB0[1]; _Pragma("unroll") for(int r=2;r<16;++r)sacc+=pB0[r]; _Pragma("unroll") for(int r=0;r<16;++r)sacc+=pB1[r]; l_reg+=sacc;
    pw0=(u32x4){PKW(pB0,0),PKW(pB0,2),PKW(pB0,4),PKW(pB0,6)};pw1=(u32x4){PKW(pB0,8),PKW(pB0,10),PKW(pB0,12),PKW(pB0,14)};pw2=(u32x4){PKW(pB1,0),PKW(pB1,2),PKW(pB1,4),PKW(pB1,6)};pw3=(u32x4){PKW(pB1,8),PKW(pB1,10),PKW(pB1,12),PKW(pB1,14)};
    SBAR(); pv(o,vb0+sl_cur,PAF(0),PAF(1),PAF(2),PAF(3)); }
  #undef PKW
  #undef PAF
  #undef VFR
  #undef PIN
  #undef MX3
  #undef GAPA
  #undef GAPB
  #undef EX
  #undef VRD
  #undef KRD
  #undef STEP
  #undef ENDW
  {auto rr=__builtin_amdgcn_permlane32_swap(__float_as_uint(l_reg),__float_as_uint(l_reg),false,false);l_reg=__uint_as_float(rr[0])+__uint_as_float(rr[1]);}
  if(J.sidx>=0)l_reg+=__builtin_amdgcn_exp2f(A.in[11][J.sidx]*1.4426950408889634f-mhat);
  if(hi==0)wsf[32+r32]=l_reg;asm volatile("s_waitcnt lgkmcnt(0)":::"memory");
  float rli[16];
  #pragma unroll
  for(int r=0;r<16;++r)rli[r]=__builtin_amdgcn_rcpf(wsf[32+crow(r,hi)]);
  bf16*Ow=(bf16*)(A.ws+WS_MIX)+J.o_off+(long)(wid*QBLK)*OP;
  { bf16*stg=(bf16*)(shm+LDS_OST)+wid*2048;
    #pragma unroll
    for(int r=0;r<16;++r){const int orow=crow(r,hi);
      #pragma unroll
      for(int d0=0;d0<2;++d0)stg[orow*64+d0*32+r32]=__float2bfloat16(o[d0][r]*rli[r]);}
    asm volatile("s_waitcnt lgkmcnt(0)":::"memory");
    #pragma unroll
    for(int i=0;i<4;++i){const int row=i*8+(lane>>3),ch=lane&7; const u32x4 v=*(const u32x4*)(stg+row*64+ch*8); ATTN_STORE16(Ow+(long)row*OP+ch*8,v);} }
  asm volatile("s_waitcnt lgkmcnt(0)\n\ts_barrier":::"memory");
  #undef TROW
  #undef DMA_K
  #undef DMA_V
  #undef CMASK
  #undef START
  #undef RESC
  #undef ROT
}
constexpr int ATTN_LDS_BYTES=LDS_BYTES;
#undef SBAR
#undef WAIT_BAR
}
#define XB_TMO      128
#define XB_XCNT(j)  (256  + 64 * (j))
#define XB_XSUB(j)  (1280 + 64 * (j))
#define XB_XGEN(j)  (2304 + 64 * (j))
#define XB_TOP      3328
#define XB_TOPGEN   3392
#define XCD_BAR_WORDS 3456
#define XB_SPIN_CAP (1u << 18)

__device__ __forceinline__ unsigned xb_ld(unsigned* p)              { return __hip_atomic_load(p, __ATOMIC_RELAXED, __HIP_MEMORY_SCOPE_AGENT); }
__device__ __forceinline__ unsigned xb_add(unsigned* p, unsigned v) { return __hip_atomic_fetch_add(p, v, __ATOMIC_RELAXED, __HIP_MEMORY_SCOPE_AGENT); }
__device__ __forceinline__ unsigned xb_xcc_id() { return (unsigned)__builtin_amdgcn_s_getreg((3 << 11) | 20) & 0xFu; }
#define XB_SPIN(cond, bar) do { unsigned _sp = 0; while (cond) { __builtin_amdgcn_s_sleep(1); \
    if ((++_sp & 255u) == 0u) { if (xb_ld(&(bar)[XB_TMO])) break; if (_sp > XB_SPIN_CAP) { atomicAdd(&(bar)[XB_TMO], 1u); break; } } } } while (0)

struct XcdBarrier {
    unsigned* bar; unsigned x;
    volatile LAS unsigned* st;
};

__device__ __forceinline__ XcdBarrier xcd_barrier_post(unsigned* bar, volatile LAS unsigned* st, bool leader  ) {
    XcdBarrier b; b.bar = bar; b.x = xb_xcc_id(); b.st = st;
    if (leader) (void)xb_add(&bar[XB_XCNT(b.x)], 1u);
    return b;
}
__device__ __forceinline__ void xcd_barrier_complete(unsigned* bar, unsigned x, unsigned& nloc, unsigned& nx) {
    const unsigned G = gridDim.x * gridDim.y * gridDim.z;
    unsigned sum, cnt, mine, sp = 0u;
    for (;;) {
        sum = 0u; cnt = 0u; mine = 0u;
#pragma unroll
        for (unsigned j = 0; j < 16; ++j) { const unsigned c = xb_ld(&bar[XB_XCNT(j)]); sum += c; cnt += (c > 0u) ? 1u : 0u; mine = (j == x) ? c : mine; }
        if (sum == G) break;
        __builtin_amdgcn_s_sleep(1);
        if ((++sp & 255u) == 0u) { if (xb_ld(&bar[XB_TMO])) break; if (sp > XB_SPIN_CAP) { atomicAdd(&bar[XB_TMO], 1u); break; } }
    }
    nloc = mine > 0u ? mine : 1u; nx = cnt > 0u ? cnt : 1u;
}

__device__ __forceinline__ void xcd_barrier(const XcdBarrier& b, bool leader  ) {
    asm volatile("s_waitcnt vmcnt(0)" ::: "memory");
    __syncthreads();
    if (leader) {
        unsigned* bar = b.bar; asm volatile("" : "+s"(bar));
        __builtin_amdgcn_s_waitcnt(0);
        unsigned nloc = b.st[0], nx = b.st[1];
        if (nloc == 0u) { xcd_barrier_complete(bar, b.x, nloc, nx); b.st[0] = nloc; b.st[1] = nx; }
        const unsigned old = xb_add(&bar[XB_XSUB(b.x)], 1u);
        const unsigned gen = old / nloc;
        if (old + 1u == (gen + 1u) * nloc) {
            __builtin_amdgcn_fence(__ATOMIC_RELEASE, "agent");
            asm volatile("s_waitcnt vmcnt(0)" ::: "memory");
            const unsigned og = xb_add(&bar[XB_TOP], 1u);
            const unsigned tg = og / nx;
            if (og + 1u == (tg + 1u) * nx) xb_add(&bar[XB_TOPGEN], 1u);
            else XB_SPIN(xb_ld(&bar[XB_TOPGEN]) == tg, bar);
            __builtin_amdgcn_fence(__ATOMIC_ACQUIRE, "agent");
            xb_add(&bar[XB_XGEN(b.x)], 1u);
            asm volatile("s_waitcnt vmcnt(0)" ::: "memory");
        } else {
            XB_SPIN(xb_ld(&bar[XB_XGEN(b.x)]) == gen, bar);
            __builtin_amdgcn_fence(__ATOMIC_ACQUIRE, "agent");
            asm volatile("s_waitcnt vmcnt(0)" ::: "memory");
        }
    }
    __syncthreads();
}
struct Ctx { LAS unsigned char* lds; int tid, lane, wave, vcu, G, gw, NGW; };
__device__ __forceinline__ float lora_e(float x) { return 0.60653065971263342f / (1.0f + __expf(-x)); }
__device__ __forceinline__ float sigm(float x) { return 1.0f / (1.0f + __expf(-x)); }
#define DPP_ADD(v, ctrl) v += __builtin_bit_cast(float, __builtin_amdgcn_update_dpp(0, __builtin_bit_cast(int, v), ctrl, 0xF, 0xF, false))
__device__ __forceinline__ float wave_sum(float v) {
    DPP_ADD(v, 0xB1); DPP_ADD(v, 0x4E); DPP_ADD(v, 0x141); DPP_ADD(v, 0x140);
    const int iv = __builtin_bit_cast(int, v);
    const float a = __builtin_bit_cast(float, __builtin_amdgcn_readlane(iv, 0)), b = __builtin_bit_cast(float, __builtin_amdgcn_readlane(iv, 16)),
                c = __builtin_bit_cast(float, __builtin_amdgcn_readlane(iv, 32)), d = __builtin_bit_cast(float, __builtin_amdgcn_readlane(iv, 48));
    return (a + b) + (c + d);
}
__device__ __forceinline__ float swap32(float v, int lane) {
    const unsigned u = __builtin_bit_cast(unsigned, v); auto rr = __builtin_amdgcn_permlane32_swap(u, u, false, false);
    return __builtin_bit_cast(float, lane < 32 ? rr[1] : rr[0]);
}
__device__ __forceinline__ float dpp_xor_sum8(float v) {
    v += __builtin_bit_cast(float, __builtin_amdgcn_update_dpp(0, __builtin_bit_cast(int, v), 0xB1, 0xF, 0xF, false));
    v += __builtin_bit_cast(float, __builtin_amdgcn_update_dpp(0, __builtin_bit_cast(int, v), 0x4E, 0xF, 0xF, false));
    v += __builtin_bit_cast(float, __builtin_amdgcn_update_dpp(0, __builtin_bit_cast(int, v), 0x141, 0xF, 0xF, false));
    return v;
}
__device__ __forceinline__ void p0_transpose_item(const float* W, int K, int N, bf16* WT, LAS float* scr, int item, int lane) {
    const int nblk = N / 32, kb = item / nblk, nb = item % nblk, k0 = 64 * kb, n0 = 32 * nb;
#pragma unroll
    for (int i = 0; i < 8; ++i) { const int kk = 8 * i + (lane >> 3), c4 = (lane & 7) * 4;
        const f32x4 wv = *(const f32x4*)(W + (size_t)(k0 + kk) * N + n0 + c4);
        LAS float* d = scr + kk * 33 + c4; d[0] = wv.x; d[1] = wv.y; d[2] = wv.z; d[3] = wv.w; }
    LDS_WAIT(); asm volatile("" ::: "memory");
    const int c = lane & 7;
#pragma unroll
    for (int j = 0; j < 4; ++j) { const int n = (lane >> 3) + 8 * j; const LAS float* s = scr + (8 * c) * 33 + n;
        v4u o; o.x = pk2(s[0 * 33], s[1 * 33]); o.y = pk2(s[2 * 33], s[3 * 33]); o.z = pk2(s[4 * 33], s[5 * 33]); o.w = pk2(s[6 * 33], s[7 * 33]);
        *(v4u*)(WT + (size_t)(n0 + n) * K + k0 + 8 * c) = o; }
    LDS_WAIT(); asm volatile("" ::: "memory");
}
constexpr int CI_IN = 32 * (NIN / 32), CI_OUT = 32 * 64, CI_1 = 32 * 256, CI_2 = 128 * 64;
__device__ __forceinline__ void convert_items(const Ctx& F, const Args& A, int l, int mat, int it0, int it1, int w0, int nw) {
    LAS float* scr = (LAS float*)(F.lds + F.wave * 16384);
    for (int it = it0 + w0; it < it1; it += nw) {
        if (mat == 0) p0_transpose_item((A.in[8]) + (size_t)l * D * NIN, D, NIN, ((bf16*)(A.ws + WS_WIN)) + (size_t)l * NINP * D, scr, it, F.lane);
        else if (mat == 1) p0_transpose_item((A.in[25]) + (size_t)l * D * D, D, D, ((bf16*)(A.ws + WS_WOUT)) + (size_t)l * D * D, scr, it, F.lane);
        else if (mat == 2) p0_transpose_item((A.in[26]) + (size_t)l * D * FF, D, FF, ((bf16*)(A.ws + WS_W1)) + (size_t)l * FF * D, scr, it, F.lane);
        else p0_transpose_item((A.in[27]) + (size_t)l * FF * D, FF, D, ((bf16*)(A.ws + WS_W2)) + (size_t)l * D * FF, scr, it, F.lane);
    }
}
__device__ __forceinline__ void p0_prologue(const Ctx& F, const Args& A) {
    LAS float* sil = (LAS float*)F.lds;
    for (int i = F.tid; i < 3 * D; i += NWAVES * 64) { const int v = i / D, k = i % D; const float xv = v < 2 ? (A.in[1])[v * D + k] : (A.in[3])[k]; sil[i] = xv / (1.0f + __expf(-xv)); }
    __syncthreads();
    for (int it = F.gw; it < DEPTH * 48 * 8; it += F.NGW) {
        const int l = it / 384, r = it % 384, nb = r >> 3, ks = r & 7;
        const float* W = (A.in[4]) + ((size_t)l * D + (size_t)ks * 256) * MODW + nb * 256 + F.lane * 4;
        f32x4 a0 = {0.f, 0.f, 0.f, 0.f}, a1 = a0, a2 = a0;
#pragma unroll 8
        for (int k = 0; k < 256; ++k) { const f32x4 w = *(const f32x4*)(W + (size_t)k * MODW); const int kk = ks * 256 + k; a0 += sil[kk] * w; a1 += sil[D + kk] * w; a2 += sil[2 * D + kk] * w; }
        float* o = ((float*)(A.ws + WS_MODP)) + ((size_t)ks * 12 + l * 3) * MODW + nb * 256 + F.lane * 4;
        *(f32x4*)o = a0; *(f32x4*)(o + MODW) = a1; *(f32x4*)(o + 2 * MODW) = a2;
    }
    __syncthreads();
    if (F.G == 256) convert_items(F, A, 0, 0, 0, CI_IN, F.gw, F.NGW);
    else for (int l2 = 0; l2 < DEPTH; ++l2) { convert_items(F, A, l2, 0, 0, CI_IN, F.gw, F.NGW); convert_items(F, A, l2, 1, 0, CI_OUT, F.gw, F.NGW); convert_items(F, A, l2, 2, 0, CI_1, F.gw, F.NGW); convert_items(F, A, l2, 3, 0, CI_2, F.gw, F.NGW); }
    const int gt = F.gw * 64 + F.lane, NGT = F.NGW * 64;
    for (int i = gt; i < DEPTH * 128 * 256; i += NGT) {
        const int l = i / (128 * 256), r = i % (128 * 256);
        *(v4u*)(((bf16*)(A.ws + WS_WIN)) + ((size_t)l * NINP + NIN) * D + (size_t)r * 8) = (v4u){0u, 0u, 0u, 0u};
    }
    for (int i = gt; i < DEPTH * 5 * 1024 * 32; i += NGT) {
        const int n = i & 1023, k0 = ((i >> 10) & 31) * 8, lp = i >> 15, p = lp % 5, l = lp / 5;
        float v[8];
#pragma unroll
        for (int e = 0; e < 8; ++e) { const int k = k0 + e;
            v[e] = p < 2 ? (k < 96 ? (A.in[16])[((size_t)(l * 2 + p) * 96 + k) * BW + n] : 0.f) : p < 4 ? (k < 96 ? (A.in[18])[((size_t)(l * 2 + (p - 2)) * 96 + k) * BW + n] : 0.f) : (A.in[19])[((size_t)l * 256 + k) * BW + n]; }
        *(v4u*)(((bf16*)(A.ws + WS_LW)) + ((size_t)lp * 1024 + n) * 256 + k0) = (v4u){pk2(v[0], v[1]), pk2(v[2], v[3]), pk2(v[4], v[5]), pk2(v[6], v[7])};
    }
    for (int i = gt; i < T * 32; i += NGT) {
        const int t = i >> 5, j = i & 31, pos = j < 16 ? (t >> 6) : (t & 63);
        const float inv = (float)pow(10000.0, -(double)(j & 15) / 16.0), ang = (float)pos * inv;
        ((float*)(A.ws + WS_ROPE))[i] = (float)cos((double)ang); ((float*)(A.ws + WS_ROPE))[T * 32 + i] = (float)sin((double)ang);
    }
}
__device__ __forceinline__ void p0b_mods(const Ctx& F, const Args& A) {
    const int gt = F.gw * 64 + F.lane, NGT = F.NGW * 64;
    for (int i = gt; i < DEPTH * 3 * MODW; i += NGT) { const int l = i / (3 * MODW), n = i % MODW; float s = (A.in[5])[l * MODW + n];
#pragma unroll
        for (int ks = 0; ks < 8; ++ks) s += ((float*)(A.ws + WS_MODP))[(size_t)ks * 12 * MODW + i];
        ((float*)(A.ws + WS_MOD))[i] = s; }
}
__device__ __forceinline__ const float* norm_src(const Args& A, int l, int which, int m) {
    const int b = m / SU, s = m % SU;
    return s < CT ? (l == 0 ? (A.in[2]) : ((float*)(A.ws + WS_HCTX))) + ((size_t)b * CT + s) * D : (l == 0 && !which ? (A.in[0]) : (A.out)) + ((size_t)b * T + (s - CT)) * D;
}
__device__ __forceinline__ void norm_row(const Ctx& F, const Args& A, int l, int which, int m, f32x4 (&v)[8], const float* gain) {
    const int b = m / SU, s = m % SU; const bool isctx = s < CT;
    const float* mod = ((float*)(A.ws + WS_MOD)) + ((size_t)l * 3 + (isctx ? 2 : b)) * MODW + which * 3 * D;
    float ss = 0.f;
    if (isctx && (which ? true : l > 0)) {
        const float* sl = ((const float*)(A.ws + WS_SL)) + ((size_t)b * CT + s) * D + F.lane * 8;
        const float* gt = ((float*)(A.ws + WS_MOD)) + ((size_t)(which ? l : l - 1) * 3 + 2) * MODW + (which ? 2 : 5) * D + F.lane * 8;
        float* hw = ((float*)(A.ws + WS_HCTX)) + ((size_t)b * CT + s) * D + F.lane * 8;
#pragma unroll
        for (int j = 0; j < 8; ++j) { const int co = 512 * (j >> 1) + 4 * (j & 1); f32x4 a = *(const f32x4*)(sl + co);
#pragma unroll
            for (int q = 1; q < 8; ++q) a += *(const f32x4*)(sl + (size_t)q * 512 * D + co);
            v[j] += *(const f32x4*)(gt + co) * a; *(f32x4*)(hw + co) = v[j]; }
    }
#pragma unroll
    for (int j = 0; j < 8; ++j) ss += (v[j].x * v[j].x + v[j].y * v[j].y) + (v[j].z * v[j].z + v[j].w * v[j].w);
    const float rstd = 1.0f / sqrtf(wave_sum(ss) * (1.0f / D) + 1e-6f);
    bf16* o = ((bf16*)(A.ws + WS_U)) + (size_t)m * D;
    const LAS float* tg = (const LAS float*)F.lds + (isctx ? 2 : b) * 2 * D;
#pragma unroll
    for (int j2 = 0; j2 < 4; ++j2) { const int col = F.lane * 8 + 512 * j2;
        const f32x4 g0 = *(const LAS f32x4*)(tg + col), g1 = *(const LAS f32x4*)(tg + col + 4), s0 = *(const LAS f32x4*)(tg + D + col), s1 = *(const LAS f32x4*)(tg + D + col + 4);
        const f32x4 y0 = (v[2 * j2] * rstd) * g0 + s0, y1 = (v[2 * j2 + 1] * rstd) * g1 + s1;
        *(v4u*)(o + col) = (v4u){pk2(y0.x, y0.y), pk2(y0.z, y0.w), pk2(y1.x, y1.y), pk2(y1.z, y1.w)}; }
}
__device__ __forceinline__ void ph_norm(const Ctx& F, const Args& A, int l, int which) {
    const float* gain = (which ? (A.in[7]) : (A.in[6])) + l * D;
    const bool last = (l == DEPTH - 1);
    {
        LAS float* tb = (LAS float*)F.lds;
        for (int i = F.tid; i < 3 * (D / 4); i += NWAVES * 64) { const int v = i / (D / 4), col = (i % (D / 4)) * 4;
            const float* mod = ((float*)(A.ws + WS_MOD)) + ((size_t)l * 3 + v) * MODW + which * 3 * D;
            const f32x4 g = *(const f32x4*)(gain + col), sh = *(const f32x4*)(mod + col), sc = *(const f32x4*)(mod + D + col);
            *(LAS f32x4*)(tb + v * 2 * D + col) = g * (1.0f + sc); *(LAS f32x4*)(tb + v * 2 * D + D + col) = sh; }
        __syncthreads();
    }
    const bool even = (NB * T) % F.NGW == 0 && F.NGW % (NB * CT) == 0; const int cstep = even ? F.NGW / (NB * CT) : 1, nlat = (NB * T) / F.NGW;
    if (!even) {
        for (int m = F.gw; m < M; m += F.NGW) { if ((m % SU) < CT && last && which) continue; f32x4 v[8]; const float* row = norm_src(A, l, which, m);
#pragma unroll
            for (int j = 0; j < 8; ++j) v[j] = *(const f32x4*)(row + F.lane * 8 + 512 * (j >> 1) + 4 * (j & 1));
            norm_row(F, A, l, which, m, v, gain); }
        return;
    }
    f32x4 vn[8];
    { const int vi = F.gw; const float* row = norm_src(A, l, which, (vi / T) * SU + CT + (vi % T));
#pragma unroll
      for (int j = 0; j < 8; ++j) vn[j] = *(const f32x4*)(row + F.lane * 8 + 512 * (j >> 1) + 4 * (j & 1)); }
    for (int it = 0; it < nlat; ++it) {
        const int vi = it * F.NGW + F.gw, m = (vi / T) * SU + CT + (vi % T);
        f32x4 v[8];
#pragma unroll
        for (int j = 0; j < 8; ++j) v[j] = vn[j];
        if (it + 1 < nlat) { const int vj = vi + F.NGW; const float* row = norm_src(A, l, which, (vj / T) * SU + CT + (vj % T));
#pragma unroll
            for (int j = 0; j < 8; ++j) vn[j] = *(const f32x4*)(row + F.lane * 8 + 512 * (j >> 1) + 4 * (j & 1)); }
        norm_row(F, A, l, which, m, v, gain);
    }
    if (!(last && which) && F.gw % cstep == 0) {
        const int c = F.gw / cstep, m = (c / CT) * SU + (c % CT); f32x4 v[8]; const float* row = norm_src(A, l, which, m);
#pragma unroll
        for (int j = 0; j < 8; ++j) v[j] = *(const f32x4*)(row + F.lane * 8 + 512 * (j >> 1) + 4 * (j & 1));
        norm_row(F, A, l, which, m, v, gain);
    }
}
__device__ __forceinline__ void ph_prep(const Ctx& F, const Args& A, int l) {
    const int lane = F.lane, g8 = lane & 7, hd = lane >> 3;
    constexpr float C2 = 0.125f * 1.4426950408889634f;
    bf16* R = ((bf16*)(A.ws + WS_STR)); bf16* KS = R + (size_t)M * BW; bf16* VS = R + 2 * (size_t)M * BW; bf16* KK = R + 3 * (size_t)M * BW;
    const float* ROPE = (const float*)(A.ws + WS_ROPE); bf16* LA = (bf16*)(A.ws + WS_LA);
    LAS float* const mu0b = (LAS float*)F.lds; LAS float* mu0 = mu0b; LAS float* mu1 = mu0 + BIN; LAS float* kkw = mu1 + BIN; LAS float* gwt = kkw + BW;
    for (int i = F.tid; i < 2 * BIN; i += NWAVES * 64) mu0[i] = (A.in[14])[(size_t)(l * 2) * BIN + i];
    for (int i = F.tid; i < BW; i += NWAVES * 64) kkw[i] = (A.in[20])[l * BW + i];
    if (F.tid < 256) { const int q = F.tid >> 6, j = F.tid & 63; gwt[F.tid] = (q == 0 ? (A.in[9]) : q == 1 ? (A.in[10]) : q == 2 ? (A.in[12]) : (A.in[13]))[l * 64 + j]; }
    __syncthreads();
    for (int m = F.gw; m < M; m += F.NGW) {
        const int s = m % SU; const bool isctx = s < CT; const int t = isctx ? 0 : s - CT;
        const bf16* prow = ((bf16*)(A.ws + WS_P)) + (size_t)m * NINP;
        { unsigned ob_ = 0; asm volatile("" : "+v"(ob_)); mu0 = mu0b + ob_; mu1 = mu0 + BIN; kkw = mu1 + BIN; gwt = kkw + BW; }
        const bool hasp = (s != 0 && s != CT), hasn = (s != CT - 1 && s != SU - 1);
        v4u rc[8], rp[8], rn[8];
#pragma unroll
        for (int pass = 0; pass < 8; ++pass) { const int c0 = pass * 512 + lane * 8; const bool on = pass < 7 || lane < 16;
            rc[pass] = on ? *(const v4u*)(prow + PB0 + c0) : (v4u){0u, 0u, 0u, 0u};
            rp[pass] = (on && hasp) ? *(const v4u*)(prow + PB0 + c0 - NINP) : (v4u){0u, 0u, 0u, 0u};
            rn[pass] = (on && hasn) ? *(const v4u*)(prow + PB0 + c0 + NINP) : (v4u){0u, 0u, 0u, 0u}; }
        f32x4 cs = {1.f, 1.f, 1.f, 1.f}, sn = {0.f, 0.f, 0.f, 0.f};
        if (!isctx) { cs = *(const f32x4*)(ROPE + t * 32 + 4 * g8); sn = *(const f32x4*)(ROPE + T * 32 + t * 32 + 4 * g8); }
#pragma unroll
        for (int pass = 0; pass < 3; ++pass) {
            const int part = pass < 2 ? pass : ((hd >> 1) & 1), hs = pass < 2 ? hd : (hd & 1);
            const int src = (pass < 2 ? (part ? PC_Q : PA_Q) : (part ? PC_K : PA_K)) + hs * 64 + 4 * g8;
            const LAS float* gw = gwt + (pass < 2 ? (part ? 2 : 0) : (part ? 3 : 1)) * 64 + 4 * g8;
            const v2u a = *(const v2u*)(prow + src), b = *(const v2u*)(prow + src + 32);
            float x1[4] = {__builtin_bit_cast(float, a.x << 16), __builtin_bit_cast(float, a.x & 0xffff0000u), __builtin_bit_cast(float, a.y << 16), __builtin_bit_cast(float, a.y & 0xffff0000u)};
            float x2[4] = {__builtin_bit_cast(float, b.x << 16), __builtin_bit_cast(float, b.x & 0xffff0000u), __builtin_bit_cast(float, b.y << 16), __builtin_bit_cast(float, b.y & 0xffff0000u)};
            float ss = 0.f;
#pragma unroll
            for (int e = 0; e < 4; ++e) ss += x1[e] * x1[e] + x2[e] * x2[e];
            const float rs = (1.0f / sqrtf(dpp_xor_sum8(ss) * (1.0f / 64.0f) + 1e-6f)) * (pass < 2 ? C2 : 1.0f);
            const f32x4 g1 = *(const LAS f32x4*)gw, g2 = *(const LAS f32x4*)(gw + 32);
            float o1[4], o2[4];
#pragma unroll
            for (int e = 0; e < 4; ++e) { const float y1 = x1[e] * rs * g1[e], y2 = x2[e] * rs * g2[e]; o1[e] = y1 * cs[e] - y2 * sn[e]; o2[e] = y1 * sn[e] + y2 * cs[e]; }
            bf16* dst = pass < 2 ? (part ? ((bf16*)(A.ws + WS_QC)) : ((bf16*)(A.ws + WS_QA))) + (size_t)m * 512 + hs * 64 + 4 * g8
                                 : (part ? ((bf16*)(A.ws + WS_KC)) : ((bf16*)(A.ws + WS_KA))) + (size_t)m * 128 + hs * 64 + 4 * g8;
            if (pass < 2 || hd < 4) { *(v2u*)dst = (v2u){pk2(o1[0], o1[1]), pk2(o1[2], o1[3])}; *(v2u*)(dst + 32) = (v2u){pk2(o2[0], o2[1]), pk2(o2[2], o2[3])}; }
        }
#pragma unroll
        for (int pass = 0; pass < 8; ++pass) {
            const int c0 = pass * 512 + lane * 8;
            if (pass == 7 && lane >= 16) break;
            const v4u pc = rc[pass], pp = rp[pass], pn = rn[pass];
            const f32x4 m0a = *(const LAS f32x4*)(mu0 + c0), m0b = *(const LAS f32x4*)(mu0 + c0 + 4), m1a = *(const LAS f32x4*)(mu1 + c0), m1b = *(const LAS f32x4*)(mu1 + c0 + 4);
            float xs[8];
#pragma unroll
            for (int e = 0; e < 8; ++e) { const unsigned wc = pc[e >> 1], wp = pp[e >> 1], wn = pn[e >> 1];
                const float p = __builtin_bit_cast(float, (e & 1) ? (wc & 0xffff0000u) : (wc << 16)), pv = __builtin_bit_cast(float, (e & 1) ? (wp & 0xffff0000u) : (wp << 16)), nx = __builtin_bit_cast(float, (e & 1) ? (wn & 0xffff0000u) : (wn << 16));
                const float a0 = e < 4 ? m0a[e] : m0b[e - 4], a1 = e < 4 ? m1a[e] : m1b[e - 4];
                xs[e] = p + a0 * (pv - p) + a1 * (nx - p); }
            if (pass < 6) {
                bf16* dst = (pass < 2 ? R : pass < 4 ? KS : VS) + (size_t)m * BW + (c0 & 1023);
                *(v4u*)dst = (v4u){pk2(xs[0], xs[1]), pk2(xs[2], xs[3]), pk2(xs[4], xs[5]), pk2(xs[6], xs[7])};
                if (pass == 2 || pass == 3) {
                    const int cc = c0 - BW; const f32x4 ka = *(const LAS f32x4*)(kkw + cc), kb = *(const LAS f32x4*)(kkw + cc + 4);
                    float z[8], n2 = 0.f;
#pragma unroll
                    for (int e = 0; e < 8; ++e) { z[e] = xs[e] * (e < 4 ? ka[e] : kb[e - 4]); n2 += z[e] * z[e]; }
                    const float inv = 1.0f / fmaxf(sqrtf(dpp_xor_sum8(n2)), 1e-12f);
                    *(v4u*)(KK + (size_t)m * BW + cc) = (v4u){pk2(z[0] * inv, z[1] * inv), pk2(z[2] * inv, z[3] * inv), pk2(z[4] * inv, z[5] * inv), pk2(z[6] * inv, z[7] * inv)};
                }
            } else {
                const int cl = c0 - 3 * BW, p2 = cl < 384 ? cl / 96 : 4, off = cl < 384 ? cl - 96 * p2 : cl - 384;
                float v[8];
#pragma unroll
                for (int e = 0; e < 8; ++e) { const float ex = __expf(p2 < 2 ? 2.0f * xs[e] : -xs[e]), rc = 1.0f / (1.0f + ex); v[e] = p2 < 2 ? 1.0f - 2.0f * rc : (p2 < 4 ? xs[e] : rc); }
                *(v4u*)(LA + ((size_t)p2 * M + m) * 256 + off) = (v4u){pk2(v[0], v[1]), pk2(v[2], v[3]), pk2(v[4], v[5]), pk2(v[6], v[7])};
            }
        }
        for (int i = lane; i < 80; i += 64) { const int p2 = i / 20, j = i % 20; *(v4u*)(LA + ((size_t)p2 * M + m) * 256 + 96 + 8 * j) = (v4u){0u, 0u, 0u, 0u}; }
    }
}
__device__ __forceinline__ void ph_readout(const Ctx& F, const Args& A, int l) {
    const int lane = F.lane; const bool last = (l == DEPTH - 1);
    const bf16* R = ((bf16*)(A.ws + WS_STR)); const bf16* KS = R + (size_t)M * BW; const bf16* VS = R + 2 * (size_t)M * BW;
    const bf16* Y0 = ((bf16*)(A.ws + WS_Y)); const bf16* Y1 = Y0 + (size_t)M * BW; const bf16* AG = ((bf16*)(A.ws + WS_AG));
    const bf16* A0 = AG; const bf16* A1 = AG + (size_t)M * BW; const bf16* Gt = AG + (size_t)2 * M * BW;
    const float* gng = (A.in[23]) + l * BW; const float* gnb = (A.in[24]) + l * BW; const float* kaw = (A.in[21]) + l * BW; const float* rkw = (A.in[22]) + l * BW;
    const int nrow = (M - F.gw + F.NGW - 1) / F.NGW, nit = 2 * nrow;
    v4u rw[8];
#define RO_LOAD(it_) do { const int m_ = F.gw + F.NGW * ((it_) >> 1); const size_t a_ = (size_t)m_ * BW + ((it_) & 1) * 512 + lane * 8; \
        rw[0] = *(const v4u*)(Y0 + a_); rw[1] = *(const v4u*)(Y1 + a_); rw[2] = *(const v4u*)(R + a_); rw[3] = *(const v4u*)(KS + a_); rw[4] = *(const v4u*)(VS + a_); \
        rw[5] = *(const v4u*)(A0 + a_); rw[6] = *(const v4u*)(A1 + a_); rw[7] = *(const v4u*)(Gt + a_); } while (0)
#define UB8(dst, u_) do { _Pragma("unroll") for (int e_ = 0; e_ < 8; ++e_) dst[e_] = __builtin_bit_cast(float, (e_ & 1) ? (u_[e_ >> 1] & 0xffff0000u) : (u_[e_ >> 1] << 16)); } while (0)
#define LD8(dst, ptr) do { const f32x4 u0_ = *(const f32x4*)(ptr), u1_ = *(const f32x4*)((ptr) + 4); dst[0] = u0_.x; dst[1] = u0_.y; dst[2] = u0_.z; dst[3] = u0_.w; dst[4] = u1_.x; dst[5] = u1_.y; dst[6] = u1_.z; dst[7] = u1_.w; } while (0)
    float qg[2][8], qb[2][8], qk[2][8], qr[2][8];
#pragma unroll
    for (int hh = 0; hh < 2; ++hh) { LD8(qg[hh], gng + hh * 512 + lane * 8); LD8(qb[hh], gnb + hh * 512 + lane * 8); LD8(qk[hh], kaw + hh * 512 + lane * 8); LD8(qr[hh], rkw + hh * 512 + lane * 8); }
    if (nit > 0) RO_LOAD(0);
    for (int it0 = 0; it0 < nit; it0 += 2)
#pragma unroll
    for (int hh2 = 0; hh2 < 2; ++hh2) {
        const int it = it0 + hh2; const int m = F.gw + F.NGW * (it >> 1), c0 = hh2 * 512 + lane * 8;
        float y[8], r[8], k[8], v[8], a0[8], a1[8], g[8], pg[8], pb[8], pk[8], pr[8];
        UB8(y, rw[0]); UB8(r, rw[1]);
#pragma unroll
        for (int e = 0; e < 8; ++e) y[e] += r[e];
        UB8(r, rw[2]); UB8(k, rw[3]); UB8(v, rw[4]); UB8(a0, rw[5]); UB8(a1, rw[6]); UB8(g, rw[7]);
        if (it + 1 < nit) RO_LOAD(it + 1);
        if (last && (m % SU) < CT) continue;
#pragma unroll
        for (int e = 0; e < 8; ++e) { pg[e] = qg[hh2][e]; pb[e] = qb[hh2][e]; pk[e] = qk[hh2][e]; pr[e] = qr[hh2][e]; }
        float sy = 0.f, sb = 0.f;
#pragma unroll
        for (int e = 0; e < 8; ++e) { sy += y[e]; sb += r[e] * (k[e] * (2.0f + (a0[e] + a1[e] - 2.0f) * pk[e])) * pr[e]; }
        const float mu = dpp_xor_sum8(sy) * (1.0f / 64.0f), bon = dpp_xor_sum8(sb);
        float sv = 0.f;
#pragma unroll
        for (int e = 0; e < 8; ++e) { y[e] -= mu; sv += y[e] * y[e]; }
        const float rstd = 1.0f / sqrtf(dpp_xor_sum8(sv) * (1.0f / 64.0f) + 64e-5f);
        float o[8];
#pragma unroll
        for (int e = 0; e < 8; ++e) o[e] = (y[e] * rstd * pg[e] + pb[e] + bon * v[e]) * g[e];
        *(v4u*)(((bf16*)(A.ws + WS_MIX)) + (size_t)m * D + 512 + c0) = (v4u){pk2(o[0], o[1]), pk2(o[2], o[3]), pk2(o[4], o[5]), pk2(o[6], o[7])};
    }
#undef RO_LOAD
#undef UB8
#undef LD8
}
namespace wk {
typedef short bf16x8 __attribute__((ext_vector_type(8)));
typedef short s16x4 __attribute__((ext_vector_type(4)));
typedef float f32x16 __attribute__((ext_vector_type(16)));
typedef float f32x4 __attribute__((ext_vector_type(4)));
typedef unsigned u32x4 __attribute__((ext_vector_type(4)));
typedef unsigned u32x2 __attribute__((ext_vector_type(2)));
#define WK_LAS __attribute__((address_space(3)))
#define WK_MFMA(a, b, c) __builtin_amdgcn_mfma_f32_32x32x16_bf16((a), (b), (c), 0, 0, 0)
constexpr int IMG = 16384;
constexpr int O_I0 = 0, O_I1 = IMG, O_I2 = 2 * IMG, O_I3 = 3 * IMG, O_I4 = 4 * IMG, O_I5 = 5 * IMG, O_I6 = 6 * IMG, O_NF = 7 * IMG, O_GAM = 6 * IMG + 8192, O_PART = O_GAM + 256;
constexpr int R1_LDS = 8 * IMG;
constexpr int O_ND = 131072 + 2048;
constexpr int UNIT_GF = 0, UNIT_RF = 8192, UNIT_HT = 16384, UNIT_Y0 = 24576, UNIT_BYTES = 32768;
__device__ __forceinline__ unsigned off_b(unsigned row, unsigned ch) { return 256u * row + 16u * (ch ^ (((row & 3u) << 2) | ((row >> 2) & 3u))); }
__device__ __forceinline__ int crow(int reg, int h) { return (reg & 3) + 8 * (reg >> 2) + 4 * h; }
__device__ __forceinline__ bf16x8 frag_row(const WK_LAS unsigned char* img, int c, int rb, int ks, int lane) {
    return *(const WK_LAS bf16x8*)(img + off_b(32 * rb + (lane & 31), 8 * c + 2 * ks + (lane >> 5)));
}
__device__ __forceinline__ bf16x8 frag_tr(const WK_LAS unsigned char* img, int c, int cb, int ks, int lane) {
    const unsigned h = lane >> 5, blk = (lane >> 4) & 1, q = (lane & 15) >> 2, p = lane & 3, ch = 4 * (2 * c + cb) + 2 * blk + (p >> 1);
    const s16x4 lo = __builtin_bit_cast(s16x4, __builtin_amdgcn_ds_read_tr16_b64_v4i16((WK_LAS s16x4*)(img + off_b(16 * ks + 8 * h + q, ch) + 8 * (p & 1))));
    const s16x4 hi = __builtin_bit_cast(s16x4, __builtin_amdgcn_ds_read_tr16_b64_v4i16((WK_LAS s16x4*)(img + off_b(16 * ks + 8 * h + 4 + q, ch) + 8 * (p & 1))));
    return (bf16x8){lo[0], lo[1], lo[2], lo[3], hi[0], hi[1], hi[2], hi[3]};
}
typedef float f32x2_t __attribute__((ext_vector_type(2))); typedef __bf16 bf16x2_t __attribute__((ext_vector_type(2)));
__device__ __forceinline__ unsigned pkbf(float lo, float hi) { const f32x2_t v = {lo, hi}; return __builtin_bit_cast(unsigned, __builtin_convertvector(v, bf16x2_t)); }
__device__ __forceinline__ void store_T(WK_LAS unsigned char* img, int c, int mb, int nb, const f32x16& a, int lane) {
    const unsigned row = 32 * nb + (lane & 31), h = lane >> 5;
#pragma unroll
    for (int g = 0; g < 4; ++g) *(WK_LAS u32x2*)(img + off_b(row, 8 * c + 4 * mb + g) + 8 * h) = (u32x2){pkbf(a[4 * g], a[4 * g + 1]), pkbf(a[4 * g + 2], a[4 * g + 3])};
}
template <bool STRICT> __device__ __forceinline__ void mask_diag(f32x16& a, int lane) {
    const int n = lane & 31, h = lane >> 5;
#pragma unroll
    for (int r = 0; r < 16; ++r) { const int m = crow(r, h); if (STRICT ? !(m < n) : !(m <= n)) a[r] = 0.f; }
}
__device__ __forceinline__ bf16x8 pack8(const f32x16& a, int s) { u32x4 p; p[0] = pkbf(a[8 * s], a[8 * s + 1]); p[1] = pkbf(a[8 * s + 2], a[8 * s + 3]); p[2] = pkbf(a[8 * s + 4], a[8 * s + 5]); p[3] = pkbf(a[8 * s + 6], a[8 * s + 7]); return __builtin_bit_cast(bf16x8, p); }
__device__ __forceinline__ f32x16 zero16() { f32x16 z;
#pragma unroll
    for (int i = 0; i < 16; ++i) z[i] = 0.f;
    return z; }
template <bool AT, bool BT> __device__ __forceinline__ void prod(f32x16& acc, const WK_LAS unsigned char* ia, int ca, int ba, const WK_LAS unsigned char* ib, int cbh, int bb, int lane) {
#pragma unroll
    for (int ks = 0; ks < 4; ++ks) {
        const bf16x8 a = AT ? frag_tr(ia, ca, ba, ks, lane) : frag_row(ia, ca, ba, ks, lane);
        const bf16x8 b = BT ? frag_tr(ib, cbh, bb, ks, lane) : frag_row(ib, cbh, bb, ks, lane);
        acc = WK_MFMA(a, b, acc);
    }
}
__device__ __forceinline__ void store_tile_f32(float* dst, const f32x16& a, int lane) {
#pragma unroll
    for (int q = 0; q < 4; ++q) *(f32x4*)(dst + (q * 64 + lane) * 4) = (f32x4){a[4 * q], a[4 * q + 1], a[4 * q + 2], a[4 * q + 3]};
}
__device__ __forceinline__ void store_tile_bf16(unsigned char* dst, const f32x16& a, int lane) {
#pragma unroll
    for (int q2 = 0; q2 < 2; ++q2) *(u32x4*)(dst + (q2 * 64 + lane) * 16) = (u32x4){pkbf(a[8 * q2], a[8 * q2 + 1]), pkbf(a[8 * q2 + 2], a[8 * q2 + 3]), pkbf(a[8 * q2 + 4], a[8 * q2 + 5]), pkbf(a[8 * q2 + 6], a[8 * q2 + 7])};
}
__device__ __forceinline__ void unpack_tile_bf16(f32x16& o, const u32x4& lo, const u32x4& hi) {
#pragma unroll
    for (int e = 0; e < 4; ++e) { o[2 * e] = __builtin_bit_cast(float, lo[e] << 16); o[2 * e + 1] = __builtin_bit_cast(float, lo[e] & 0xffff0000u); o[8 + 2 * e] = __builtin_bit_cast(float, hi[e] << 16); o[8 + 2 * e + 1] = __builtin_bit_cast(float, hi[e] & 0xffff0000u); }
}
struct R1In { const unsigned short *R, *KS, *VS, *KK, *Aa; const _Float16* E; const float* ka; };
struct R1Pre { u32x4 x[6]; };
__device__ __forceinline__ void r1_load(R1Pre& P, const R1In& in, int row0, int rstep, int col0, int tid) {
    const unsigned off = (unsigned)((row0 + rstep * (tid >> 3)) * BW + col0 + 8 * (tid & 7));
    P.x[0] = *(const u32x4*)(in.KK + off); P.x[1] = *(const u32x4*)(in.Aa + off); P.x[2] = *(const u32x4*)(in.KS + off);
    P.x[3] = *(const u32x4*)(in.R + off);  P.x[4] = *(const u32x4*)(in.VS + off); P.x[5] = *(const u32x4*)((const unsigned short*)in.E + off);
}
__device__ __forceinline__ void wkv_r1_unit(WK_LAS unsigned char* L, const R1In& in, R1Pre& P, int col0, unsigned char* urec, int tid, bool has_next, const R1In& inN, int row0N, int rstepN, int col0N) {
    int lane = tid & 63; const int w = __builtin_amdgcn_readfirstlane(tid >> 6); int h = lane >> 5;
#define WK_OPQ() do { asm volatile("" : "+v"(lane)); h = lane >> 5; } while (0)
    WK_LAS unsigned char* I0 = L + O_I0; WK_LAS unsigned char* I1 = L + O_I1; WK_LAS unsigned char* I2 = L + O_I2; WK_LAS unsigned char* I3 = L + O_I3;
    WK_LAS unsigned char* I4 = L + O_I4; WK_LAS unsigned char* I5 = L + O_I5; WK_LAS unsigned char* I6 = L + O_I6;
    WK_OPQ();
    WK_LAS float* NF = (WK_LAS float*)(L + O_NF); WK_LAS float* GAM = (WK_LAS float*)(L + O_GAM); WK_LAS float* PART = (WK_LAS float*)(L + O_PART); WK_LAS float* ND = (WK_LAS float*)(L + O_ND);
    { PB_BEGIN(30); PBS(36);
        WK_LAS unsigned char* ST = L + O_I3;
#pragma unroll
        for (int a = 0; a < 6; ++a) *(WK_LAS u32x4*)(ST + a * 8192 + tid * 16) = P.x[a];
        if (has_next) r1_load(P, inN, row0N, rstepN, col0N, tid);
        __syncthreads();
        float e[8], kk[8], aa[8], kv[8], rr[8]; unsigned short vraw[8];
        const float ka = in.ka[col0 + lane];
#pragma unroll
        for (int i = 0; i < 8; ++i) { const WK_LAS unsigned short* sp = (const WK_LAS unsigned short*)ST + (8 * w + i) * 64 + lane;
            kk[i] = bf2f(sp[0]); aa[i] = bf2f(sp[4096]); kv[i] = bf2f(sp[2 * 4096]); rr[i] = bf2f(sp[3 * 4096]); vraw[i] = sp[4 * 4096]; e[i] = (float)*(const WK_LAS _Float16*)(sp + 5 * 4096); }
        float run = 0.f;
#pragma unroll
        for (int i = 0; i < 8; ++i) run += e[i];
        PART[w * 64 + lane] = run;
        PBE(36);
        __syncthreads();
        PBS(37);
        float offs = 0.f, tot = 0.f;
#pragma unroll
        for (int w2 = 0; w2 < 8; ++w2) { const float pv = PART[w2 * 64 + lane]; tot += pv; if (w2 < w) offs += pv; }
        if (w == 0) GAM[lane] = __expf(-tot);
        float cum = offs, gprev = __expf(-offs);
#pragma unroll
        for (int i = 0; i < 8; ++i) {
            const int p = 8 * w + i; cum += e[i];
            const float g = __expf(-cum), ginv = __builtin_amdgcn_rcpf(g), a = aa[i];
            const float al = kk[i] * gprev, be = kk[i] * a * ginv, kp = kv[i] * (1.0f + (a - 1.0f) * ka) * ginv, rh = rr[i] * g;
            const unsigned o0 = off_b(p, lane >> 3) + 2 * (lane & 7), o1 = off_b(p, 8 + (lane >> 3)) + 2 * (lane & 7);
            const unsigned c01 = pkbf(al, be), c23 = pkbf(kp, rh);
            *(WK_LAS unsigned short*)(I0 + o0) = (unsigned short)c01; *(WK_LAS unsigned short*)(I0 + o1) = (unsigned short)(c01 >> 16);
            *(WK_LAS unsigned short*)(I1 + o0) = (unsigned short)c23; *(WK_LAS unsigned short*)(I1 + o1) = (unsigned short)(c23 >> 16);
            *(WK_LAS unsigned short*)(I2 + o0) = vraw[i];
            gprev = g;
        }
      PBE(37); PB_END(30); }
    __syncthreads();
    WK_OPQ();
    PBS(31);
#pragma unroll
    for (int q = 0; q < 2; ++q) {
        const int id = 2 * w + q, pr = id >> 2, mb = (id >> 1) & 1, nb = id & 1;
        f32x16 acc = zero16();
        if (pr == 0) {
            if (!(mb == 0 && nb == 1)) { prod<false, false>(acc, I0, 0, mb, I0, 1, nb, lane);
                if (mb == nb) {
#pragma unroll
                    for (int r = 0; r < 16; ++r) if (!((lane & 31) < crow(r, h))) acc[r] = 0.f;
#pragma unroll
                    for (int g = 0; g < 4; ++g) *(WK_LAS f32x4*)(ND + nb * 1024 + (g * 64 + lane) * 4) = (f32x4){acc[4 * g], acc[4 * g + 1], acc[4 * g + 2], acc[4 * g + 3]}; } }
#pragma unroll
            for (int g = 0; g < 4; ++g) *(WK_LAS f32x4*)(NF + (32 * nb + (lane & 31)) * 64 + 32 * mb + 8 * g + 4 * h) = (f32x4){acc[4 * g], acc[4 * g + 1], acc[4 * g + 2], acc[4 * g + 3]};
        } else if (pr == 1) {
            if (!(mb == 1 && nb == 0)) { prod<false, false>(acc, I1, 0, mb, I0, 0, nb, lane); if (mb == nb) mask_diag<true>(acc, lane); }
            store_T(I3, 0, mb, nb, acc, lane);
        } else if (pr == 2) {
            if (!(mb == 1 && nb == 0)) { prod<false, false>(acc, I1, 0, mb, I1, 1, nb, lane); if (mb == nb) mask_diag<false>(acc, lane); }
            store_T(I4, 0, mb, nb, acc, lane);
        } else {
            if (!(mb == 1 && nb == 0)) { prod<false, false>(acc, I0, 1, mb, I1, 1, nb, lane); if (mb == nb) mask_diag<false>(acc, lane); }
            store_T(I4, 1, mb, nb, acc, lane);
        }
    }
    PBE(31);
    __syncthreads();
    WK_OPQ();
    PBS(32);
    f32x16 accA = zero16(), accB = zero16(), accC = zero16();
    const int omb = (w >> 1) & 1, onb = w & 1;
    if (w == 0) {
        f32x16 X[2], XT[2], R[2], RT[2];
        const int tt = lane & 31;
#pragma unroll
        for (int b = 0; b < 2; ++b) {
#pragma unroll
            for (int g = 0; g < 4; ++g) { const f32x4 v = *(const WK_LAS f32x4*)(ND + b * 1024 + (g * 64 + lane) * 4); XT[b][4 * g] = v.x; XT[b][4 * g + 1] = v.y; XT[b][4 * g + 2] = v.z; XT[b][4 * g + 3] = v.w; }
#pragma unroll
            for (int r = 0; r < 16; ++r) X[b][r] = NF[(32 * b + crow(r, h)) * 64 + 32 * b + tt];
#pragma unroll
            for (int r = 0; r < 16; ++r) { const float d = (crow(r, h) == tt) ? 1.f : 0.f; R[b][r] = d - X[b][r]; RT[b][r] = d - XT[b][r]; }
        }
        bf16x8 pX[2][2], pT[2][2], pR[2][2];
#pragma unroll
        for (int b = 0; b < 2; ++b) { pX[b][0] = pack8(X[b], 0); pX[b][1] = pack8(X[b], 1); }
#pragma unroll
        for (int it = 0; it < 4; ++it) {
#pragma unroll
            for (int b = 0; b < 2; ++b) { pT[b][0] = pack8(XT[b], 0); pT[b][1] = pack8(XT[b], 1); }
#pragma unroll
            for (int b = 0; b < 2; ++b) {
                X[b] = WK_MFMA(pT[b][0], pX[b][0], zero16()); X[b] = WK_MFMA(pT[b][1], pX[b][1], X[b]);
                if (it < 3) { XT[b] = WK_MFMA(pX[b][0], pT[b][0], zero16()); XT[b] = WK_MFMA(pX[b][1], pT[b][1], XT[b]); }
            }
#pragma unroll
            for (int b = 0; b < 2; ++b) { pX[b][0] = pack8(X[b], 0); pX[b][1] = pack8(X[b], 1); pR[b][0] = pack8(RT[b], 0); pR[b][1] = pack8(RT[b], 1); }
#pragma unroll
            for (int b = 0; b < 2; ++b) {
                R[b] = WK_MFMA(pR[b][0], pX[b][0], R[b]); R[b] = WK_MFMA(pR[b][1], pX[b][1], R[b]);
                if (it < 3) { RT[b] = WK_MFMA(pX[b][0], pR[b][0], RT[b]); RT[b] = WK_MFMA(pX[b][1], pR[b][1], RT[b]); }
            }
        }
        store_T(I2, 1, 0, 0, R[0], lane); store_T(I2, 1, 1, 1, R[1], lane);
        if (h == 0) {
#pragma unroll
            for (int c4 = 0; c4 < 4; ++c4) *(WK_LAS u32x4*)(I2 + off_b(tt, 8 + 4 + c4)) = (u32x4){0u, 0u, 0u, 0u};
        }
    } else if (w < 4) {
        prod<false, true>(accA, I4, 0, omb, I2, 0, onb, lane);
        if (w == 1) prod<false, true>(accC, I4, 0, 0, I2, 0, 0, lane);
    } else {
        prod<true, true>(accA, I1, 0, omb, I2, 0, onb, lane);
        f32x16 q = zero16(); prod<true, false>(q, I2, 0, omb, I3, 0, onb, lane); store_T(I3, 1, omb, onb, q, lane);
    }
    WK_OPQ();
    if (w == 0) {
        f32x16 t1 = zero16();
#pragma unroll
        for (int ks = 0; ks < 2; ++ks) {
            const WK_LAS float* np = NF + (lane & 31) * 64 + 32 + 16 * ks + 8 * h; const f32x4 n0 = *(const WK_LAS f32x4*)np, n1 = *(const WK_LAS f32x4*)(np + 4);
            const bf16x8 a = __builtin_bit_cast(bf16x8, (u32x4){pkbf(n0.x, n0.y), pkbf(n0.z, n0.w), pkbf(n1.x, n1.y), pkbf(n1.z, n1.w)});
            t1 = WK_MFMA(a, frag_row(I2, 1, 1, 2 + ks, lane), t1);
        }
        store_T(I6, 0, 0, 0, t1, lane);
        f32x16 m01 = zero16();
#pragma unroll
        for (int ks = 0; ks < 2; ++ks) m01 = WK_MFMA(frag_tr(I2, 1, 0, ks, lane), frag_row(I6, 0, 0, ks, lane), m01);
#pragma unroll
        for (int r = 0; r < 16; ++r) m01[r] = -m01[r];
        store_T(I2, 1, 0, 1, m01, lane);
    }
    PBE(32);
    __syncthreads();
    WK_OPQ();
    PBS(33);
    {
        f32x16 acc = zero16();
        if (w < 4) { prod<true, false>(acc, I0, 0, omb, I2, 1, onb, lane); store_T(I5, 0, omb, onb, acc, lane); }
        else       { prod<true, false>(acc, I3, 1, omb, I2, 1, onb, lane); store_T(I5, 1, omb, onb, acc, lane); }
    }
    PBE(33);
    __syncthreads();
    WK_OPQ();
#pragma unroll
    for (int a = 0; a < 6; ++a) asm volatile("" :: "v"(P.x[a]));
    PBS(34);
    if (w < 4) {
        f32x16 acc = zero16();
        prod<true, false>(acc, I5, 0, omb, I4, 1, onb, lane);
        { const unsigned row = 32 * onb + (lane & 31);
#pragma unroll
            for (int g = 0; g < 4; ++g) { const u32x2 rv = *(const WK_LAS u32x2*)(I1 + off_b(row, 8 + 4 * omb + g) + 8 * h);
                acc[4 * g] = __builtin_bit_cast(float, rv.x << 16) - acc[4 * g]; acc[4 * g + 1] = __builtin_bit_cast(float, rv.x & 0xffff0000u) - acc[4 * g + 1];
                acc[4 * g + 2] = __builtin_bit_cast(float, rv.y << 16) - acc[4 * g + 2]; acc[4 * g + 3] = __builtin_bit_cast(float, rv.y & 0xffff0000u) - acc[4 * g + 3]; } }
#pragma unroll
        for (int s = 0; s < 2; ++s) *(bf16x8*)(urec + UNIT_RF + (((omb * 2 + onb) * 2 + s) * 64 + lane) * 16) = pack8(acc, s);
        if (w >= 1) {
            prod<false, true>(accB, I4, 1, omb, I5, 1, onb, lane);
#pragma unroll
            for (int r = 0; r < 16; ++r) accA[r] -= accB[r];
            store_tile_bf16(urec + UNIT_Y0 + (omb * 2 + onb) * 2048, accA, lane);
            if (w == 1) { f32x16 b2 = zero16(); prod<false, true>(b2, I4, 1, 0, I5, 1, 0, lane);
#pragma unroll
                for (int r = 0; r < 16; ++r) accC[r] -= b2[r];
                store_tile_bf16(urec + UNIT_Y0, accC, lane); }
        }
    } else {
        f32x16 x = zero16();
        prod<true, true>(x, I5, 0, omb, I0, 1, onb, lane);
        const float gj = GAM[32 * onb + (lane & 31)];
#pragma unroll
        for (int r = 0; r < 16; ++r) x[r] = gj * (((32 * omb + crow(r, h)) == (32 * onb + (lane & 31)) ? 1.f : 0.f) - x[r]);
#pragma unroll
        for (int s = 0; s < 2; ++s) *(bf16x8*)(urec + UNIT_GF + (((omb * 2 + onb) * 2 + s) * 64 + lane) * 16) = pack8(x, s);
        prod<true, true>(accB, I0, 1, omb, I5, 1, onb, lane);
#pragma unroll
        for (int g = 0; g < 4; ++g) { const f32x4 gv = *(const WK_LAS f32x4*)(GAM + 32 * omb + 8 * g + 4 * h);
            accA[4 * g] = gv.x * (accA[4 * g] - accB[4 * g]); accA[4 * g + 1] = gv.y * (accA[4 * g + 1] - accB[4 * g + 1]); accA[4 * g + 2] = gv.z * (accA[4 * g + 2] - accB[4 * g + 2]); accA[4 * g + 3] = gv.w * (accA[4 * g + 3] - accB[4 * g + 3]); }
        store_tile_bf16(urec + UNIT_HT + (omb * 2 + onb) * 2048, accA, lane);
    }
    PBE(34);
    __syncthreads();
#undef WK_OPQ
}
constexpr int R2_NS = 8, R2_CTL = R2_NS * 4096;
struct R2G { bf16x8 g[8]; u32x4 h[2][2]; };
__device__ __forceinline__ void r2_ld_g(R2G& X, const unsigned char* u, int vb, int lane) {
#pragma unroll
    for (int f = 0; f < 8; ++f) X.g[f] = *(const bf16x8*)(u + UNIT_GF + (f * 64 + lane) * 16);
#pragma unroll
    for (int mbk = 0; mbk < 2; ++mbk)
#pragma unroll
        for (int q = 0; q < 2; ++q) X.h[mbk][q] = *(const u32x4*)(u + UNIT_HT + (mbk * 2 + vb) * 2048 + (q * 64 + lane) * 16);
}
__device__ __forceinline__ void r2_step_a(f32x16& S0, f32x16& S1, const R2G& X, WK_LAS unsigned char* L, int ci, int lane) {
    volatile WK_LAS unsigned* ctl = (volatile WK_LAS unsigned*)(L + R2_CTL);
    if (ci >= R2_NS) { unsigned sp_ = 0; while (((int)ctl[1] < ci - R2_NS + 1 || (int)ctl[2] < ci - R2_NS + 1) && ++sp_ < (1u << 22)) __builtin_amdgcn_s_sleep(1); }
    const bf16x8 s00 = pack8(S0, 0), s01 = pack8(S0, 1), s10 = pack8(S1, 0), s11 = pack8(S1, 1);
    WK_LAS bf16x8* slot = (WK_LAS bf16x8*)(L + (ci % R2_NS) * 4096) + lane;
    slot[0] = s00; slot[64] = s01; slot[128] = s10; slot[192] = s11;
    asm volatile("s_waitcnt lgkmcnt(0)" ::: "memory");
    if (lane == 0) ctl[0] = (unsigned)(ci + 1);
    f32x16 h0, h1; unpack_tile_bf16(h0, X.h[0][0], X.h[0][1]); unpack_tile_bf16(h1, X.h[1][0], X.h[1][1]);
    h0 = WK_MFMA(X.g[0], s00, h0); h0 = WK_MFMA(X.g[1], s01, h0); h0 = WK_MFMA(X.g[4], s10, h0); h0 = WK_MFMA(X.g[5], s11, h0);
    h1 = WK_MFMA(X.g[2], s00, h1); h1 = WK_MFMA(X.g[3], s01, h1); h1 = WK_MFMA(X.g[6], s10, h1); h1 = WK_MFMA(X.g[7], s11, h1);
    S0 = h0; S1 = h1;
}
struct R2Rh { bf16x8 r[4]; u32x4 y[2]; };
__device__ __forceinline__ void r2_ld_rh(R2Rh& X, const unsigned char* u, int vb, int tb, int lane) {
#pragma unroll
    for (int ib = 0; ib < 2; ++ib)
#pragma unroll
        for (int s = 0; s < 2; ++s) X.r[ib * 2 + s] = *(const bf16x8*)(u + UNIT_RF + ((((ib * 2 + tb) * 2 + s) * 64) + lane) * 16);
#pragma unroll
    for (int q = 0; q < 2; ++q) X.y[q] = *(const u32x4*)(u + UNIT_Y0 + (tb * 2 + vb) * 2048 + (q * 64 + lane) * 16);
}
__device__ __forceinline__ void r2_step_b(R2Rh& X, const unsigned char* unext, WK_LAS unsigned char* L, int ci, unsigned short* Yo, int brow0, int dir, int col0, int vb, int tb, int lane) {
    volatile WK_LAS unsigned* ctl = (volatile WK_LAS unsigned*)(L + R2_CTL);
    { unsigned sp_ = 0; while ((int)ctl[0] < ci + 1 && ++sp_ < (1u << 22)) __builtin_amdgcn_s_sleep(1); }
    asm volatile("" ::: "memory");
    const WK_LAS bf16x8* slot = (const WK_LAS bf16x8*)(L + (ci % R2_NS) * 4096) + lane;
    const bf16x8 s00 = slot[0], s01 = slot[64], s10 = slot[128], s11 = slot[192];
    f32x16 yo; unpack_tile_bf16(yo, X.y[0], X.y[1]);
    yo = WK_MFMA(X.r[0], s00, yo); yo = WK_MFMA(X.r[1], s01, yo); yo = WK_MFMA(X.r[2], s10, yo); yo = WK_MFMA(X.r[3], s11, yo);
    asm volatile("s_waitcnt lgkmcnt(0)" ::: "memory");
    if (lane == 0) ctl[1 + tb] = (unsigned)(ci + 1);
    r2_ld_rh(X, unext, vb, tb, lane);
    const int uc = dir == 0 ? ci : (ci < 4 ? 3 - ci : 71 - ci);
    int lo_ = lane; asm volatile("" : "+v"(lo_));
    WK_LAS unsigned short* ys = (WK_LAS unsigned short*)(L + R2_CTL + 256 + tb * 2048);
    const int n_ = lo_ & 31, h_ = lo_ >> 5;
#pragma unroll
    for (int r = 0; r < 16; r += 2) { const unsigned pr_ = pkbf(yo[r], yo[r + 1]);
        ys[((r & 3) + 8 * (r >> 2) + 4 * h_) * 32 + n_] = (unsigned short)pr_; ys[(((r + 1) & 3) + 8 * ((r + 1) >> 2) + 4 * h_) * 32 + n_] = (unsigned short)(pr_ >> 16); }
    asm volatile("s_waitcnt lgkmcnt(0)" ::: "memory");
#pragma unroll
    for (int k = 0; k < 2; ++k) { const int pl = 16 * k + (lo_ >> 2), pos = 32 * tb + pl; const u32x4 v = *(const WK_LAS u32x4*)((const WK_LAS unsigned char*)ys + pl * 64 + (lo_ & 3) * 16);
        *(u32x4*)(Yo + (size_t)(brow0 + 64 * uc + (dir ? 63 - pos : pos)) * BW + col0 + 32 * vb + (lo_ & 3) * 8) = v; }
    asm volatile("s_waitcnt lgkmcnt(0)" ::: "memory");
}
__device__ __forceinline__ void wkv_r2_chain(const unsigned char* urec0, unsigned short* Yo, int brow0, int dir, int col0, int vb, int lane, int role, WK_LAS unsigned char* L) {
#define R2_U(ci_) (urec0 + (size_t)((ci_) < 68 ? (ci_) : 67) * UNIT_BYTES)
    if (role == 0) {
        f32x16 S0 = zero16(), S1 = zero16();
        R2G X0, X1; r2_ld_g(X0, R2_U(0), vb, lane); r2_ld_g(X1, R2_U(1), vb, lane);
        for (int ci = 0; ci < 68; ci += 2) {
            r2_step_a(S0, S1, X0, L, ci, lane);     r2_ld_g(X0, R2_U(ci + 2), vb, lane);
            r2_step_a(S0, S1, X1, L, ci + 1, lane); r2_ld_g(X1, R2_U(ci + 3), vb, lane);
        }
    } else {
        const int tb = role - 1;
        R2Rh X0, X1, X2, X3; r2_ld_rh(X0, R2_U(0), vb, tb, lane); r2_ld_rh(X1, R2_U(1), vb, tb, lane); r2_ld_rh(X2, R2_U(2), vb, tb, lane); r2_ld_rh(X3, R2_U(3), vb, tb, lane);
        for (int ci = 0; ci < 68; ci += 4) {
            r2_step_b(X0, R2_U(ci + 4), L, ci, Yo, brow0, dir, col0, vb, tb, lane);
            r2_step_b(X1, R2_U(ci + 5), L, ci + 1, Yo, brow0, dir, col0, vb, tb, lane);
            r2_step_b(X2, R2_U(ci + 6), L, ci + 2, Yo, brow0, dir, col0, vb, tb, lane);
            r2_step_b(X3, R2_U(ci + 7), L, ci + 3, Yo, brow0, dir, col0, vb, tb, lane);
        }
    }
#undef R2_U
}
#undef WK_LAS
#undef WK_MFMA
}
__device__ __forceinline__ void ph_wkv_r1(const Ctx& F, const Args& A, int l) {
    const bf16* STR = (const bf16*)(A.ws + WS_STR);
#define R1_UNIT_SETUP(u_, in_, row0_, rstep_, col0_) do { const int ci_ = (u_) % 68, hd_ = ((u_) / 68) & 15, dir_ = ((u_) / (68 * 16)) & 1, b_ = (u_) / (68 * 32); \
        const int uc_ = dir_ == 0 ? ci_ : (ci_ < 4 ? 3 - ci_ : 71 - ci_); \
        in_.R = STR; in_.KS = STR + (size_t)M * BW; in_.VS = STR + 2 * (size_t)M * BW; in_.KK = STR + 3 * (size_t)M * BW; \
        in_.E = (const _Float16*)(A.ws + WS_LO) + (size_t)dir_ * M * BW; in_.Aa = (const bf16*)(A.ws + WS_AG) + (size_t)dir_ * M * BW; in_.ka = A.in[21] + l * BW; \
        row0_ = b_ * SU + 64 * uc_ + (dir_ ? 63 : 0); rstep_ = dir_ ? -1 : 1; col0_ = 64 * hd_; } while (0)
    constexpr int NU = 2 * 2 * 16 * 68;
    wk::R1Pre P; wk::R1In in, inN; int row0, rstep, col0, row0N = 0, rstepN = 1, col0N = 0;
    int u = F.vcu;
    if (u < NU) { R1_UNIT_SETUP(u, in, row0, rstep, col0); wk::r1_load(P, in, row0, rstep, col0, F.tid); }
    for (; u < NU; u += F.G) {
        const bool hn = (u + F.G) < NU; inN = in;
        if (hn) R1_UNIT_SETUP(u + F.G, inN, row0N, rstepN, col0N);
        wk::wkv_r1_unit(F.lds, in, P, col0, A.ws + WS_RW + (size_t)u * wk::UNIT_BYTES, F.tid, hn, inN, row0N, rstepN, col0N);
        in = inN; col0 = col0N;
    }
#undef R1_UNIT_SETUP
}
__device__ __forceinline__ void ph_attn(const Ctx& F, const Args& A, int l, char* ldsg) {
    const bool last = (l == DEPTH - 1);
    typedef attn_body::bf16 abf;
    for (int i = 0;; ++i) {
        int u;
        if (F.G == 256) { if (i == 0) u = F.vcu; else if (F.vcu < 128 || i > 3) break; else if (i < 3) u = 256 + 2 * (F.vcu - 128) + (i - 1); else { if (last || F.vcu >= 160) break; u = 512 + (F.vcu - 128); } }
        else { u = i * F.G + F.vcu; if (u >= (last ? 512 : 544)) break; }
        attn_body::AttnJob J;
        if (u < 256) {
            const int b = u >> 7, h = (u >> 4) & 7, qb = u & 15; const size_t r0 = (size_t)b * SU, q0 = r0 + CT + (size_t)qb * 256;
            J.Qw0 = (const abf*)(((bf16*)(A.ws + WS_QC)) + q0 * 512 + h * 64); J.Kh = (const abf*)(((bf16*)(A.ws + WS_KC)) + r0 * 128 + (h >> 2) * 64); J.Vh = (const abf*)(((bf16*)(A.ws + WS_P)) + r0 * NINP + PC_V + (h >> 2) * 64);
            J.o_off = (unsigned)(q0 * D + 1536 + h * 64); J.NT = 68; J.lat_lo = 0; J.qpos0 = 0; J.sidx = -1;
            attn_body::attn_unit<0, 8>(J, A, ldsg, F.wave);
        } else if (u < 512) {
            const int w = u - 256, b = w >> 7, h = (w >> 4) & 7, qb = w & 15; const size_t r0 = (size_t)b * SU, q0 = r0 + CT + (size_t)qb * 256;
            const int lo = (4 * qb - 2) < 0 ? 0 : 4 * qb - 2, hi = (4 * qb + 5) > 63 ? 63 : 4 * qb + 5;
            J.Qw0 = (const abf*)(((bf16*)(A.ws + WS_QA)) + q0 * 512 + h * 64); J.Kh = (const abf*)(((bf16*)(A.ws + WS_KA)) + r0 * 128 + (h >> 2) * 64); J.Vh = (const abf*)(((bf16*)(A.ws + WS_P)) + r0 * NINP + PA_V + (h >> 2) * 64);
            J.o_off = (unsigned)(q0 * D + h * 64); J.NT = 4 + (hi - lo + 1); J.lat_lo = lo; J.qpos0 = qb * 256; J.sidx = l * 8 + h;
            attn_body::attn_unit<1, 8>(J, A, ldsg, F.wave);
        } else {
            const int c = u - 512, part = c >> 4, b = (c >> 3) & 1, h = c & 7; const size_t r0 = (size_t)b * SU;
            J.Qw0 = (const abf*)((part ? ((bf16*)(A.ws + WS_QC)) : ((bf16*)(A.ws + WS_QA))) + r0 * 512 + h * 64); J.Kh = (const abf*)((part ? ((bf16*)(A.ws + WS_KC)) : ((bf16*)(A.ws + WS_KA))) + r0 * 128 + (h >> 2) * 64);
            J.Vh = (const abf*)(((bf16*)(A.ws + WS_P)) + r0 * NINP + (part ? PC_V : PA_V) + (h >> 2) * 64); J.o_off = (unsigned)(r0 * D + (part ? 1536 : 0) + h * 64);
            J.NT = 4; J.lat_lo = 0; J.qpos0 = 0; J.sidx = part ? -1 : l * 8 + h;
            attn_body::attn_unit<0, 8>(J, A, ldsg, F.wave);
        }
    }
    if (F.tid < 4) ((volatile LAS unsigned*)(F.lds + wk::R2_CTL))[F.tid] = 0u;
    __syncthreads();
    { PB_BEGIN(12);
      for (int hc = F.vcu; hc < 128; hc += F.G) if (F.wave < 3) {
          const int ch = hc >> 1, b = ch >> 5, hd = (ch >> 1) & 15, dir = ch & 1;
          wk::wkv_r2_chain(A.ws + WS_RW + (size_t)(((b * 2 + dir) * 16 + hd) * 68) * wk::UNIT_BYTES, (bf16*)(A.ws + WS_Y) + (size_t)dir * M * BW, b * SU, dir, 64 * hd, hc & 1, F.lane, F.wave, F.lds);
      }
      PB_END(12); }
}
#define MKARGS() const __attribute__((address_space(4))) Args* ap_ = (const __attribute__((address_space(4))) Args*)__builtin_amdgcn_kernarg_segment_ptr(); asm volatile("" : "+s"(ap_)); const Args& A = *(const Args*)ap_
#define MKCTX() MKARGS(); Ctx F; { int t_ = wv * 64 + hw_lane(); asm volatile("" : "+v"(t_)); F.lds = ldsb; F.tid = t_; F.lane = t_ & 63; F.wave = __builtin_amdgcn_readfirstlane(t_ >> 6); F.G = gridDim.x; \
        { const int bx = blockIdx.x; F.vcu = (F.G % 8 == 0) ? (bx % 8) * (F.G / 8) + bx / 8 : bx; } F.gw = F.vcu * NWAVES + F.wave; F.NGW = F.G * NWAVES; }
#ifndef ONLY_PHASE
#define ONLY_PHASE -1
#endif
#define EN(j) (ONLY_PHASE < 0 || ONLY_PHASE == (j))
#define IN(k) (lo <= (k) && (k) < hi)
#define SEAM(k) do { if (IN((k) + 1)) { if (MK_PER_PHASE) { if (wv == 0 && hw_lane() == 0) __hip_atomic_store(ctl + CW_TMO, 0xBADBA0u, RLX_AGENT); } else { xcd_barrier(bar, wv == 0 && hw_lane() == 0); if (PROBE_PHASE == 20) xcd_barrier(bar, wv == 0 && hw_lane() == 0); } } } while (0)
template <int l> __device__ __forceinline__ void layer_phases(int wv, int lo, int hi, const XcdBarrier& bar, gu32* ctl, LAS unsigned char* const ldsb, unsigned char* lds_raw) {
        const int pb = 2 + PPL * l; const bool last = (l == DEPTH - 1);
        if (EN(2) && IN(pb + 0)) { MKCTX(); PB_BEGIN(2); ph_norm(F, A, l, 0); PB_END(2); SEAM(pb + 0); }
        if (EN(3) && IN(pb + 1)) {
            MKARGS();
            pg8::Gemm g{((bf16*)(A.ws + WS_U)), ((bf16*)(A.ws + WS_WIN)) + (size_t)l * NINP * D, M, NINP, D}; pg8::StaticOrder S; S.init(M, NINP, (int)gridDim.x, (int)blockIdx.x);
            pg8::EpiBf16<0> E{((bf16*)(A.ws + WS_P)), NINP, nullptr, 0, 0, 1.f};
            PB_BEGIN(3);
            pg8::gemm_phase<pg8::EpiBf16<0>, pg8::StaticOrder, true, true>(ldsb, g, S, E, wv * 64 + hw_lane());
            if ((int)gridDim.x == 256 && (int)blockIdx.x >= 202) { MKCTX(); convert_items(F, A, l, 1, 0, CI_OUT, ((int)blockIdx.x - 202) * NWAVES + F.wave, 54 * NWAVES); }
            PB_END(3);
            SEAM(pb + 1);
        }
        if (EN(4) && IN(pb + 2)) { MKCTX(); PB_BEGIN(4); ph_prep(F, A, l); PB_END(4); SEAM(pb + 2); }
        if (EN(5) && IN(pb + 3)) {
            MKARGS();
            pg8::Gemm g{((bf16*)(A.ws + WS_LA)), ((bf16*)(A.ws + WS_LW)) + (size_t)l * 5 * 1024 * 256, 5 * M, 5 * 1024, 256}; pg8::LoraOrder S{(int)gridDim.x, (int)blockIdx.x};
            pg8::EpiLora E{((_Float16*)(A.ws + WS_LO)), (bf16*)(A.ws + WS_AG), (A.in[15]) + (size_t)l * 2 * BW, (A.in[17]) + (size_t)l * 2 * BW};
            PB_BEGIN(5);
            pg8::gemm_phase<pg8::EpiLora, pg8::LoraOrder, true, true>(ldsb, g, S, E, wv * 64 + hw_lane());
            PB_END(5);
            SEAM(pb + 3);
        }
        if (EN(13) && IN(pb + 4)) { MKCTX(); PB_BEGIN(13); ph_wkv_r1(F, A, l); PB_END(13); SEAM(pb + 4); }
        if (EN(6) && IN(pb + 5)) { MKCTX(); PB_BEGIN(6); ph_attn(F, A, l, (char*)lds_raw); PB_END(6); SEAM(pb + 5); }
        if (EN(7) && IN(pb + 6)) { MKCTX(); PB_BEGIN(7); ph_readout(F, A, l); PB_END(7); SEAM(pb + 6); }
        if (EN(8) && IN(pb + 7)) {
            MKARGS();
            pg8::Gemm g{((bf16*)(A.ws + WS_MIX)), ((bf16*)(A.ws + WS_WOUT)) + (size_t)l * D * D, M, D, D}; pg8::RowMapOrder S; S.init2(D, D, (int)gridDim.x, (int)blockIdx.x, last ? 1 : 0, 8);
            pg8::EpiResid E{l == 0 ? (A.in[0]) : (A.out), l == 0 ? (A.in[2]) : ((float*)(A.ws + WS_HCTX)), (A.out), ((float*)(A.ws + WS_HCTX)), ((float*)(A.ws + WS_MOD)) + (size_t)l * 3 * MODW + 2 * D, (float*)(A.ws + WS_SL)};
            PB_BEGIN(8);
            pg8::gemm_phase<pg8::EpiResid, pg8::RowMapOrder, true, true>(ldsb, g, S, E, wv * 64 + hw_lane());
            if (!last && (int)gridDim.x == 256 && (int)blockIdx.x >= 128) { MKCTX(); const int w0_ = ((int)blockIdx.x - 128) * NWAVES + F.wave, nw_ = 128 * NWAVES;
                convert_items(F, A, l, 2, 0, CI_1, w0_, nw_); convert_items(F, A, 3, 3, l * (CI_2 / 3 + 1), (l + 1) * (CI_2 / 3 + 1) < CI_2 ? (l + 1) * (CI_2 / 3 + 1) : CI_2, w0_, nw_); }
            PB_END(8);
            SEAM(pb + 7);
        }
        if (EN(9) && IN(pb + 8)) { MKCTX(); PB_BEGIN(9); ph_norm(F, A, l, 1); PB_END(9); SEAM(pb + 8); }
        if (EN(10) && IN(pb + 9)) {
            MKARGS();
            pg8::Gemm g{((bf16*)(A.ws + WS_U)), ((bf16*)(A.ws + WS_W1)) + (size_t)l * FF * D, M, FF, D}; pg8::RowMapOrder S; S.init2(FF, D, (int)gridDim.x, (int)blockIdx.x, last ? 1 : 0, 1);
            pg8::EpiRelu2 E{((bf16*)(A.ws + WS_HID)), FF};
            PB_BEGIN(10);
            pg8::gemm_phase<pg8::EpiRelu2, pg8::RowMapOrder, true, true>(ldsb, g, S, E, wv * 64 + hw_lane());
            if (!last && (int)gridDim.x == 256 && (int)blockIdx.x >= 64) { MKCTX(); const int w0_ = ((int)blockIdx.x - 64) * NWAVES + F.wave, nw_ = 192 * NWAVES;
                convert_items(F, A, l, 3, 0, CI_2, w0_, nw_); convert_items(F, A, 3, 2, l * (CI_1 / 3 + 1), (l + 1) * (CI_1 / 3 + 1) < CI_1 ? (l + 1) * (CI_1 / 3 + 1) : CI_1, w0_, nw_); }
            PB_END(10);
            SEAM(pb + 9);
        }
        if (EN(11) && IN(pb + 10)) {
            MKARGS();
            pg8::Gemm g{((bf16*)(A.ws + WS_HID)), ((bf16*)(A.ws + WS_W2)) + (size_t)l * D * FF, M, D, FF}; pg8::RowMapOrder S; S.init2(D, FF, (int)gridDim.x, (int)blockIdx.x, last ? 1 : 0, 8);
            pg8::EpiResid E{(A.out), ((float*)(A.ws + WS_HCTX)), (A.out), ((float*)(A.ws + WS_HCTX)), ((float*)(A.ws + WS_MOD)) + (size_t)l * 3 * MODW + 5 * D, (float*)(A.ws + WS_SL)};
            PB_BEGIN(11);
            pg8::gemm_phase<pg8::EpiResid, pg8::RowMapOrder, true, true>(ldsb, g, S, E, wv * 64 + hw_lane());
            if (!last && (int)gridDim.x == 256 && (int)blockIdx.x >= 128) { MKCTX(); convert_items(F, A, l + 1, 0, 0, CI_IN, ((int)blockIdx.x - 128) * NWAVES + F.wave, 128 * NWAVES); }
            PB_END(11);
            SEAM(pb + 10);
        }
}
__global__ void __launch_bounds__(NWAVES * 64, 2) fwd(Args args) {
    extern __shared__ __attribute__((aligned(16))) unsigned char lds_raw[];
    LAS unsigned char* const ldsb = (LAS unsigned char*)lds_raw;
    unsigned char* ws = args.ws;
    const int wv = __builtin_amdgcn_readfirstlane((int)threadIdx.x >> 6);
    for (int u = wv * 64 + hw_lane(); u < (LDS_BYTES - LDSCTL_OFF) / 4; u += NWAVES * 64) ((LAS unsigned*)(ldsb + LDSCTL_OFF))[u] = 0u;
    __syncthreads();
    gu32* ctl = (gu32*)(ws + WS_CTL);
    XcdBarrier bar; bar.bar = (unsigned*)(ctl + CW_BAR); bar.x = 0; bar.st = nullptr;
    if (!MK_PER_PHASE) bar = xcd_barrier_post((unsigned*)(ctl + CW_BAR), (volatile LAS unsigned*)(ldsb + MISC_OFF) + 8, wv == 0 && hw_lane() == 0);
    const int lo = args.ph_lo, hi = args.ph_hi;
    if (EN(0) && IN(0)) { MKCTX(); PB_BEGIN(0); p0_prologue(F, A); PB_END(0); SEAM(0); }
    if (EN(1) && IN(1)) { MKCTX(); PB_BEGIN(1); p0b_mods(F, A); PB_END(1); SEAM(1); }
    layer_phases<0>(wv, lo, hi, bar, ctl, ldsb, lds_raw); layer_phases<1>(wv, lo, hi, bar, ctl, ldsb, lds_raw); layer_phases<2>(wv, lo, hi, bar, ctl, ldsb, lds_raw); layer_phases<3>(wv, lo, hi, bar, ctl, ldsb, lds_raw);
#undef IN
#undef SEAM
}
extern "C" void kernel_launch(void* const* d_in, const int* in_sizes, int n_in, void* d_out, int out_size, void* d_ws, size_t ws_size, hipStream_t stream) {
    static int grid = 0;
    if (grid == 0) {
        if (n_in != 28 || out_size != NB * T * D || ws_size < WS_END) { fprintf(stderr, "kernel_launch: unexpected shapes (n_in %d, out %d, ws %zu < %zu)\n", n_in, out_size, ws_size, (size_t)WS_END); grid = -1; return; }
        int dev = 0, cus = 0, per_cu = 0;
        if (hipGetDevice(&dev) != hipSuccess || hipDeviceGetAttribute(&cus, hipDeviceAttributeMultiprocessorCount, dev) != hipSuccess) { grid = -1; return; }
        if (hipFuncSetAttribute((const void*)fwd, hipFuncAttributeMaxDynamicSharedMemorySize, LDS_BYTES) != hipSuccess) { fprintf(stderr, "kernel_launch: hipFuncSetAttribute failed\n"); grid = -1; return; }
        if (hipOccupancyMaxActiveBlocksPerMultiprocessor(&per_cu, (const void*)fwd, NWAVES * 64, LDS_BYTES) != hipSuccess || per_cu < 1) fprintf(stderr, "kernel_launch: occupancy query reports %d\n", per_cu);
        (void)hipGetLastError();
        grid = cus;
    }
    if (grid < 0) return;
    if (hipMemsetAsync((char*)d_ws + WS_CTL, 0, CTL_ZERO_BYTES, stream) != hipSuccess) return;
    Args a{};
    for (int i = 0; i < 28; ++i) a.in[i] = (const float*)d_in[i];
    a.out = (float*)d_out; a.ws = (unsigned char*)d_ws;
#if MK_PER_PHASE
    for (int p = 0; p < N_PHASES; ++p) { a.ph_lo = p; a.ph_hi = p + 1; hipLaunchKernelGGL(fwd, dim3(grid), dim3(NWAVES * 64), LDS_BYTES, stream, a); }
#else
    a.ph_lo = 0; a.ph_hi = N_PHASES;
    hipLaunchKernelGGL(fwd, dim3(grid), dim3(NWAVES * 64), LDS_BYTES, stream, a);
#endif
    const hipError_t le = hipPeekAtLastError();
    if (le != hipSuccess) fprintf(stderr, "kernel_launch: launch failed: %s\n", hipGetErrorName(le));
}
```

```cpp
#include <hip/hip_runtime.h>
#include <cstdio>
#include <cstdint>
namespace pg8 {
#define PG8_LAS __attribute__((address_space(3)))
typedef unsigned short bf16_t;
typedef short bf16x8 __attribute__((ext_vector_type(8)));
typedef float f32x4 __attribute__((ext_vector_type(4)));
typedef unsigned u32x4 __attribute__((ext_vector_type(4)));
constexpr int BM = 256, BK = 64, HALF = 128, HTB = HALF * BK * 2  , STAGE_BYTES = 8 * HTB, NXCD = 8, WGM = 8;

__host__ __device__ __forceinline__ int lds_byte(int r, int c) { const int st = (r >> 4) * 2 + (c >> 5), rr = r & 15, cc = c & 31, ob = rr * 64 + cc * 2; return st * 1024 + (ob ^ (((ob >> 9) & 1) << 5)); }
__host__ __device__ __forceinline__ void stage_rc(int b, int& R, int& C) { const int st = b / 1024, sb = b % 1024, swz = sb ^ (((sb >> 9) & 1) << 5); R = (st >> 1) * 16 + swz / 64; C = (st & 1) * 32 + (swz % 64) / 2; }
__host__ __device__ __forceinline__ int perm32(int rho) { const int n = rho >> 4, i = rho & 15; return 8 * (i >> 2) + 4 * n + (i & 3); }

struct Unit { int pm, pn, k0, nt, slice; };
struct Gemm { const bf16_t* A; const bf16_t* Bt; int M, N, K; };

struct StaticOrder {
    int nM, nN, nwg, G, c;
    __host__ __device__ void init(int M, int N, int G_, int c_) { nM = M / BM; nN = N / BM; nwg = nM * nN; G = G_; c = c_; }
    __host__ __device__ bool next(int i, Unit& u) const {
        const long L = (long)i * G + c; if (L >= nwg) return false;
        int wgid = (int)L; { const int q = nwg / NXCD, r = nwg % NXCD, xcd = wgid % NXCD, off = wgid / NXCD; wgid = (xcd < r ? xcd * (q + 1) : r * (q + 1) + (xcd - r) * q) + off; }
        const int nig = WGM * nN, gid = wgid / nig, fm = gid * WGM, gsz = (nM - fm) < WGM ? (nM - fm) : WGM;
        u.pm = fm + ((wgid % nig) % gsz); u.pn = (wgid % nig) / gsz; u.k0 = 0; u.nt = 0; u.slice = -1; return true;
    }
    __device__ __forceinline__ void a_ready(const Unit&) const {}
    __device__ __forceinline__ void done(const Unit&) const {}
};

__device__ __forceinline__ unsigned cvt_pk_bf16(float lo, float hi) { unsigned r; asm volatile("v_cvt_pk_bf16_f32 %0, %1, %2" : "=v"(r) : "v"(lo), "v"(hi)); return r; }
typedef float f32x2 __attribute__((ext_vector_type(2)));
__device__ __forceinline__ f32x2 gelu_pk(f32x2 v) {
    const f32x2 av = __builtin_elementwise_abs(v), d = av * 0.2316418882f + 1.0f;
    f32x2 t; t.x = __builtin_amdgcn_rcpf(d.x); t.y = __builtin_amdgcn_rcpf(d.y);
    f32x2 q = t * 0.5307027145f + (-0.7265760135f); q = q * t + 0.7107068705f; q = q * t + (-0.142248368f); q = q * t + 0.127414796f; q = q * t;
    const f32x2 s = (v * v) * (-0.72134752044f);
    f32x2 e; e.x = __builtin_amdgcn_exp2f(s.x); e.y = __builtin_amdgcn_exp2f(s.y);
    const f32x2 m = v * (q * e), r = v - m;
    f32x2 o; o.x = v.x < 0.f ? m.x : r.x; o.y = v.y < 0.f ? m.y : r.y; return o;
}

template <int ACT  > struct EpiBf16 {
    static constexpr bool PERM = true, AFTER_DRAIN = false; static_assert(ACT == 0 || ACT == 1, "EpiBf16: ACT is 0 (none) or 1 (gelu_pk)");
    bf16_t* O; int ldc; const float* bias; int split_cols; size_t split_stride; float scale0;
    __device__ __forceinline__ void operator()(const f32x4 (&acc)[2][2][4][2], const Unit& u, int wr, int wc, int fr, int fq) const {
        const int row0 = u.pm * BM + wr * 64 + fr; int colt = u.pn * BM; bf16_t* base = O;
        float sc = 1.f; if (split_cols) { const int t = colt / split_cols; base += (size_t)t * split_stride; colt -= t * split_cols; if (t == 0) sc = scale0; }
        const int col0 = colt + wc * 32 + 8 * fq, bcol0 = u.pn * BM + wc * 32 + 8 * fq;
        f32x4 bv[2][2];
#pragma unroll
        for (int bj = 0; bj < 2; ++bj)
#pragma unroll
            for (int n = 0; n < 2; ++n) bv[bj][n] = bias ? *(const f32x4*)(bias + bcol0 + bj * HALF + 4 * n) : (f32x4){0.f, 0.f, 0.f, 0.f};
#pragma unroll
        for (int ai = 0; ai < 2; ++ai)
#pragma unroll
            for (int m = 0; m < 4; ++m) { bf16_t* rowp = base + (size_t)(row0 + ai * HALF + m * 16) * ldc + col0;
#pragma unroll
                for (int bj = 0; bj < 2; ++bj) { f32x4 v0 = acc[ai][bj][m][0] + bv[bj][0], v1 = acc[ai][bj][m][1] + bv[bj][1];
                    if (ACT == 1) { f32x2 a = gelu_pk((f32x2){v0[0], v0[1]}), b = gelu_pk((f32x2){v0[2], v0[3]}), c = gelu_pk((f32x2){v1[0], v1[1]}), d = gelu_pk((f32x2){v1[2], v1[3]});
                        v0 = (f32x4){a.x, a.y, b.x, b.y}; v1 = (f32x4){c.x, c.y, d.x, d.y}; }
                    v0 = v0 * sc; v1 = v1 * sc; u32x4 w; w.x = cvt_pk_bf16(v0[0], v0[1]); w.y = cvt_pk_bf16(v0[2], v0[3]); w.z = cvt_pk_bf16(v1[0], v1[1]); w.w = cvt_pk_bf16(v1[2], v1[3]);
                    *(u32x4*)(rowp + bj * HALF) = w; } }
    }
};
struct EpiRelu2 {
    static constexpr bool PERM = true, AFTER_DRAIN = false;
    bf16_t* O; int ldc;
    __device__ __forceinline__ void operator()(const f32x4 (&acc)[2][2][4][2], const Unit& u, int wr, int wc, int fr, int fq) const {
        const int row0 = u.pm * BM + wr * 64 + fr, col0 = u.pn * BM + wc * 32 + 8 * fq;
#pragma unroll
        for (int ai = 0; ai < 2; ++ai)
#pragma unroll
            for (int m = 0; m < 4; ++m) { bf16_t* rowp = O + (size_t)(row0 + ai * HALF + m * 16) * ldc + col0;
#pragma unroll
                for (int bj = 0; bj < 2; ++bj) { f32x4 v0 = acc[ai][bj][m][0], v1 = acc[ai][bj][m][1];
#pragma unroll
                    for (int e = 0; e < 4; ++e) { const float a = v0[e] > 0.f ? v0[e] : 0.f, b = v1[e] > 0.f ? v1[e] : 0.f; v0[e] = a * a; v1[e] = b * b; }
                    u32x4 w; w.x = cvt_pk_bf16(v0[0], v0[1]); w.y = cvt_pk_bf16(v0[2], v0[3]); w.z = cvt_pk_bf16(v1[0], v1[1]); w.w = cvt_pk_bf16(v1[2], v1[3]);
                    *(u32x4*)(rowp + bj * HALF) = w; } }
    }
};
struct EpiResid {
    static constexpr bool PERM = false, AFTER_DRAIN = false;
    const float* src_lat; const float* src_ctx; float* dst_lat; float* dst_ctx; const float* gate; float* slab;
    __device__ __forceinline__ void operator()(const f32x4 (&acc)[2][2][4][2], const Unit& u, int wr, int wc, int fr, int fq) const {
        if (u.slice >= 0) {
            float* sl = slab + ((size_t)u.slice * 512 + (size_t)(u.pm / 17) * 256) * 2048; const int r0s = wr * 64 + fr, c0s = u.pn * BM + wc * 32 + 4 * fq;
#pragma unroll
            for (int ai = 0; ai < 2; ++ai)
#pragma unroll
                for (int m = 0; m < 4; ++m) { float* rp = sl + (size_t)(r0s + ai * HALF + m * 16) * 2048 + c0s;
#pragma unroll
                    for (int bj = 0; bj < 2; ++bj)
#pragma unroll
                        for (int n = 0; n < 2; ++n) *(f32x4*)(rp + bj * HALF + n * 16) = acc[ai][bj][m][n]; }
            return;
        }
        const int b = u.pm / 17, j = u.pm % 17; const bool isctx = (j == 0);
        const float* src = isctx ? src_ctx + (size_t)b * 256 * 2048 : src_lat + ((size_t)b * 4096 + (size_t)(j - 1) * 256) * 2048;
        float* dst = isctx ? dst_ctx + (size_t)b * 256 * 2048 : dst_lat + ((size_t)b * 4096 + (size_t)(j - 1) * 256) * 2048;
        const float* g = gate + (isctx ? 2 : b) * 12288;
        const int r0 = wr * 64 + fr, col0 = u.pn * BM + wc * 32 + 4 * fq;
        f32x4 gv[2][2];
#pragma unroll
        for (int bj = 0; bj < 2; ++bj)
#pragma unroll
            for (int n = 0; n < 2; ++n) gv[bj][n] = *(const f32x4*)(g + col0 + bj * HALF + n * 16);
#pragma unroll
        for (int ai = 0; ai < 2; ++ai)
#pragma unroll
            for (int m = 0; m < 4; ++m) { const size_t roff = (size_t)(r0 + ai * HALF + m * 16) * 2048 + col0;
#pragma unroll
                for (int bj = 0; bj < 2; ++bj)
#pragma unroll
                    for (int n = 0; n < 2; ++n) { const f32x4 s = *(const f32x4*)(src + roff + bj * HALF + n * 16); *(f32x4*)(dst + roff + bj * HALF + n * 16) = s + gv[bj][n] * acc[ai][bj][m][n]; } }
    }
};
struct EpiLora {
    static constexpr bool PERM = true, AFTER_DRAIN = false;
    _Float16* oute; bf16_t* outa; const float* w0; const float* a0;
    __device__ __forceinline__ void operator()(const f32x4 (&acc)[2][2][4][2], const Unit& u, int wr, int wc, int fr, int fq) const {
        const int p = u.pn >> 2, rt = u.pm - 34 * p, ct = u.pn & 3;
        const int row0 = rt * BM + wr * 64 + fr, col0 = ct * BM + wc * 32 + 8 * fq;
        const float* bias = p < 2 ? w0 + p * 1024 : a0 + (p & 1) * 1024;
        f32x4 bv[2][2];
#pragma unroll
        for (int bj = 0; bj < 2; ++bj)
#pragma unroll
            for (int n = 0; n < 2; ++n) bv[bj][n] = p < 4 ? *(const f32x4*)(bias + col0 + bj * HALF + 4 * n) : (f32x4){0.f, 0.f, 0.f, 0.f};
        typedef _Float16 h16x8 __attribute__((ext_vector_type(8)));
#pragma unroll
        for (int ai = 0; ai < 2; ++ai)
#pragma unroll
            for (int m = 0; m < 4; ++m) { const size_t ro = (size_t)(row0 + ai * HALF + m * 16) * 1024 + col0;
#pragma unroll
                for (int bj = 0; bj < 2; ++bj) { f32x4 x0 = acc[ai][bj][m][0] + bv[bj][0], x1 = acc[ai][bj][m][1] + bv[bj][1];
                    if (p < 4) {
#pragma unroll
                        for (int q = 0; q < 4; ++q) { x0[q] = __builtin_amdgcn_rcpf(1.0f + __expf(-x0[q])); x1[q] = __builtin_amdgcn_rcpf(1.0f + __expf(-x1[q])); } }
                    if (p < 2) { const float c = 0.60653065971263342f;
                        *(h16x8*)(oute + (size_t)p * 8704 * 1024 + ro + bj * HALF) = (h16x8){(_Float16)(c * x0[0]), (_Float16)(c * x0[1]), (_Float16)(c * x0[2]), (_Float16)(c * x0[3]), (_Float16)(c * x1[0]), (_Float16)(c * x1[1]), (_Float16)(c * x1[2]), (_Float16)(c * x1[3])};
                    } else *(u32x4*)(outa + (size_t)(p - 2) * 8704 * 1024 + ro + bj * HALF) = (u32x4){cvt_pk_bf16(x0[0], x0[1]), cvt_pk_bf16(x0[2], x0[3]), cvt_pk_bf16(x1[0], x1[1]), cvt_pk_bf16(x1[2], x1[3])};
                } }
    }
};
struct RowMapOrder : StaticOrder {
    int skip, S, ntS, nLat, nNn;
    __device__ void init2(int N, int K, int G_, int c_, int skip_, int S_) { skip = skip_; S = S_; ntS = K / 64 / S_; nNn = N / BM; nLat = 32 * nNn; init(8192, N, G_, c_); }
    __device__ bool next(int i, Unit& u) const {
        const long L = (long)i * G + c;
        if (L < nLat) { StaticOrder::next(i, u); u.pm = u.pm + 1 + (u.pm >> 4); return true; }
        if (skip) return false;
        const int j = (int)(L - nLat); if (j >= 2 * nNn * S) return false;
        const int sl = j % S, cu = j / S; u.pm = 17 * (cu & 1); u.pn = cu >> 1;
        if (S > 1) { u.k0 = sl * ntS * 64; u.nt = ntS; u.slice = sl; } else { u.k0 = 0; u.nt = 0; u.slice = -1; }
        return true;
    }
};
struct LoraOrder {
    int G, c;
    __device__ bool next(int i, Unit& u) const { const int L = i * G + c; if (L >= 680) return false; const int p = L / 136, rem = L % 136; u.pm = 34 * p + rem % 34; u.pn = 4 * p + rem / 34; u.k0 = 0; u.nt = p < 4 ? 2 : 0; u.slice = -1; return true; }
    __device__ __forceinline__ void a_ready(const Unit&) const {}
    __device__ __forceinline__ void done(const Unit&) const {}
};
template <class Epi, class Sched, bool ALIGN_EPI = false, bool SP2 = false>
__device__ __forceinline__ void gemm_phase(PG8_LAS unsigned char* lds, const Gemm g, const Sched& S, const Epi& E, int tid_in) {
    int tid_ = tid_in; asm volatile("" : "+v"(tid_));
    const int tid = tid_, wid = __builtin_amdgcn_readfirstlane(tid >> 6), lane = tid & 63, wr = wid >> 2, wc = wid & 3, fr = lane & 15, fq = lane >> 4;
    const int K = g.K;
    unsigned voffA[2], voffB[2];
#pragma unroll
    for (int i = 0; i < 2; ++i) { int R, C; stage_rc(tid * 16 + i * 8192, R, C); const int Rb = Epi::PERM ? ((R & ~31) + perm32(R & 31)) : R;
        voffA[i] = (unsigned)(R * K + C) * 2u; voffB[i] = (unsigned)(Rb * K + C) * 2u; }
    const size_t kstep = (size_t)(BK * 2);
    const size_t hstep = (size_t)HALF * K * 2;
    const size_t tstep = 2 * hstep;
    const unsigned ldsw = (unsigned)wid * 1024u;
    const int aoff = lds_byte(wr * 64 + fr, fq * 8), boff = lds_byte(wc * 32 + fr, fq * 8);
#define PG8_SA(b, h) (((b) * 2 + (h)) * HTB)
#define PG8_SB(b, h) ((4 + (b) * 2 + (h)) * HTB)
#define PG8_STAGE(bufoff, gbase, voff) do { _Pragma("unroll") for (int _i = 0; _i < 2; ++_i) \
        __builtin_amdgcn_global_load_lds((const unsigned*)((const char*)(gbase) + (voff)[_i]), (PG8_LAS unsigned*)(lds + (bufoff) + ldsw + _i * 8192), 16, 0, 0); } while (0)
#define PG8_LDA(dst, b, h) do { _Pragma("unroll") for (int m = 0; m < 4; ++m) _Pragma("unroll") for (int k = 0; k < 2; ++k) dst[m][k] = *(const PG8_LAS bf16x8*)(lds + PG8_SA(b, h) + aoff + m * 2048 + k * 1024); } while (0)
#define PG8_LDB(dst, b, h) do { _Pragma("unroll") for (int n = 0; n < 2; ++n) _Pragma("unroll") for (int k = 0; k < 2; ++k) dst[n][k] = *(const PG8_LAS bf16x8*)(lds + PG8_SB(b, h) + boff + n * 2048 + k * 1024); } while (0)
#define PG8_MMA(ai, bj, At, Bt) do { __builtin_amdgcn_s_setprio(1); _Pragma("unroll") for (int m = 0; m < 4; ++m) _Pragma("unroll") for (int n = 0; n < 2; ++n) _Pragma("unroll") for (int k = 0; k < 2; ++k) \
        acc[ai][bj][m][n] = __builtin_amdgcn_mfma_f32_16x16x32_bf16(Bt[n][k], At[m][k], acc[ai][bj][m][n], 0, 0, 0); __builtin_amdgcn_s_setprio(0); } while (0)
#define PG8_WAIT_V(n) asm volatile("s_waitcnt vmcnt(" #n ")" ::: "memory")
#define PG8_WAIT_L(n) asm volatile("s_waitcnt lgkmcnt(" #n ")" ::: "memory")
#define PG8_BAR __builtin_amdgcn_s_barrier()
#define PG8_SCHED __builtin_amdgcn_sched_barrier(0)
    Unit cur, nxt; int ui = 0;
    if (!S.next(0, cur)) return;
    f32x4 acc[2][2][4][2];
#pragma unroll
    for (int a = 0; a < 2; ++a)
#pragma unroll
        for (int b = 0; b < 2; ++b)
#pragma unroll
            for (int m = 0; m < 4; ++m)
#pragma unroll
                for (int n = 0; n < 2; ++n) acc[a][b][m][n] = (f32x4){0.f, 0.f, 0.f, 0.f};
    bf16x8 At[4][2], B0[2][2], B1[2][2];
    const char* cA = (const char*)g.A + (size_t)cur.pm * tstep + (size_t)cur.k0 * 2; const char* cB = (const char*)g.Bt + (size_t)cur.pn * tstep + (size_t)cur.k0 * 2;
    int nt = cur.nt > 0 ? cur.nt : K / BK;
    S.a_ready(cur);
    if constexpr (SP2) {
        PG8_STAGE(PG8_SB(0, 0), cB, voffB); PG8_STAGE(PG8_SB(0, 1), cB + hstep, voffB); PG8_STAGE(PG8_SA(0, 0), cA, voffA); PG8_STAGE(PG8_SA(0, 1), cA + hstep, voffA);
        if (wr == 1) PG8_BAR;
        PG8_WAIT_V(2); PG8_BAR;
        PG8_STAGE(PG8_SB(1, 0), cB + kstep, voffB); PG8_STAGE(PG8_SA(1, 0), cA + kstep, voffA); PG8_STAGE(PG8_SB(1, 1), cB + hstep + kstep, voffB);
        PG8_WAIT_V(6); PG8_BAR;
    } else {
        PG8_STAGE(PG8_SB(0, 0), cB, voffB); PG8_STAGE(PG8_SA(0, 0), cA, voffA); PG8_STAGE(PG8_SB(0, 1), cB + hstep, voffB); PG8_STAGE(PG8_SA(0, 1), cA + hstep, voffA);
        if (wr == 1) PG8_BAR;
        PG8_WAIT_V(4); PG8_BAR;
        PG8_STAGE(PG8_SB(1, 0), cB + kstep, voffB); PG8_STAGE(PG8_SA(1, 0), cA + kstep, voffA); PG8_STAGE(PG8_SB(1, 1), cB + hstep + kstep, voffB);
        PG8_WAIT_V(6); PG8_BAR;
    }
    for (;;) {
        const bool has_next = S.next(ui + 1, nxt);
        const char* nA = has_next ? (const char*)g.A + (size_t)nxt.pm * tstep + (size_t)nxt.k0 * 2 : cA; const char* nB = has_next ? (const char*)g.Bt + (size_t)nxt.pn * tstep + (size_t)nxt.k0 * 2 : cB;
#pragma unroll 1
        for (int t = 0; t < nt; t += 2) {
            const bool last = (t == nt - 2);
            const char* a1 = cA + (size_t)(t + 1) * kstep;
            const char* a2 = last ? nA : cA + (size_t)(t + 2) * kstep; const char* b2 = last ? nB : cB + (size_t)(t + 2) * kstep;
            const char* a3 = a2 + kstep; const char* b3 = b2 + kstep;
            if (last && has_next) S.a_ready(nxt);
            if constexpr (SP2) {
            PG8_LDB(B0, 0, 0); PG8_LDB(B1, 0, 1); PG8_SCHED; PG8_LDA(At, 0, 0); PG8_STAGE(PG8_SA(1, 1), a1 + hstep, voffA);
            PG8_WAIT_V(8); PG8_WAIT_L(0); PG8_BAR; PG8_MMA(0, 0, At, B0); PG8_MMA(0, 1, At, B1); PG8_BAR; PG8_SCHED;
            PG8_LDA(At, 0, 1); PG8_STAGE(PG8_SB(0, 0), b2, voffB); PG8_STAGE(PG8_SB(0, 1), b2 + hstep, voffB); PG8_STAGE(PG8_SA(0, 0), a2, voffA);
            PG8_WAIT_V(8); PG8_WAIT_L(0); PG8_BAR; PG8_MMA(1, 0, At, B0); PG8_MMA(1, 1, At, B1); PG8_BAR; PG8_SCHED;
            PG8_LDB(B0, 1, 0); PG8_LDB(B1, 1, 1); PG8_SCHED; PG8_LDA(At, 1, 0); PG8_STAGE(PG8_SA(0, 1), a2 + hstep, voffA);
            PG8_WAIT_V(8); PG8_WAIT_L(0); PG8_BAR; PG8_MMA(0, 0, At, B0); PG8_MMA(0, 1, At, B1); PG8_BAR; PG8_SCHED;
            PG8_LDA(At, 1, 1); PG8_STAGE(PG8_SB(1, 0), b3, voffB); PG8_STAGE(PG8_SB(1, 1), b3 + hstep, voffB); PG8_STAGE(PG8_SA(1, 0), a3, voffA);
            PG8_WAIT_V(8); PG8_WAIT_L(0); PG8_BAR; PG8_MMA(1, 0, At, B0); PG8_MMA(1, 1, At, B1); PG8_BAR; PG8_SCHED;
            } else {
            PG8_LDB(B0, 0, 0); PG8_SCHED; PG8_LDA(At, 0, 0); PG8_STAGE(PG8_SA(1, 1), a1 + hstep, voffA);
            PG8_WAIT_L(8); PG8_BAR; PG8_WAIT_L(0); PG8_MMA(0, 0, At, B0); PG8_BAR; PG8_SCHED;
            PG8_LDB(B1, 0, 1); PG8_STAGE(PG8_SB(0, 0), b2, voffB);
            PG8_BAR; PG8_WAIT_L(0); PG8_MMA(0, 1, At, B1); PG8_BAR;
            PG8_LDA(At, 0, 1); PG8_STAGE(PG8_SA(0, 0), a2, voffA);
            PG8_BAR; PG8_WAIT_L(0); PG8_MMA(1, 0, At, B0); PG8_BAR; PG8_SCHED;
            PG8_STAGE(PG8_SB(0, 1), b2 + hstep, voffB);
            PG8_WAIT_V(6); PG8_BAR; PG8_MMA(1, 1, At, B1); PG8_BAR;
            PG8_LDB(B0, 1, 0); PG8_SCHED; PG8_LDA(At, 1, 0); PG8_STAGE(PG8_SA(0, 1), a2 + hstep, voffA);
            PG8_WAIT_L(8); PG8_BAR; PG8_WAIT_L(0); PG8_MMA(0, 0, At, B0); PG8_BAR; PG8_SCHED;
            PG8_LDB(B1, 1, 1); PG8_STAGE(PG8_SB(1, 0), b3, voffB);
            PG8_BAR; PG8_WAIT_L(0); PG8_MMA(0, 1, At, B1); PG8_BAR;
            PG8_LDA(At, 1, 1); PG8_STAGE(PG8_SA(1, 0), a3, voffA);
            PG8_BAR; PG8_WAIT_L(0); PG8_MMA(1, 0, At, B0); PG8_BAR; PG8_SCHED;
            PG8_STAGE(PG8_SB(1, 1), b3 + hstep, voffB);
            PG8_WAIT_V(6); PG8_BAR; PG8_MMA(1, 1, At, B1); PG8_BAR;
            }
        }
        if constexpr (ALIGN_EPI) { if (wr == 0) PG8_BAR; }
        if constexpr (!Epi::AFTER_DRAIN) { E(acc, cur, wr, wc, fr, fq); S.done(cur); }
        if (!has_next) break;
#pragma unroll
        for (int a = 0; a < 2; ++a)
#pragma unroll
            for (int b = 0; b < 2; ++b)
#pragma unroll
                for (int m = 0; m < 4; ++m)
#pragma unroll
                    for (int n = 0; n < 2; ++n) acc[a][b][m][n] = (f32x4){0.f, 0.f, 0.f, 0.f};
        cur = nxt; cA = nA; cB = nB; ++ui; nt = cur.nt > 0 ? cur.nt : K / BK;
        if constexpr (ALIGN_EPI) { if (wr == 1) PG8_BAR; }
    }
    PG8_WAIT_V(0);
    if constexpr (!ALIGN_EPI) { if (wr == 0) PG8_BAR; }
    PG8_BAR;
    if constexpr (Epi::AFTER_DRAIN) { E.fused(acc, cur, wr, wc, fr, fq, lds, wid, lane); S.done(cur); }
#undef PG8_SA
#undef PG8_SB
#undef PG8_STAGE
#undef PG8_LDA
#undef PG8_LDB
#undef PG8_MMA
#undef PG8_WAIT_V
#undef PG8_WAIT_L
#undef PG8_BAR
#undef PG8_SCHED
}
}
constexpr int NWAVES = 8;
constexpr int D = 2048, NB = 2, T = 4096, CT = 256, SU = T + CT  , M = NB * SU  , DEPTH = 4;
constexpr int NIN = 5248, NINP = 5376, BIN = 3712, FF = 8192, BW = 1024;
constexpr int PA_Q = 0, PA_K = 512, PA_V = 640, PB0 = 768, PC_Q = 4480, PC_K = 4992, PC_V = 5120;
constexpr int MODW = 6 * D;
#ifndef MK_PER_PHASE
#define MK_PER_PHASE 0
#endif
constexpr int PPL = 11, N_PHASES = 2 + PPL * DEPTH;
constexpr size_t MiB = 1u << 20;
constexpr size_t WS_CTL = 0, CTL_ZERO_BYTES = 32 * 1024;
constexpr size_t WS_MOD = 1 * MiB;
constexpr size_t WS_MODP = 2 * MiB;
constexpr size_t WS_ROPE = 10 * MiB;
constexpr size_t WS_WIN = 11 * MiB;
constexpr size_t WS_WOUT = WS_WIN + 84 * MiB;
constexpr size_t WS_W1 = WS_WOUT + 32 * MiB;
constexpr size_t WS_W2 = WS_W1 + 128 * MiB;
constexpr size_t WS_LW = WS_W2 + 128 * MiB;
constexpr size_t WS_HCTX = WS_LW + 10 * MiB;
constexpr size_t WS_U = WS_HCTX + 4 * MiB;
constexpr size_t WS_P = WS_U + 34 * MiB;
constexpr size_t WS_QA = WS_P + 90 * MiB;
constexpr size_t WS_KA = WS_QA + 9 * MiB;
constexpr size_t WS_QC = WS_KA + 3 * MiB;
constexpr size_t WS_KC = WS_QC + 9 * MiB;
constexpr size_t WS_LA = WS_KC + 3 * MiB;
constexpr size_t WS_MIX = WS_LA + 22 * MiB;
constexpr size_t WS_Y = WS_MIX + 34 * MiB;
constexpr size_t WS_LO = WS_Y + 68 * MiB;
constexpr size_t WS_AG = WS_LO + 68 * MiB;
constexpr size_t WS_STR = WS_LO + 170 * MiB;
constexpr size_t WS_RW = WS_STR + 136 * MiB;
constexpr size_t WS_SL = WS_RW + 204 * MiB;
constexpr size_t WS_END = WS_SL + 32 * MiB;
constexpr size_t WS_HID = WS_LO;
static_assert(WS_HID + (size_t)M * FF * 2 <= WS_RW, "hidden overlay");
constexpr int CW_TMO = 0, CW_BAR = 4096;
constexpr int RING_BYTES = 131072, LDSCTL_OFF = RING_BYTES, MISC_OFF = LDSCTL_OFF + 320, LDS_BYTES = 147456;

#define GAS __attribute__((address_space(1)))
#define LAS __attribute__((address_space(3)))
typedef unsigned short bf16;
typedef unsigned v4u __attribute__((ext_vector_type(4)));
typedef unsigned v2u __attribute__((ext_vector_type(2)));
typedef float f32x4 __attribute__((ext_vector_type(4)));
typedef GAS unsigned gu32;
#define RLX_AGENT __ATOMIC_RELAXED, __HIP_MEMORY_SCOPE_AGENT
#define LDS_WAIT() asm volatile("s_waitcnt lgkmcnt(0)" ::: "memory")
__device__ __forceinline__ unsigned f2bf(float f) { unsigned u = __builtin_bit_cast(unsigned, f); return (u + 0x7fffu + ((u >> 16) & 1u)) >> 16; }
__device__ __forceinline__ unsigned pk2(float lo, float hi) { return f2bf(lo) | (f2bf(hi) << 16); }
__device__ __forceinline__ float bf2f(bf16 x) { return __builtin_bit_cast(float, (unsigned)x << 16); }
struct Args { const float* in[28]; float* out; unsigned char* ws; int ph_lo, ph_hi; };
__device__ __forceinline__ int hw_lane() { int l_; asm volatile("v_mbcnt_lo_u32_b32 %0, -1, 0\n\tv_mbcnt_hi_u32_b32 %0, -1, %0" : "=&v"(l_)); return l_; }
#ifndef PROBE_PHASE
#define PROBE_PHASE -1
#endif
#define PB_BEGIN(j) const unsigned long long pt0_ = (PROBE_PHASE == (j)) ? __builtin_amdgcn_s_memrealtime() : 0ull
#define PB_END(j) do { if (PROBE_PHASE == (j)) { const unsigned long long d_ = __builtin_amdgcn_s_memrealtime() - pt0_, e_ = __builtin_amdgcn_s_memrealtime() + d_; while (__builtin_amdgcn_s_memrealtime() < e_) __builtin_amdgcn_s_sleep(8); } } while (0)
#define PBS(j) const unsigned long long ptq##j##_ = (PROBE_PHASE == (j)) ? __builtin_amdgcn_s_memrealtime() : 0ull
#define PBE(j) do { if (PROBE_PHASE == (j)) { const unsigned long long d_ = __builtin_amdgcn_s_memrealtime() - ptq##j##_, e_ = __builtin_amdgcn_s_memrealtime() + d_; while (__builtin_amdgcn_s_memrealtime() < e_) __builtin_amdgcn_s_sleep(8); } } while (0)
#include <hip/hip_bf16.h>
#include <cmath>
namespace attn_body {
using bf16=__hip_bfloat16;
using bf16x8=__attribute__((ext_vector_type(8)))short;
using s16x4=__attribute__((ext_vector_type(4)))short;
using f32x16=__attribute__((ext_vector_type(16)))float;
using u32x4=__attribute__((ext_vector_type(4)))unsigned;
constexpr int D=64,QP=512,KP=128,VP=5376,OP=2048;
constexpr int NW=8,QBLK=32,QB=QBLK*NW,KVBLK=64;
__device__ __forceinline__ int crow(int r,int hi){return (r&3)+8*(r>>2)+4*hi;}
#define SBAR() __builtin_amdgcn_sched_barrier(0)
#define ZC16 ((f32x16){0.f,0.f,0.f,0.f,0.f,0.f,0.f,0.f,0.f,0.f,0.f,0.f,0.f,0.f,0.f,0.f})
__device__ __forceinline__ void wmask(f32x16&p0,f32x16&p1,int kpos,int qpos,int hi){
  const float NEG=-INFINITY; const int kb=kpos+4*hi-qpos;
  #pragma unroll
  for(int r=0;r<16;++r){const int d=kb+(r&3)+8*(r>>2); if(d>128||d<-128)p0[r]=NEG; if(d+32>128||d+32<-128)p1[r]=NEG;}
}

constexpr int NSLOT=3, SLOTB=8192;
constexpr int LDS_K=0, LDS_V=NSLOT*SLOTB, LDS_WS=2*NSLOT*SLOTB, LDS_OST=LDS_WS+NW*64*4, LDS_BYTES=LDS_OST+NW*4096;
constexpr float C2=0.125f*1.4426950408889634f;
__device__ __forceinline__ void glds16(const void*gsrc,unsigned lds_dst){unsigned keep;
  asm volatile("s_mov_b32 %0, m0\n\ts_mov_b32 m0, %2\n\ts_nop 0\n\tglobal_load_lds_dwordx4 %1, off\n\ts_mov_b32 m0, %0":"=&s"(keep):"v"(gsrc),"s"(lds_dst):"memory");}
__device__ __forceinline__ float max3f(float a,float b,float c){float r;asm("v_max3_f32 %0, %1, %2, %3":"=v"(r):"v"(a),"v"(b),"v"(c));return r;}
__device__ __forceinline__ float max2f(float a,float b){float r;asm("v_max_f32_e32 %0, %1, %2":"=v"(r):"v"(a),"v"(b));return r;}
__device__ __forceinline__ float fadd_s(float a,float b){float r;asm("v_add_f32_e32 %0, %1, %2":"=v"(r):"v"(a),"v"(b));return r;}
__device__ __forceinline__ float fsub_s(float a,float b){float r;asm("v_sub_f32_e32 %0, %1, %2":"=v"(r):"v"(a),"v"(b));return r;}
typedef float f32x2_t __attribute__((ext_vector_type(2))); typedef __bf16 bf16x2_t __attribute__((ext_vector_type(2)));
__device__ __forceinline__ unsigned cvtpk_s(float lo,float hi){f32x2_t v={lo,hi};bf16x2_t b=__builtin_convertvector(v,bf16x2_t);return __builtin_bit_cast(unsigned,b);}
#define WAIT_BAR(N) asm volatile("s_waitcnt vmcnt(" #N ") lgkmcnt(0)\n\ts_barrier":::"memory")

__device__ __forceinline__ void qkt(f32x16&p0,f32x16&p1,const char*Kslot,const bf16x8*qr,const f32x16&negm,int r32,int hi){
  const char*kb=Kslot+hi*1024+r32*16;
  #pragma unroll
  for(int d0=0;d0<4;++d0){
    const bf16x8 b0=*reinterpret_cast<const bf16x8*>(kb+d0*2048);
    const bf16x8 b1=*reinterpret_cast<const bf16x8*>(kb+d0*2048+512);
    if(d0==0){p0=__builtin_amdgcn_mfma_f32_32x32x16_bf16(b0,qr[0],negm,0,0,0);p1=__builtin_amdgcn_mfma_f32_32x32x16_bf16(b1,qr[0],negm,0,0,0);}
    else{p0=__builtin_amdgcn_mfma_f32_32x32x16_bf16(b0,qr[d0],p0,0,0,0);p1=__builtin_amdgcn_mfma_f32_32x32x16_bf16(b1,qr[d0],p1,0,0,0);}}
}
typedef __attribute__((address_space(3))) const char* lds_cptr;
typedef short v4i16_t __attribute__((ext_vector_type(4)));
__device__ __forceinline__ void kload8(bf16x8*kf,lds_cptr kp){
  kf[0]=*(const __attribute__((address_space(3))) bf16x8*)(kp);      kf[1]=*(const __attribute__((address_space(3))) bf16x8*)(kp+512);
  kf[2]=*(const __attribute__((address_space(3))) bf16x8*)(kp+2048); kf[3]=*(const __attribute__((address_space(3))) bf16x8*)(kp+2560);
  kf[4]=*(const __attribute__((address_space(3))) bf16x8*)(kp+4096); kf[5]=*(const __attribute__((address_space(3))) bf16x8*)(kp+4608);
  kf[6]=*(const __attribute__((address_space(3))) bf16x8*)(kp+6144); kf[7]=*(const __attribute__((address_space(3))) bf16x8*)(kp+6656);
}
__device__ __forceinline__ void kload2(bf16x8*kf,lds_cptr kp,int j){ kf[2*j]=*(const __attribute__((address_space(3))) bf16x8*)(kp+j*2048); kf[2*j+1]=*(const __attribute__((address_space(3))) bf16x8*)(kp+j*2048+512); }
__device__ __forceinline__ s16x4 vtr(lds_cptr p){ return __builtin_bit_cast(s16x4,__builtin_amdgcn_ds_read_tr16_b64_v4i16((__attribute__((address_space(3))) v4i16_t*)p)); }
__device__ __forceinline__ float rowmax(const f32x16&p0,const f32x16&p1){
  float a=max3f(p0[0],p0[1],p1[0]),b=max3f(p0[2],p0[3],p1[1]);a=max3f(a,p1[2],p1[3]);
  #pragma unroll
  for(int r=4;r<16;r+=4){a=max3f(a,p0[r],p0[r+1]);b=max3f(b,p0[r+2],p0[r+3]);a=max3f(a,p1[r],p1[r+1]);b=max3f(b,p1[r+2],p1[r+3]);}
  const float m=max2f(a,b);
  auto rr=__builtin_amdgcn_permlane32_swap(__float_as_uint(m),__float_as_uint(m),false,false);
  return max2f(__uint_as_float(rr[0]),__uint_as_float(rr[1]));
}
__device__ __forceinline__ void pv(f32x16*o,int vb,bf16x8 pa0,bf16x8 pa1,bf16x8 pa2,bf16x8 pa3){
  #pragma unroll
  for(int d0=0;d0<2;++d0){s16x4 lo[4],hi[4];
    #pragma unroll
    for(int ks=0;ks<4;++ks){
      asm volatile("ds_read_b64_tr_b16 %0,%1 offset:%c2":"=&v"(lo[ks]):"v"(vb),"i"(d0*4096+ks*1024):"memory");
      asm volatile("ds_read_b64_tr_b16 %0,%1 offset:%c2":"=&v"(hi[ks]):"v"(vb),"i"(d0*4096+ks*1024+512):"memory");}
    asm volatile("s_waitcnt lgkmcnt(0)":::"memory");SBAR();
    #define PK(k) (bf16x8){lo[k][0],lo[k][1],lo[k][2],lo[k][3],hi[k][0],hi[k][1],hi[k][2],hi[k][3]}
    o[d0]=__builtin_amdgcn_mfma_f32_32x32x16_bf16(pa0,PK(0),o[d0],0,0,0);
    o[d0]=__builtin_amdgcn_mfma_f32_32x32x16_bf16(pa1,PK(1),o[d0],0,0,0);
    o[d0]=__builtin_amdgcn_mfma_f32_32x32x16_bf16(pa2,PK(2),o[d0],0,0,0);
    o[d0]=__builtin_amdgcn_mfma_f32_32x32x16_bf16(pa3,PK(3),o[d0],0,0,0);
    #undef PK
  }
}

#ifndef ATTN_STORE16
#define ATTN_STORE16(p,v) (*(u32x4*)(p)=(v))
#endif
struct AttnJob { const bf16* Qw0; const bf16* Kh; const bf16* Vh; unsigned o_off; int NT, lat_lo, qpos0, sidx; };
template<int MODE,int THRL> __device__ __forceinline__ void attn_unit(const AttnJob&J,const Args&A,char*shm,int wv){
  int tid_=wv*64+hw_lane(); asm volatile("":"+v"(tid_));
  const int tid=tid_,lane=tid&63,r32=lane&31,hi=lane>>5; const int wid=__builtin_amdgcn_readfirstlane(tid>>6);
  const int lat_lo=J.lat_lo;
  const bf16*Qw=J.Qw0+(long)(wid*QBLK)*QP;
  const bf16*Kh=J.Kh,*Vh=J.Vh;
  const unsigned lds0=(unsigned)(uintptr_t)shm;
  float*wsf=(float*)(shm+LDS_WS)+wid*64;
  const bf16*ksrc=Kh+(long)lane*KP+wid*8;
  const bf16*vsrc=Vh+(long)(16*(wid&3)+(lane>>2))*VP+(wid>>2)*32+(lane&3)*8;
  const unsigned kdst=lds0+LDS_K+wid*1024, vdst=lds0+LDS_V+wid*1024;
  #define TROW(t) ((long)KVBLK*((t)+(((t)>=4)?lat_lo:0)))
  #define DMA_K(t,slot) glds16(ksrc+TROW(t)*KP,(unsigned)__builtin_amdgcn_readfirstlane(kdst+(slot)))
  #define DMA_V(t,slot) glds16(vsrc+TROW(t)*VP,(unsigned)__builtin_amdgcn_readfirstlane(vdst+(slot)))
  const int vb0=(int)(lds0+LDS_V)+((lane>>4)&1)*32+(lane&3)*8+(4*hi+((lane&15)>>2))*64;
  const char*Kbase=shm+LDS_K; bf16x8 kf[8];
  const lds_cptr shm3=(lds_cptr)shm; const lds_cptr kp0=shm3+LDS_K+hi*1024+r32*16; const lds_cptr vp0=shm3+LDS_V+((lane>>4)&1)*32+(lane&3)*8+(4*hi+((lane&15)>>2))*64;
  const int NT=J.NT;
  DMA_K(0,0);DMA_V(0,0);DMA_K(1,SLOTB);
  bf16x8 qr[4];
  #pragma unroll
  for(int d0=0;d0<4;++d0)qr[d0]=*reinterpret_cast<const bf16x8*>(&Qw[(long)r32*QP+d0*16+hi*8]);
  float mhat=0.f,l_reg=0.f;f32x16 o[2],negm;
  #pragma unroll
  for(int r=0;r<16;++r){float z0,z1,z2;asm volatile("v_mov_b32 %0, 0\n\tv_mov_b32 %1, 0\n\tv_mov_b32 %2, 0":"=v"(z0),"=v"(z1),"=v"(z2));o[0][r]=z0;o[1][r]=z1;negm[r]=z2;}
  asm volatile("":"+v"(negm));
  const int qpos=J.qpos0+wid*QBLK+r32;
  #define CMASK(P0,P1,t) do{ if(MODE==1&&(t)>=4)wmask(P0,P1,KVBLK*(lat_lo+(t)-4),qpos,hi); }while(0)
  bool resc=false;
  #define START(P0,P1) do{ const float rm=rowmax(P0,P1); resc=false; \
    { const float dl=rm; mhat=fadd_s(mhat,dl); \
      _Pragma("unroll") for(int r=0;r<16;++r){P0[r]=fsub_s(P0[r],dl);P1[r]=fsub_s(P1[r],dl);} \
      _Pragma("unroll") for(int r=0;r<16;++r)negm[r]=-mhat; asm volatile("":"+v"(negm)); } \
    _Pragma("unroll") for(int r=0;r<16;++r)P0[r]=__builtin_amdgcn_exp2f(P0[r]); }while(0)
  #define RESC() do{ if(resc){ asm volatile("s_waitcnt lgkmcnt(0)":::"memory"); \
      _Pragma("unroll") for(int d_=0;d_<2;++d_) _Pragma("unroll") for(int r=0;r<16;++r)o[d_][r]*=wsf[crow(r,hi)]; } }while(0)
  f32x16 pA0,pA1,pB0,pB1;
  int sl_prev=0,sl_cur=0,sl_next=SLOTB;
  #define ROT() do{sl_prev=sl_cur;sl_cur=sl_next;sl_next=(sl_next==(NSLOT-1)*SLOTB)?0:sl_next+SLOTB;}while(0)
  DMA_K(2,2*SLOTB);
  WAIT_BAR(3);
  qkt(pA0,pA1,Kbase,qr,negm,r32,hi);asm volatile("s_nop 15\n\ts_nop 7":"+v"(pA0),"+v"(pA1));CMASK(pA0,pA1,0);
  START(pA0,pA1);
  _Pragma("unroll") for(int r=0;r<16;++r)pA1[r]=__builtin_amdgcn_exp2f(pA1[r]);
  WAIT_BAR(0);
  DMA_K(3,0);DMA_V(1,SLOTB);
  ROT();
  kload8(kf,kp0+sl_cur);
  WAIT_BAR(2);
  s16x4 vlo[8],vhi[8]; u32x4 pw0,pw1,pw2,pw3;
  #define PKW(P,B) cvtpk_s(P[B],P[B+1])
  #define PAF(k) __builtin_bit_cast(bf16x8,pw##k)
  #define VFR(i) (bf16x8){vlo[i][0],vlo[i][1],vlo[i][2],vlo[i][3],vhi[i][0],vhi[i][1],vhi[i][2],vhi[i][3]}
  #define PIN(x) asm volatile("":"+v"(x))
  #define MX3(a,b,c) __builtin_fmaxf(__builtin_fmaxf((a),(b)),(c))
  #define GAPA(MF,A0,A1,A2,A3,W0,W1,PW) do{ MF; sacc+=A0; sacc+=A1; sacc+=A2; sacc+=A3; PIN(sacc); W0; W1; PIN(PW); SBAR(); }while(0)
  #define EX(v) __builtin_amdgcn_exp2f(v)
  #define GAPB(MF,X,B) do{ MF; X[B]=EX(X[B]); X[B+1]=EX(X[B+1]); X[B+2]=EX(X[B+2]); X[B+3]=EX(X[B+3]); PIN(X); SBAR(); }while(0)
  #define VRD(i) do{ vlo[i]=vtr(vp_+(((i)>>2)*4096+((i)&3)*1024)); vhi[i]=vtr(vp_+(((i)>>2)*4096+((i)&3)*1024+512)); }while(0)
  #define KRD(G,j) do{ if(G){ kload2(kf,kp0+sl_next,j); SBAR(); } }while(0)
  #define STEP(C0,C1,P0,P1,t,GK,GV,GL) do{ SBAR(); \
    const lds_cptr vp_=vp0+sl_prev; \
    VRD(0); SBAR(); float sacc=(P0[0]+P0[1]); \
    GAPA(C0=__builtin_amdgcn_mfma_f32_32x32x16_bf16(kf[0],qr[0],negm,0,0,0), P0[2],P0[3],P0[4],P0[5],     pw0[0]=PKW(P0,0), pw0[1]=PKW(P0,2), pw0); \
    VRD(4); SBAR(); GAPA(C1=__builtin_amdgcn_mfma_f32_32x32x16_bf16(kf[1],qr[0],negm,0,0,0), P0[6],P0[7],P0[8],P0[9],     pw0[2]=PKW(P0,4), pw0[3]=PKW(P0,6), pw0); \
    VRD(1); SBAR(); GAPA(C0=__builtin_amdgcn_mfma_f32_32x32x16_bf16(kf[2],qr[1],C0,0,0,0),   P0[10],P0[11],P0[12],P0[13], pw1[0]=PKW(P0,8), pw1[1]=PKW(P0,10), pw1); \
    VRD(5); SBAR(); GAPA(C1=__builtin_amdgcn_mfma_f32_32x32x16_bf16(kf[3],qr[1],C1,0,0,0),   P0[14],P0[15],P1[0],P1[1],   pw1[2]=PKW(P0,12),pw1[3]=PKW(P0,14), pw1); \
    VRD(2); SBAR(); GAPA(C0=__builtin_amdgcn_mfma_f32_32x32x16_bf16(kf[4],qr[2],C0,0,0,0),   P1[2],P1[3],P1[4],P1[5],     pw2[0]=PKW(P1,0), pw2[1]=PKW(P1,2), pw2); \
    VRD(6); SBAR(); GAPA(C1=__builtin_amdgcn_mfma_f32_32x32x16_bf16(kf[5],qr[2],C1,0,0,0),   P1[6],P1[7],P1[8],P1[9],     pw2[2]=PKW(P1,4), pw2[3]=PKW(P1,6), pw2); \
    VRD(3); SBAR(); GAPA(C0=__builtin_amdgcn_mfma_f32_32x32x16_bf16(kf[6],qr[3],C0,0,0,0),   P1[10],P1[11],P1[12],P1[13], pw3[0]=PKW(P1,8), pw3[1]=PKW(P1,10), pw3); \
    VRD(7); SBAR(); GAPA(C1=__builtin_amdgcn_mfma_f32_32x32x16_bf16(kf[7],qr[3],C1,0,0,0),   P1[14],P1[15],0.f,0.f,       pw3[2]=PKW(P1,12),pw3[3]=PKW(P1,14), pw3); \
    l_reg+=sacc; \
    if(GK){DMA_K((t)+3,sl_cur);} if(GV){DMA_V((t)+1,sl_next);} \
    CMASK(C0,C1,t); \
    { float a=MX3(C0[0],C0[1],C1[0]),b=MX3(C0[2],C0[3],C1[1]); a=MX3(a,C1[2],C1[3]); \
      _Pragma("unroll") for(int r=4;r<16;r+=4){a=MX3(a,C0[r],C0[r+1]);b=MX3(b,C0[r+2],C0[r+3]);a=MX3(a,C1[r],C1[r+1]);b=MX3(b,C1[r+2],C1[r+3]);} \
      float rm=__builtin_fmaxf(a,b); { auto rr=__builtin_amdgcn_permlane32_swap(__float_as_uint(rm),__float_as_uint(rm),false,false); rm=__builtin_fmaxf(__uint_as_float(rr[0]),__uint_as_float(rr[1])); } \
      resc=false; \
      if(__builtin_expect(__any(rm>(float)THRL),0)){ const float dl=__builtin_fmaxf(rm,0.f); mhat+=dl; \
        _Pragma("unroll") for(int r=0;r<16;++r){C0[r]-=dl;C1[r]-=dl;} \
        _Pragma("unroll") for(int r=0;r<16;++r)negm[r]=-mhat; asm volatile("":"+v"(negm)); \
        const float f=__builtin_amdgcn_exp2f(-dl); l_reg*=f; if(hi==0)wsf[r32]=f; resc=true; } } \
    SBAR(); \
    GAPB(o[0]=__builtin_amdgcn_mfma_f32_32x32x16_bf16(PAF(0),VFR(0),o[0],0,0,0), C0,0); \
    GAPB(o[1]=__builtin_amdgcn_mfma_f32_32x32x16_bf16(PAF(0),VFR(4),o[1],0,0,0), C0,4); \
    KRD(GL,0); GAPB(o[0]=__builtin_amdgcn_mfma_f32_32x32x16_bf16(PAF(1),VFR(1),o[0],0,0,0), C0,8); \
    KRD(GL,1); GAPB(o[1]=__builtin_amdgcn_mfma_f32_32x32x16_bf16(PAF(1),VFR(5),o[1],0,0,0), C0,12); \
    KRD(GL,2); GAPB(o[0]=__builtin_amdgcn_mfma_f32_32x32x16_bf16(PAF(2),VFR(2),o[0],0,0,0), C1,0); \
    KRD(GL,3); GAPB(o[1]=__builtin_amdgcn_mfma_f32_32x32x16_bf16(PAF(2),VFR(6),o[1],0,0,0), C1,4); \
    GAPB(o[0]=__builtin_amdgcn_mfma_f32_32x32x16_bf16(PAF(3),VFR(3),o[0],0,0,0), C1,8); \
    GAPB(o[1]=__builtin_amdgcn_mfma_f32_32x32x16_bf16(PAF(3),VFR(7),o[1],0,0,0), C1,12); \
    }while(0)
  int t=1;
  for(;t+5<NT;t+=2){
    STEP(pB0,pB1,pA0,pA1,t,true,true,true);     WAIT_BAR(2); RESC(); ROT();
    STEP(pA0,pA1,pB0,pB1,t+1,true,true,true);   WAIT_BAR(2); RESC(); ROT();
  }
  #define ENDW(tt) do{ if((tt)+3<NT){WAIT_BAR(2);} else if((tt)+2<NT){WAIT_BAR(1);} else {WAIT_BAR(0);} }while(0)
  for(;t+1<NT;t+=2){
    STEP(pB0,pB1,pA0,pA1,t,(t+3<NT),(t+1<NT),(t+1<NT));       ENDW(t);   RESC(); ROT();
    STEP(pA0,pA1,pB0,pB1,t+1,(t+4<NT),(t+2<NT),(t+2<NT));     ENDW(t+1); RESC(); ROT();
  }
  STEP(pB0,pB1,pA0,pA1,NT-1,false,false,false); RESC();
  { float sacc=pB0[0]+pB0[1]; _Pragma("unroll") for(int r=2;r<16;++r)sacc+=pB0[r]; _Pragma("unroll") for(int r=0;r<16;++r)sacc+=pB1[r]; l_reg+=sacc;
    pw0=(u32x4){PKW(pB0,0),PKW(pB0,2),PKW(pB0,4),PKW(pB0,6)};pw1=(u32x4){PKW(pB0,8),PKW(pB0,10),PKW(pB0,12),PKW(pB0,14)};pw2=(u32x4){PKW(pB1,0),PKW(pB1,2),PKW(pB1,4),PKW(pB1,6)};pw3=(u32x4){PKW(pB1,8),PKW(pB1,10),PKW(pB1,12),PKW(pB1,14)};
    SBAR(); pv(o,vb0+sl_cur,PAF(0),PAF(1),PAF(2),PAF(3)); }
  #undef PKW
  #undef PAF
  #undef VFR
  #undef PIN
  #undef MX3
  #undef GAPA
  #undef GAPB
  #undef EX
  #undef VRD
  #undef KRD
  #undef STEP
  #undef ENDW
  {auto rr=__builtin_amdgcn_permlane32_swap(__float_as_uint(l_reg),__float_as_uint(l_reg),false,false);l_reg=__uint_as_float(rr[0])+__uint_as_float(rr[1]);}
  if(J.sidx>=0)l_reg+=__builtin_amdgcn_exp2f(A.in[11][J.sidx]*1.4426950408889634f-mhat);
  if(hi==0)wsf[32+r32]=l_reg;asm volatile("s_waitcnt lgkmcnt(0)":::"memory");
  float rli[16];
  #pragma unroll
  for(int r=0;r<16;++r)rli[r]=__builtin_amdgcn_rcpf(wsf[32+crow(r,hi)]);
  bf16*Ow=(bf16*)(A.ws+WS_MIX)+J.o_off+(long)(wid*QBLK)*OP;
  { bf16*stg=(bf16*)(shm+LDS_OST)+wid*2048;
    #pragma unroll
    for(int r=0;r<16;++r){const int orow=crow(r,hi);
      #pragma unroll
      for(int d0=0;d0<2;++d0)stg[orow*64+d0*32+r32]=__float2bfloat16(o[d0][r]*rli[r]);}
    asm volatile("s_waitcnt lgkmcnt(0)":::"memory");
    #pragma unroll
    for(int i=0;i<4;++i){const int row=i*8+(lane>>3),ch=lane&7; const u32x4 v=*(const u32x4*)(stg+row*64+ch*8); ATTN_STORE16(Ow+(long)row*OP+ch*8,v);} }
  asm volatile("s_waitcnt lgkmcnt(0)\n\ts_barrier":::"memory");
  #undef TROW
  #undef DMA_K
  #undef DMA_V
  #undef CMASK
  #undef START
  #undef RESC
  #undef ROT
}
constexpr int ATTN_LDS_BYTES=LDS_BYTES;
#undef SBAR
#undef WAIT_BAR
}
#define XB_TMO      128
#define XB_XCNT(j)  (256  + 64 * (j))
#define XB_XSUB(j)  (1280 + 64 * (j))
#define XB_XGEN(j)  (2304 + 64 * (j))
#define XB_TOP      3328
#define XB_TOPGEN   3392
#define XCD_BAR_WORDS 3456
#define XB_SPIN_CAP (1u << 18)

__device__ __forceinline__ unsigned xb_ld(unsigned* p)              { return __hip_atomic_load(p, __ATOMIC_RELAXED, __HIP_MEMORY_SCOPE_AGENT); }
__device__ __forceinline__ unsigned xb_add(unsigned* p, unsigned v) { return __hip_atomic_fetch_add(p, v, __ATOMIC_RELAXED, __HIP_MEMORY_SCOPE_AGENT); }
__device__ __forceinline__ unsigned xb_xcc_id() { return (unsigned)__builtin_amdgcn_s_getreg((3 << 11) | 20) & 0xFu; }
#define XB_SPIN(cond, bar) do { unsigned _sp = 0; while (cond) { __builtin_amdgcn_s_sleep(1); \
    if ((++_sp & 255u) == 0u) { if (xb_ld(&(bar)[XB_TMO])) break; if (_sp > XB_SPIN_CAP) { atomicAdd(&(bar)[XB_TMO], 1u); break; } } } } while (0)

struct XcdBarrier {
    unsigned* bar; unsigned x;
    volatile LAS unsigned* st;
};

__device__ __forceinline__ XcdBarrier xcd_barrier_post(unsigned* bar, volatile LAS unsigned* st, bool leader  ) {
    XcdBarrier b; b.bar = bar; b.x = xb_xcc_id(); b.st = st;
    if (leader) (void)xb_add(&bar[XB_XCNT(b.x)], 1u);
    return b;
}
__device__ __forceinline__ void xcd_barrier_complete(unsigned* bar, unsigned x, unsigned& nloc, unsigned& nx) {
    const unsigned G = gridDim.x * gridDim.y * gridDim.z;
    unsigned sum, cnt, mine, sp = 0u;
    for (;;) {
        sum = 0u; cnt = 0u; mine = 0u;
#pragma unroll
        for (unsigned j = 0; j < 16; ++j) { const unsigned c = xb_ld(&bar[XB_XCNT(j)]); sum += c; cnt += (c > 0u) ? 1u : 0u; mine = (j == x) ? c : mine; }
        if (sum == G) break;
        __builtin_amdgcn_s_sleep(1);
        if ((++sp & 255u) == 0u) { if (xb_ld(&bar[XB_TMO])) break; if (sp > XB_SPIN_CAP) { atomicAdd(&bar[XB_TMO], 1u); break; } }
    }
    nloc = mine > 0u ? mine : 1u; nx = cnt > 0u ? cnt : 1u;
}

__device__ __forceinline__ void xcd_barrier(const XcdBarrier& b, bool leader  ) {
    asm volatile("s_waitcnt vmcnt(0)" ::: "memory");
    __syncthreads();
    if (leader) {
        unsigned* bar = b.bar; asm volatile("" : "+s"(bar));
        __builtin_amdgcn_s_waitcnt(0);
        unsigned nloc = b.st[0], nx = b.st[1];
        if (nloc == 0u) { xcd_barrier_complete(bar, b.x, nloc, nx); b.st[0] = nloc; b.st[1] = nx; }
        const unsigned old = xb_add(&bar[XB_XSUB(b.x)], 1u);
        const unsigned gen = old / nloc;
        if (old + 1u == (gen + 1u) * nloc) {
            __builtin_amdgcn_fence(__ATOMIC_RELEASE, "agent");
            asm volatile("s_waitcnt vmcnt(0)" ::: "memory");
            const unsigned og = xb_add(&bar[XB_TOP], 1u);
            const unsigned tg = og / nx;
            if (og + 1u == (tg + 1u) * nx) xb_add(&bar[XB_TOPGEN], 1u);
            else XB_SPIN(xb_ld(&bar[XB_TOPGEN]) == tg, bar);
            __builtin_amdgcn_fence(__ATOMIC_ACQUIRE, "agent");
            xb_add(&bar[XB_XGEN(b.x)], 1u);
            asm volatile("s_waitcnt vmcnt(0)" ::: "memory");
        } else {
            XB_SPIN(xb_ld(&bar[XB_XGEN(b.x)]) == gen, bar);
            __builtin_amdgcn_fence(__ATOMIC_ACQUIRE, "agent");
            asm volatile("s_waitcnt vmcnt(0)" ::: "memory");
        }
    }
    __syncthreads();
}
struct Ctx { LAS unsigned char* lds; int tid, lane, wave, vcu, G, gw, NGW; };
__device__ __forceinline__ float lora_e(float x) { return 0.60653065971263342f / (1.0f + __expf(-x)); }
__device__ __forceinline__ float sigm(float x) { return 1.0f / (1.0f + __expf(-x)); }
#define DPP_ADD(v, ctrl) v += __builtin_bit_cast(float, __builtin_amdgcn_update_dpp(0, __builtin_bit_cast(int, v), ctrl, 0xF, 0xF, false))
__device__ __forceinline__ float wave_sum(float v) {
    DPP_ADD(v, 0xB1); DPP_ADD(v, 0x4E); DPP_ADD(v, 0x141); DPP_ADD(v, 0x140);
    const int iv = __builtin_bit_cast(int, v);
    const float a = __builtin_bit_cast(float, __builtin_amdgcn_readlane(iv, 0)), b = __builtin_bit_cast(float, __builtin_amdgcn_readlane(iv, 16)),
                c = __builtin_bit_cast(float, __builtin_amdgcn_readlane(iv, 32)), d = __builtin_bit_cast(float, __builtin_amdgcn_readlane(iv, 48));
    return (a + b) + (c + d);
}
__device__ __forceinline__ float swap32(float v, int lane) {
    const unsigned u = __builtin_bit_cast(unsigned, v); auto rr = __builtin_amdgcn_permlane32_swap(u, u, false, false);
    return __builtin_bit_cast(float, lane < 32 ? rr[1] : rr[0]);
}
__device__ __forceinline__ float dpp_xor_sum8(float v) {
    v += __builtin_bit_cast(float, __builtin_amdgcn_update_dpp(0, __builtin_bit_cast(int, v), 0xB1, 0xF, 0xF, false));
    v += __builtin_bit_cast(float, __builtin_amdgcn_update_dpp(0, __builtin_bit_cast(int, v), 0x4E, 0xF, 0xF, false));
    v += __builtin_bit_cast(float, __builtin_amdgcn_update_dpp(0, __builtin_bit_cast(int, v), 0x141, 0xF, 0xF, false));
    return v;
}
__device__ __forceinline__ void p0_transpose_item(const float* W, int K, int N, bf16* WT, LAS float* scr, int item, int lane) {
    const int nblk = N / 32, kb = item / nblk, nb = item % nblk, k0 = 64 * kb, n0 = 32 * nb;
#pragma unroll
    for (int i = 0; i < 8; ++i) { const int kk = 8 * i + (lane >> 3), c4 = (lane & 7) * 4;
        const f32x4 wv = *(const f32x4*)(W + (size_t)(k0 + kk) * N + n0 + c4);
        LAS float* d = scr + kk * 33 + c4; d[0] = wv.x; d[1] = wv.y; d[2] = wv.z; d[3] = wv.w; }
    LDS_WAIT(); asm volatile("" ::: "memory");
    const int c = lane & 7;
#pragma unroll
    for (int j = 0; j < 4; ++j) { const int n = (lane >> 3) + 8 * j; const LAS float* s = scr + (8 * c) * 33 + n;
        v4u o; o.x = pk2(s[0 * 33], s[1 * 33]); o.y = pk2(s[2 * 33], s[3 * 33]); o.z = pk2(s[4 * 33], s[5 * 33]); o.w = pk2(s[6 * 33], s[7 * 33]);
        *(v4u*)(WT + (size_t)(n0 + n) * K + k0 + 8 * c) = o; }
    LDS_WAIT(); asm volatile("" ::: "memory");
}
constexpr int CI_IN = 32 * (NIN / 32), CI_OUT = 32 * 64, CI_1 = 32 * 256, CI_2 = 128 * 64;
__device__ __forceinline__ void convert_items(const Ctx& F, const Args& A, int l, int mat, int it0, int it1, int w0, int nw) {
    LAS float* scr = (LAS float*)(F.lds + F.wave * 16384);
    for (int it = it0 + w0; it < it1; it += nw) {
        if (mat == 0) p0_transpose_item((A.in[8]) + (size_t)l * D * NIN, D, NIN, ((bf16*)(A.ws + WS_WIN)) + (size_t)l * NINP * D, scr, it, F.lane);
        else if (mat == 1) p0_transpose_item((A.in[25]) + (size_t)l * D * D, D, D, ((bf16*)(A.ws + WS_WOUT)) + (size_t)l * D * D, scr, it, F.lane);
        else if (mat == 2) p0_transpose_item((A.in[26]) + (size_t)l * D * FF, D, FF, ((bf16*)(A.ws + WS_W1)) + (size_t)l * FF * D, scr, it, F.lane);
        else p0_transpose_item((A.in[27]) + (size_t)l * FF * D, FF, D, ((bf16*)(A.ws + WS_W2)) + (size_t)l * D * FF, scr, it, F.lane);
    }
}
__device__ __forceinline__ void p0_prologue(const Ctx& F, const Args& A) {
    LAS float* sil = (LAS float*)F.lds;
    for (int i = F.tid; i < 3 * D; i += NWAVES * 64) { const int v = i / D, k = i % D; const float xv = v < 2 ? (A.in[1])[v * D + k] : (A.in[3])[k]; sil[i] = xv / (1.0f + __expf(-xv)); }
    __syncthreads();
    for (int it = F.gw; it < DEPTH * 48 * 8; it += F.NGW) {
        const int l = it / 384, r = it % 384, nb = r >> 3, ks = r & 7;
        const float* W = (A.in[4]) + ((size_t)l * D + (size_t)ks * 256) * MODW + nb * 256 + F.lane * 4;
        f32x4 a0 = {0.f, 0.f, 0.f, 0.f}, a1 = a0, a2 = a0;
#pragma unroll 8
        for (int k = 0; k < 256; ++k) { const f32x4 w = *(const f32x4*)(W + (size_t)k * MODW); const int kk = ks * 256 + k; a0 += sil[kk] * w; a1 += sil[D + kk] * w; a2 += sil[2 * D + kk] * w; }
        float* o = ((float*)(A.ws + WS_MODP)) + ((size_t)ks * 12 + l * 3) * MODW + nb * 256 + F.lane * 4;
        *(f32x4*)o = a0; *(f32x4*)(o + MODW) = a1; *(f32x4*)(o + 2 * MODW) = a2;
    }
    __syncthreads();
    if (F.G == 256) convert_items(F, A, 0, 0, 0, CI_IN, F.gw, F.NGW);
    else for (int l2 = 0; l2 < DEPTH; ++l2) { convert_items(F, A, l2, 0, 0, CI_IN, F.gw, F.NGW); convert_items(F, A, l2, 1, 0, CI_OUT, F.gw, F.NGW); convert_items(F, A, l2, 2, 0, CI_1, F.gw, F.NGW); convert_items(F, A, l2, 3, 0, CI_2, F.gw, F.NGW); }
    const int gt = F.gw * 64 + F.lane, NGT = F.NGW * 64;
    for (int i = gt; i < DEPTH * 128 * 256; i += NGT) {
        const int l = i / (128 * 256), r = i % (128 * 256);
        *(v4u*)(((bf16*)(A.ws + WS_WIN)) + ((size_t)l * NINP + NIN) * D + (size_t)r * 8) = (v4u){0u, 0u, 0u, 0u};
    }
    for (int i = gt; i < DEPTH * 5 * 1024 * 32; i += NGT) {
        const int n = i & 1023, k0 = ((i >> 10) & 31) * 8, lp = i >> 15, p = lp % 5, l = lp / 5;
        float v[8];
#pragma unroll
        for (int e = 0; e < 8; ++e) { const int k = k0 + e;
            v[e] = p < 2 ? (k < 96 ? (A.in[16])[((size_t)(l * 2 + p) * 96 + k) * BW + n] : 0.f) : p < 4 ? (k < 96 ? (A.in[18])[((size_t)(l * 2 + (p - 2)) * 96 + k) * BW + n] : 0.f) : (A.in[19])[((size_t)l * 256 + k) * BW + n]; }
        *(v4u*)(((bf16*)(A.ws + WS_LW)) + ((size_t)lp * 1024 + n) * 256 + k0) = (v4u){pk2(v[0], v[1]), pk2(v[2], v[3]), pk2(v[4], v[5]), pk2(v[6], v[7])};
    }
    for (int i = gt; i < T * 32; i += NGT) {
        const int t = i >> 5, j = i & 31, pos = j < 16 ? (t >> 6) : (t & 63);
        const float inv = (float)pow(10000.0, -(double)(j & 15) / 16.0), ang = (float)pos * inv;
        ((float*)(A.ws + WS_ROPE))[i] = (float)cos((double)ang); ((float*)(A.ws + WS_ROPE))[T * 32 + i] = (float)sin((double)ang);
    }
}
__device__ __forceinline__ void p0b_mods(const Ctx& F, const Args& A) {
    const int gt = F.gw * 64 + F.lane, NGT = F.NGW * 64;
    for (int i = gt; i < DEPTH * 3 * MODW; i += NGT) { const int l = i / (3 * MODW), n = i % MODW; float s = (A.in[5])[l * MODW + n];
#pragma unroll
        for (int ks = 0; ks < 8; ++ks) s += ((float*)(A.ws + WS_MODP))[(size_t)ks * 12 * MODW + i];
        ((float*)(A.ws + WS_MOD))[i] = s; }
}
__device__ __forceinline__ const float* norm_src(const Args& A, int l, int which, int m) {
    const int b = m / SU, s = m % SU;
    return s < CT ? (l == 0 ? (A.in[2]) : ((float*)(A.ws + WS_HCTX))) + ((size_t)b * CT + s) * D : (l == 0 && !which ? (A.in[0]) : (A.out)) + ((size_t)b * T + (s - CT)) * D;
}
__device__ __forceinline__ void norm_row(const Ctx& F, const Args& A, int l, int which, int m, f32x4 (&v)[8], const float* gain) {
    const int b = m / SU, s = m % SU; const bool isctx = s < CT;
    const float* mod = ((float*)(A.ws + WS_MOD)) + ((size_t)l * 3 + (isctx ? 2 : b)) * MODW + which * 3 * D;
    float ss = 0.f;
    if (isctx && (which ? true : l > 0)) {
        const float* sl = ((const float*)(A.ws + WS_SL)) + ((size_t)b * CT + s) * D + F.lane * 8;
        const float* gt = ((float*)(A.ws + WS_MOD)) + ((size_t)(which ? l : l - 1) * 3 + 2) * MODW + (which ? 2 : 5) * D + F.lane * 8;
        float* hw = ((float*)(A.ws + WS_HCTX)) + ((size_t)b * CT + s) * D + F.lane * 8;
#pragma unroll
        for (int j = 0; j < 8; ++j) { const int co = 512 * (j >> 1) + 4 * (j & 1); f32x4 a = *(const f32x4*)(sl + co);
#pragma unroll
            for (int q = 1; q < 8; ++q) a += *(const f32x4*)(sl + (size_t)q * 512 * D + co);
            v[j] += *(const f32x4*)(gt + co) * a; *(f32x4*)(hw + co) = v[j]; }
    }
#pragma unroll
    for (int j = 0; j < 8; ++j) ss += (v[j].x * v[j].x + v[j].y * v[j].y) + (v[j].z * v[j].z + v[j].w * v[j].w);
    const float rstd = 1.0f / sqrtf(wave_sum(ss) * (1.0f / D) + 1e-6f);
    bf16* o = ((bf16*)(A.ws + WS_U)) + (size_t)m * D;
    const LAS float* tg = (const LAS float*)F.lds + (isctx ? 2 : b) * 2 * D;
#pragma unroll
    for (int j2 = 0; j2 < 4; ++j2) { const int col = F.lane * 8 + 512 * j2;
        const f32x4 g0 = *(const LAS f32x4*)(tg + col), g1 = *(const LAS f32x4*)(tg + col + 4), s0 = *(const LAS f32x4*)(tg + D + col), s1 = *(const LAS f32x4*)(tg + D + col + 4);
        const f32x4 y0 = (v[2 * j2] * rstd) * g0 + s0, y1 = (v[2 * j2 + 1] * rstd) * g1 + s1;
        *(v4u*)(o + col) = (v4u){pk2(y0.x, y0.y), pk2(y0.z, y0.w), pk2(y1.x, y1.y), pk2(y1.z, y1.w)}; }
}
__device__ __forceinline__ void ph_norm(const Ctx& F, const Args& A, int l, int which) {
    const float* gain = (which ? (A.in[7]) : (A.in[6])) + l * D;
    const bool last = (l == DEPTH - 1);
    {
        LAS float* tb = (LAS float*)F.lds;
        for (int i = F.tid; i < 3 * (D / 4); i += NWAVES * 64) { const int v = i / (D / 4), col = (i % (D / 4)) * 4;
            const float* mod = ((float*)(A.ws + WS_MOD)) + ((size_t)l * 3 + v) * MODW + which * 3 * D;
            const f32x4 g = *(const f32x4*)(gain + col), sh = *(const f32x4*)(mod + col), sc = *(const f32x4*)(mod + D + col);
            *(LAS f32x4*)(tb + v * 2 * D + col) = g * (1.0f + sc); *(LAS f32x4*)(tb + v * 2 * D + D + col) = sh; }
        __syncthreads();
    }
    const bool even = (NB * T) % F.NGW == 0 && F.NGW % (NB * CT) == 0; const int cstep = even ? F.NGW / (NB * CT) : 1, nlat = (NB * T) / F.NGW;
    if (!even) {
        for (int m = F.gw; m < M; m += F.NGW) { if ((m % SU) < CT && last && which) continue; f32x4 v[8]; const float* row = norm_src(A, l, which, m);
#pragma unroll
            for (int j = 0; j < 8; ++j) v[j] = *(const f32x4*)(row + F.lane * 8 + 512 * (j >> 1) + 4 * (j & 1));
            norm_row(F, A, l, which, m, v, gain); }
        return;
    }
    f32x4 vn[8];
    { const int vi = F.gw; const float* row = norm_src(A, l, which, (vi / T) * SU + CT + (vi % T));
#pragma unroll
      for (int j = 0; j < 8; ++j) vn[j] = *(const f32x4*)(row + F.lane * 8 + 512 * (j >> 1) + 4 * (j & 1)); }
    for (int it = 0; it < nlat; ++it) {
        const int vi = it * F.NGW + F.gw, m = (vi / T) * SU + CT + (vi % T);
        f32x4 v[8];
#pragma unroll
        for (int j = 0; j < 8; ++j) v[j] = vn[j];
        if (it + 1 < nlat) { const int vj = vi + F.NGW; const float* row = norm_src(A, l, which, (vj / T) * SU + CT + (vj % T));
#pragma unroll
            for (int j = 0; j < 8; ++j) vn[j] = *(const f32x4*)(row + F.lane * 8 + 512 * (j >> 1) + 4 * (j & 1)); }
        norm_row(F, A, l, which, m, v, gain);
    }
    if (!(last && which) && F.gw % cstep == 0) {
        const int c = F.gw / cstep, m = (c / CT) * SU + (c % CT); f32x4 v[8]; const float* row = norm_src(A, l, which, m);
#pragma unroll
        for (int j = 0; j < 8; ++j) v[j] = *(const f32x4*)(row + F.lane * 8 + 512 * (j >> 1) + 4 * (j & 1));
        norm_row(F, A, l, which, m, v, gain);
    }
}
__device__ __forceinline__ void ph_prep(const Ctx& F, const Args& A, int l) {
    const int lane = F.lane, g8 = lane & 7, hd = lane >> 3;
    constexpr float C2 = 0.125f * 1.4426950408889634f;
    bf16* R = ((bf16*)(A.ws + WS_STR)); bf16* KS = R + (size_t)M * BW; bf16* VS = R + 2 * (size_t)M * BW; bf16* KK = R + 3 * (size_t)M * BW;
    const float* ROPE = (const float*)(A.ws + WS_ROPE); bf16* LA = (bf16*)(A.ws + WS_LA);
    LAS float* const mu0b = (LAS float*)F.lds; LAS float* mu0 = mu0b; LAS float* mu1 = mu0 + BIN; LAS float* kkw = mu1 + BIN; LAS float* gwt = kkw + BW;
    for (int i = F.tid; i < 2 * BIN; i += NWAVES * 64) mu0[i] = (A.in[14])[(size_t)(l * 2) * BIN + i];
    for (int i = F.tid; i < BW; i += NWAVES * 64) kkw[i] = (A.in[20])[l * BW + i];
    if (F.tid < 256) { const int q = F.tid >> 6, j = F.tid & 63; gwt[F.tid] = (q == 0 ? (A.in[9]) : q == 1 ? (A.in[10]) : q == 2 ? (A.in[12]) : (A.in[13]))[l * 64 + j]; }
    __syncthreads();
    for (int m = F.gw; m < M; m += F.NGW) {
        const int s = m % SU; const bool isctx = s < CT; const int t = isctx ? 0 : s - CT;
        const bf16* prow = ((bf16*)(A.ws + WS_P)) + (size_t)m * NINP;
        { unsigned ob_ = 0; asm volatile("" : "+v"(ob_)); mu0 = mu0b + ob_; mu1 = mu0 + BIN; kkw = mu1 + BIN; gwt = kkw + BW; }
        const bool hasp = (s != 0 && s != CT), hasn = (s != CT - 1 && s != SU - 1);
        v4u rc[8], rp[8], rn[8];
#pragma unroll
        for (int pass = 0; pass < 8; ++pass) { const int c0 = pass * 512 + lane * 8; const bool on = pass < 7 || lane < 16;
            rc[pass] = on ? *(const v4u*)(prow + PB0 + c0) : (v4u){0u, 0u, 0u, 0u};
            rp[pass] = (on && hasp) ? *(const v4u*)(prow + PB0 + c0 - NINP) : (v4u){0u, 0u, 0u, 0u};
            rn[pass] = (on && hasn) ? *(const v4u*)(prow + PB0 + c0 + NINP) : (v4u){0u, 0u, 0u, 0u}; }
        f32x4 cs = {1.f, 1.f, 1.f, 1.f}, sn = {0.f, 0.f, 0.f, 0.f};
        if (!isctx) { cs = *(const f32x4*)(ROPE + t * 32 + 4 * g8); sn = *(const f32x4*)(ROPE + T * 32 + t * 32 + 4 * g8); }
#pragma unroll
        for (int pass = 0; pass < 3; ++pass) {
            const int part = pass < 2 ? pass : ((hd >> 1) & 1), hs = pass < 2 ? hd : (hd & 1);
            const int src = (pass < 2 ? (part ? PC_Q : PA_Q) : (part ? PC_K : PA_K)) + hs * 64 + 4 * g8;
            const LAS float* gw = gwt + (pass < 2 ? (part ? 2 : 0) : (part ? 3 : 1)) * 64 + 4 * g8;
            const v2u a = *(const v2u*)(prow + src), b = *(const v2u*)(prow + src + 32);
            float x1[4] = {__builtin_bit_cast(float, a.x << 16), __builtin_bit_cast(float, a.x & 0xffff0000u), __builtin_bit_cast(float, a.y << 16), __builtin_bit_cast(float, a.y & 0xffff0000u)};
            float x2[4] = {__builtin_bit_cast(float, b.x << 16), __builtin_bit_cast(float, b.x & 0xffff0000u), __builtin_bit_cast(float, b.y << 16), __builtin_bit_cast(float, b.y & 0xffff0000u)};
            float ss = 0.f;
#pragma unroll
            for (int e = 0; e < 4; ++e) ss += x1[e] * x1[e] + x2[e] * x2[e];
            const float rs = (1.0f / sqrtf(dpp_xor_sum8(ss) * (1.0f / 64.0f) + 1e-6f)) * (pass < 2 ? C2 : 1.0f);
            const f32x4 g1 = *(const LAS f32x4*)gw, g2 = *(const LAS f32x4*)(gw + 32);
            float o1[4], o2[4];
#pragma unroll
            for (int e = 0; e < 4; ++e) { const float y1 = x1[e] * rs * g1[e], y2 = x2[e] * rs * g2[e]; o1[e] = y1 * cs[e] - y2 * sn[e]; o2[e] = y1 * sn[e] + y2 * cs[e]; }
            bf16* dst = pass < 2 ? (part ? ((bf16*)(A.ws + WS_QC)) : ((bf16*)(A.ws + WS_QA))) + (size_t)m * 512 + hs * 64 + 4 * g8
                                 : (part ? ((bf16*)(A.ws + WS_KC)) : ((bf16*)(A.ws + WS_KA))) + (size_t)m * 128 + hs * 64 + 4 * g8;
            if (pass < 2 || hd < 4) { *(v2u*)dst = (v2u){pk2(o1[0], o1[1]), pk2(o1[2], o1[3])}; *(v2u*)(dst + 32) = (v2u){pk2(o2[0], o2[1]), pk2(o2[2], o2[3])}; }
        }
#pragma unroll
        for (int pass = 0; pass < 8; ++pass) {
            const int c0 = pass * 512 + lane * 8;
            if (pass == 7 && lane >= 16) break;
            const v4u pc = rc[pass], pp = rp[pass], pn = rn[pass];
            const f32x4 m0a = *(const LAS f32x4*)(mu0 + c0), m0b = *(const LAS f32x4*)(mu0 + c0 + 4), m1a = *(const LAS f32x4*)(mu1 + c0), m1b = *(const LAS f32x4*)(mu1 + c0 + 4);
            float xs[8];
#pragma unroll
            for (int e = 0; e < 8; ++e) { const unsigned wc = pc[e >> 1], wp = pp[e >> 1], wn = pn[e >> 1];
                const float p = __builtin_bit_cast(float, (e & 1) ? (wc & 0xffff0000u) : (wc << 16)), pv = __builtin_bit_cast(float, (e & 1) ? (wp & 0xffff0000u) : (wp << 16)), nx = __builtin_bit_cast(float, (e & 1) ? (wn & 0xffff0000u) : (wn << 16));
                const float a0 = e < 4 ? m0a[e] : m0b[e - 4], a1 = e < 4 ? m1a[e] : m1b[e - 4];
                xs[e] = p + a0 * (pv - p) + a1 * (nx - p); }
            if (pass < 6) {
                bf16* dst = (pass < 2 ? R : pass < 4 ? KS : VS) + (size_t)m * BW + (c0 & 1023);
                *(v4u*)dst = (v4u){pk2(xs[0], xs[1]), pk2(xs[2], xs[3]), pk2(xs[4], xs[5]), pk2(xs[6], xs[7])};
                if (pass == 2 || pass == 3) {
                    const int cc = c0 - BW; const f32x4 ka = *(const LAS f32x4*)(kkw + cc), kb = *(const LAS f32x4*)(kkw + cc + 4);
                    float z[8], n2 = 0.f;
#pragma unroll
                    for (int e = 0; e < 8; ++e) { z[e] = xs[e] * (e < 4 ? ka[e] : kb[e - 4]); n2 += z[e] * z[e]; }
                    const float inv = 1.0f / fmaxf(sqrtf(dpp_xor_sum8(n2)), 1e-12f);
                    *(v4u*)(KK + (size_t)m * BW + cc) = (v4u){pk2(z[0] * inv, z[1] * inv), pk2(z[2] * inv, z[3] * inv), pk2(z[4] * inv, z[5] * inv), pk2(z[6] * inv, z[7] * inv)};
                }
            } else {
                const int cl = c0 - 3 * BW, p2 = cl < 384 ? cl / 96 : 4, off = cl < 384 ? cl - 96 * p2 : cl - 384;
                float v[8];
#pragma unroll
                for (int e = 0; e < 8; ++e) { const float ex = __expf(p2 < 2 ? 2.0f * xs[e] : -xs[e]), rc = 1.0f / (1.0f + ex); v[e] = p2 < 2 ? 1.0f - 2.0f * rc : (p2 < 4 ? xs[e] : rc); }
                *(v4u*)(LA + ((size_t)p2 * M + m) * 256 + off) = (v4u){pk2(v[0], v[1]), pk2(v[2], v[3]), pk2(v[4], v[5]), pk2(v[6], v[7])};
            }
        }
        for (int i = lane; i < 80; i += 64) { const int p2 = i / 20, j = i % 20; *(v4u*)(LA + ((size_t)p2 * M + m) * 256 + 96 + 8 * j) = (v4u){0u, 0u, 0u, 0u}; }
    }
}
__device__ __forceinline__ void ph_readout(const Ctx& F, const Args& A, int l) {
    const int lane = F.lane; const bool last = (l == DEPTH - 1);
    const bf16* R = ((bf16*)(A.ws + WS_STR)); const bf16* KS = R + (size_t)M * BW; const bf16* VS = R + 2 * (size_t)M * BW;
    const bf16* Y0 = ((bf16*)(A.ws + WS_Y)); const bf16* Y1 = Y0 + (size_t)M * BW; const bf16* AG = ((bf16*)(A.ws + WS_AG));
    const bf16* A0 = AG; const bf16* A1 = AG + (size_t)M * BW; const bf16* Gt = AG + (size_t)2 * M * BW;
    const float* gng = (A.in[23]) + l * BW; const float* gnb = (A.in[24]) + l * BW; const float* kaw = (A.in[21]) + l * BW; const float* rkw = (A.in[22]) + l * BW;
    const int nrow = (M - F.gw + F.NGW - 1) / F.NGW, nit = 2 * nrow;
    v4u rw[8];
#define RO_LOAD(it_) do { const int m_ = F.gw + F.NGW * ((it_) >> 1); const size_t a_ = (size_t)m_ * BW + ((it_) & 1) * 512 + lane * 8; \
        rw[0] = *(const v4u*)(Y0 + a_); rw[1] = *(const v4u*)(Y1 + a_); rw[2] = *(const v4u*)(R + a_); rw[3] = *(const v4u*)(KS + a_); rw[4] = *(const v4u*)(VS + a_); \
        rw[5] = *(const v4u*)(A0 + a_); rw[6] = *(const v4u*)(A1 + a_); rw[7] = *(const v4u*)(Gt + a_); } while (0)
#define UB8(dst, u_) do { _Pragma("unroll") for (int e_ = 0; e_ < 8; ++e_) dst[e_] = __builtin_bit_cast(float, (e_ & 1) ? (u_[e_ >> 1] & 0xffff0000u) : (u_[e_ >> 1] << 16)); } while (0)
#define LD8(dst, ptr) do { const f32x4 u0_ = *(const f32x4*)(ptr), u1_ = *(const f32x4*)((ptr) + 4); dst[0] = u0_.x; dst[1] = u0_.y; dst[2] = u0_.z; dst[3] = u0_.w; dst[4] = u1_.x; dst[5] = u1_.y; dst[6] = u1_.z; dst[7] = u1_.w; } while (0)
    float qg[2][8], qb[2][8], qk[2][8], qr[2][8];
#pragma unroll
    for (int hh = 0; hh < 2; ++hh) { LD8(qg[hh], gng + hh * 512 + lane * 8); LD8(qb[hh], gnb + hh * 512 + lane * 8); LD8(qk[hh], kaw + hh * 512 + lane * 8); LD8(qr[hh], rkw + hh * 512 + lane * 8); }
    if (nit > 0) RO_LOAD(0);
    for (int it0 = 0; it0 < nit; it0 += 2)
#pragma unroll
    for (int hh2 = 0; hh2 < 2; ++hh2) {
        const int it = it0 + hh2; const int m = F.gw + F.NGW * (it >> 1), c0 = hh2 * 512 + lane * 8;
        float y[8], r[8], k[8], v[8], a0[8], a1[8], g[8], pg[8], pb[8], pk[8], pr[8];
        UB8(y, rw[0]); UB8(r, rw[1]);
#pragma unroll
        for (int e = 0; e < 8; ++e) y[e] += r[e];
        UB8(r, rw[2]); UB8(k, rw[3]); UB8(v, rw[4]); UB8(a0, rw[5]); UB8(a1, rw[6]); UB8(g, rw[7]);
        if (it + 1 < nit) RO_LOAD(it + 1);
        if (last && (m % SU) < CT) continue;
#pragma unroll
        for (int e = 0; e < 8; ++e) { pg[e] = qg[hh2][e]; pb[e] = qb[hh2][e]; pk[e] = qk[hh2][e]; pr[e] = qr[hh2][e]; }
        float sy = 0.f, sb = 0.f;
#pragma unroll
        for (int e = 0; e < 8; ++e) { sy += y[e]; sb += r[e] * (k[e] * (2.0f + (a0[e] + a1[e] - 2.0f) * pk[e])) * pr[e]; }
        const float mu = dpp_xor_sum8(sy) * (1.0f / 64.0f), bon = dpp_xor_sum8(sb);
        float sv = 0.f;
#pragma unroll
        for (int e = 0; e < 8; ++e) { y[e] -= mu; sv += y[e] * y[e]; }
        const float rstd = 1.0f / sqrtf(dpp_xor_sum8(sv) * (1.0f / 64.0f) + 64e-5f);
        float o[8];
#pragma unroll
        for (int e = 0; e < 8; ++e) o[e] = (y[e] * rstd * pg[e] + pb[e] + bon * v[e]) * g[e];
        *(v4u*)(((bf16*)(A.ws + WS_MIX)) + (size_t)m * D + 512 + c0) = (v4u){pk2(o[0], o[1]), pk2(o[2], o[3]), pk2(o[4], o[5]), pk2(o[6], o[7])};
    }
#undef RO_LOAD
#undef UB8
#undef LD8
}
namespace wk {
typedef short bf16x8 __attribute__((ext_vector_type(8)));
typedef short s16x4 __attribute__((ext_vector_type(4)));
typedef float f32x16 __attribute__((ext_vector_type(16)));
typedef float f32x4 __attribute__((ext_vector_type(4)));
typedef unsigned u32x4 __attribute__((ext_vector_type(4)));
typedef unsigned u32x2 __attribute__((ext_vector_type(2)));
#define WK_LAS __attribute__((address_space(3)))
#define WK_MFMA(a, b, c) __builtin_amdgcn_mfma_f32_32x32x16_bf16((a), (b), (c), 0, 0, 0)
constexpr int IMG = 16384;
constexpr int O_I0 = 0, O_I1 = IMG, O_I2 = 2 * IMG, O_I3 = 3 * IMG, O_I4 = 4 * IMG, O_I5 = 5 * IMG, O_I6 = 6 * IMG, O_NF = 7 * IMG, O_GAM = 6 * IMG + 8192, O_PART = O_GAM + 256;
constexpr int R1_LDS = 8 * IMG;
constexpr int O_ND = 131072 + 2048;
constexpr int UNIT_GF = 0, UNIT_RF = 8192, UNIT_HT = 16384, UNIT_Y0 = 24576, UNIT_BYTES = 32768;
__device__ __forceinline__ unsigned off_b(unsigned row, unsigned ch) { return 256u * row + 16u * (ch ^ (((row & 3u) << 2) | ((row >> 2) & 3u))); }
__device__ __forceinline__ int crow(int reg, int h) { return (reg & 3) + 8 * (reg >> 2) + 4 * h; }
__device__ __forceinline__ bf16x8 frag_row(const WK_LAS unsigned char* img, int c, int rb, int ks, int lane) {
    return *(const WK_LAS bf16x8*)(img + off_b(32 * rb + (lane & 31), 8 * c + 2 * ks + (lane >> 5)));
}
__device__ __forceinline__ bf16x8 frag_tr(const WK_LAS unsigned char* img, int c, int cb, int ks, int lane) {
    const unsigned h = lane >> 5, blk = (lane >> 4) & 1, q = (lane & 15) >> 2, p = lane & 3, ch = 4 * (2 * c + cb) + 2 * blk + (p >> 1);
    const s16x4 lo = __builtin_bit_cast(s16x4, __builtin_amdgcn_ds_read_tr16_b64_v4i16((WK_LAS s16x4*)(img + off_b(16 * ks + 8 * h + q, ch) + 8 * (p & 1))));
    const s16x4 hi = __builtin_bit_cast(s16x4, __builtin_amdgcn_ds_read_tr16_b64_v4i16((WK_LAS s16x4*)(img + off_b(16 * ks + 8 * h + 4 + q, ch) + 8 * (p & 1))));
    return (bf16x8){lo[0], lo[1], lo[2], lo[3], hi[0], hi[1], hi[2], hi[3]};
}
typedef float f32x2_t __attribute__((ext_vector_type(2))); typedef __bf16 bf16x2_t __attribute__((ext_vector_type(2)));
__device__ __forceinline__ unsigned pkbf(float lo, float hi) { const f32x2_t v = {lo, hi}; return __builtin_bit_cast(unsigned, __builtin_convertvector(v, bf16x2_t)); }
__device__ __forceinline__ void store_T(WK_LAS unsigned char* img, int c, int mb, int nb, const f32x16& a, int lane) {
    const unsigned row = 32 * nb + (lane & 31), h = lane >> 5;
#pragma unroll
    for (int g = 0; g < 4; ++g) *(WK_LAS u32x2*)(img + off_b(row, 8 * c + 4 * mb + g) + 8 * h) = (u32x2){pkbf(a[4 * g], a[4 * g + 1]), pkbf(a[4 * g + 2], a[4 * g + 3])};
}
template <bool STRICT> __device__ __forceinline__ void mask_diag(f32x16& a, int lane) {
    const int n = lane & 31, h = lane >> 5;
#pragma unroll
    for (int r = 0; r < 16; ++r) { const int m = crow(r, h); if (STRICT ? !(m < n) : !(m <= n)) a[r] = 0.f; }
}
__device__ __forceinline__ bf16x8 pack8(const f32x16& a, int s) { u32x4 p; p[0] = pkbf(a[8 * s], a[8 * s + 1]); p[1] = pkbf(a[8 * s + 2], a[8 * s + 3]); p[2] = pkbf(a[8 * s + 4], a[8 * s + 5]); p[3] = pkbf(a[8 * s + 6], a[8 * s + 7]); return __builtin_bit_cast(bf16x8, p); }
__device__ __forceinline__ f32x16 zero16() { f32x16 z;
#pragma unroll
    for (int i = 0; i < 16; ++i) z[i] = 0.f;
    return z; }
template <bool AT, bool BT> __device__ __forceinline__ void prod(f32x16& acc, const WK_LAS unsigned char* ia, int ca, int ba, const WK_LAS unsigned char* ib, int cbh, int bb, int lane) {
#pragma unroll
    for (int ks = 0; ks < 4; ++ks) {
        const bf16x8 a = AT ? frag_tr(ia, ca, ba, ks, lane) : frag_row(ia, ca, ba, ks, lane);
        const bf16x8 b = BT ? frag_tr(ib, cbh, bb, ks, lane) : frag_row(ib, cbh, bb, ks, lane);
        acc = WK_MFMA(a, b, acc);
    }
}
__device__ __forceinline__ void store_tile_f32(float* dst, const f32x16& a, int lane) {
#pragma unroll
    for (int q = 0; q < 4; ++q) *(f32x4*)(dst + (q * 64 + lane) * 4) = (f32x4){a[4 * q], a[4 * q + 1], a[4 * q + 2], a[4 * q + 3]};
}
__device__ __forceinline__ void store_tile_bf16(unsigned char* dst, const f32x16& a, int lane) {
#pragma unroll
    for (int q2 = 0; q2 < 2; ++q2) *(u32x4*)(dst + (q2 * 64 + lane) * 16) = (u32x4){pkbf(a[8 * q2], a[8 * q2 + 1]), pkbf(a[8 * q2 + 2], a[8 * q2 + 3]), pkbf(a[8 * q2 + 4], a[8 * q2 + 5]), pkbf(a[8 * q2 + 6], a[8 * q2 + 7])};
}
__device__ __forceinline__ void unpack_tile_bf16(f32x16& o, const u32x4& lo, const u32x4& hi) {
#pragma unroll
    for (int e = 0; e < 4; ++e) { o[2 * e] = __builtin_bit_cast(float, lo[e] << 16); o[2 * e + 1] = __builtin_bit_cast(float, lo[e] & 0xffff0000u); o[8 + 2 * e] = __builtin_bit_cast(float, hi[e] << 16); o[8 + 2 * e + 1] = __builtin_bit_cast(float, hi[e] & 0xffff0000u); }
}
struct R1In { const unsigned short *R, *KS, *VS, *KK, *Aa; const _Float16* E; const float* ka; };
struct R1Pre { u32x4 x[6]; };
__device__ __forceinline__ void r1_load(R1Pre& P, const R1In& in, int row0, int rstep, int col0, int tid) {
    const unsigned off = (unsigned)((row0 + rstep * (tid >> 3)) * BW + col0 + 8 * (tid & 7));
    P.x[0] = *(const u32x4*)(in.KK + off); P.x[1] = *(const u32x4*)(in.Aa + off); P.x[2] = *(const u32x4*)(in.KS + off);
    P.x[3] = *(const u32x4*)(in.R + off);  P.x[4] = *(const u32x4*)(in.VS + off); P.x[5] = *(const u32x4*)((const unsigned short*)in.E + off);
}
__device__ __forceinline__ void wkv_r1_unit(WK_LAS unsigned char* L, const R1In& in, R1Pre& P, int col0, unsigned char* urec, int tid, bool has_next, const R1In& inN, int row0N, int rstepN, int col0N) {
    int lane = tid & 63; const int w = __builtin_amdgcn_readfirstlane(tid >> 6); int h = lane >> 5;
#define WK_OPQ() do { asm volatile("" : "+v"(lane)); h = lane >> 5; } while (0)
    WK_LAS unsigned char* I0 = L + O_I0; WK_LAS unsigned char* I1 = L + O_I1; WK_LAS unsigned char* I2 = L + O_I2; WK_LAS unsigned char* I3 = L + O_I3;
    WK_LAS unsigned char* I4 = L + O_I4; WK_LAS unsigned char* I5 = L + O_I5; WK_LAS unsigned char* I6 = L + O_I6;
    WK_OPQ();
    WK_LAS float* NF = (WK_LAS float*)(L + O_NF); WK_LAS float* GAM = (WK_LAS float*)(L + O_GAM); WK_LAS float* PART = (WK_LAS float*)(L + O_PART); WK_LAS float* ND = (WK_LAS float*)(L + O_ND);
    { PB_BEGIN(30); PBS(36);
        WK_LAS unsigned char* ST = L + O_I3;
#pragma unroll
        for (int a = 0; a < 6; ++a) *(WK_LAS u32x4*)(ST + a * 8192 + tid * 16) = P.x[a];
        if (has_next) r1_load(P, inN, row0N, rstepN, col0N, tid);
        __syncthreads();
        float e[8], kk[8], aa[8], kv[8], rr[8]; unsigned short vraw[8];
        const float ka = in.ka[col0 + lane];
#pragma unroll
        for (int i = 0; i < 8; ++i) { const WK_LAS unsigned short* sp = (const WK_LAS unsigned short*)ST + (8 * w + i) * 64 + lane;
            kk[i] = bf2f(sp[0]); aa[i] = bf2f(sp[4096]); kv[i] = bf2f(sp[2 * 4096]); rr[i] = bf2f(sp[3 * 4096]); vraw[i] = sp[4 * 4096]; e[i] = (float)*(const WK_LAS _Float16*)(sp + 5 * 4096); }
        float run = 0.f;
#pragma unroll
        for (int i = 0; i < 8; ++i) run += e[i];
        PART[w * 64 + lane] = run;
        PBE(36);
        __syncthreads();
        PBS(37);
        float offs = 0.f, tot = 0.f;
#pragma unroll
        for (int w2 = 0; w2 < 8; ++w2) { const float pv = PART[w2 * 64 + lane]; tot += pv; if (w2 < w) offs += pv; }
        if (w == 0) GAM[lane] = __expf(-tot);
        float cum = offs, gprev = __expf(-offs);
#pragma unroll
        for (int i = 0; i < 8; ++i) {
            const int p = 8 * w + i; cum += e[i];
            const float g = __expf(-cum), ginv = __builtin_amdgcn_rcpf(g), a = aa[i];
            const float al = kk[i] * gprev, be = kk[i] * a * ginv, kp = kv[i] * (1.0f + (a - 1.0f) * ka) * ginv, rh = rr[i] * g;
            const unsigned o0 = off_b(p, lane >> 3) + 2 * (lane & 7), o1 = off_b(p, 8 + (lane >> 3)) + 2 * (lane & 7);
            const unsigned c01 = pkbf(al, be), c23 = pkbf(kp, rh);
            *(WK_LAS unsigned short*)(I0 + o0) = (unsigned short)c01; *(WK_LAS unsigned short*)(I0 + o1) = (unsigned short)(c01 >> 16);
            *(WK_LAS unsigned short*)(I1 + o0) = (unsigned short)c23; *(WK_LAS unsigned short*)(I1 + o1) = (unsigned short)(c23 >> 16);
            *(WK_LAS unsigned short*)(I2 + o0) = vraw[i];
            gprev = g;
        }
      PBE(37); PB_END(30); }
    __syncthreads();
    WK_OPQ();
    PBS(31);
#pragma unroll
    for (int q = 0; q < 2; ++q) {
        const int id = 2 * w + q, pr = id >> 2, mb = (id >> 1) & 1, nb = id & 1;
        f32x16 acc = zero16();
        if (pr == 0) {
            if (!(mb == 0 && nb == 1)) { prod<false, false>(acc, I0, 0, mb, I0, 1, nb, lane);
                if (mb == nb) {
#pragma unroll
                    for (int r = 0; r < 16; ++r) if (!((lane & 31) < crow(r, h))) acc[r] = 0.f;
#pragma unroll
                    for (int g = 0; g < 4; ++g) *(WK_LAS f32x4*)(ND + nb * 1024 + (g * 64 + lane) * 4) = (f32x4){acc[4 * g], acc[4 * g + 1], acc[4 * g + 2], acc[4 * g + 3]}; } }
#pragma unroll
            for (int g = 0; g < 4; ++g) *(WK_LAS f32x4*)(NF + (32 * nb + (lane & 31)) * 64 + 32 * mb + 8 * g + 4 * h) = (f32x4){acc[4 * g], acc[4 * g + 1], acc[4 * g + 2], acc[4 * g + 3]};
        } else if (pr == 1) {
            if (!(mb == 1 && nb == 0)) { prod<false, false>(acc, I1, 0, mb, I0, 0, nb, lane); if (mb == nb) mask_diag<true>(acc, lane); }
            store_T(I3, 0, mb, nb, acc, lane);
        } else if (pr == 2) {
            if (!(mb == 1 && nb == 0)) { prod<false, false>(acc, I1, 0, mb, I1, 1, nb, lane); if (mb == nb) mask_diag<false>(acc, lane); }
            store_T(I4, 0, mb, nb, acc, lane);
        } else {
            if (!(mb == 1 && nb == 0)) { prod<false, false>(acc, I0, 1, mb, I1, 1, nb, lane); if (mb == nb) mask_diag<false>(acc, lane); }
            store_T(I4, 1, mb, nb, acc, lane);
        }
    }
    PBE(31);
    __syncthreads();
    WK_OPQ();
    PBS(32);
    f32x16 accA = zero16(), accB = zero16(), accC = zero16();
    const int omb = (w >> 1) & 1, onb = w & 1;
    if (w == 0) {
        f32x16 X[2], XT[2], R[2], RT[2];
        const int tt = lane & 31;
#pragma unroll
        for (int b = 0; b < 2; ++b) {
#pragma unroll
            for (int g = 0; g < 4; ++g) { const f32x4 v = *(const WK_LAS f32x4*)(ND + b * 1024 + (g * 64 + lane) * 4); XT[b][4 * g] = v.x; XT[b][4 * g + 1] = v.y; XT[b][4 * g + 2] = v.z; XT[b][4 * g + 3] = v.w; }
#pragma unroll
            for (int r = 0; r < 16; ++r) X[b][r] = NF[(32 * b + crow(r, h)) * 64 + 32 * b + tt];
#pragma unroll
            for (int r = 0; r < 16; ++r) { const float d = (crow(r, h) == tt) ? 1.f : 0.f; R[b][r] = d - X[b][r]; RT[b][r] = d - XT[b][r]; }
        }
        bf16x8 pX[2][2], pT[2][2], pR[2][2];
#pragma unroll
        for (int b = 0; b < 2; ++b) { pX[b][0] = pack8(X[b], 0); pX[b][1] = pack8(X[b], 1); }
#pragma unroll
        for (int it = 0; it < 4; ++it) {
#pragma unroll
            for (int b = 0; b < 2; ++b) { pT[b][0] = pack8(XT[b], 0); pT[b][1] = pack8(XT[b], 1); }
#pragma unroll
            for (int b = 0; b < 2; ++b) {
                X[b] = WK_MFMA(pT[b][0], pX[b][0], zero16()); X[b] = WK_MFMA(pT[b][1], pX[b][1], X[b]);
                if (it < 3) { XT[b] = WK_MFMA(pX[b][0], pT[b][0], zero16()); XT[b] = WK_MFMA(pX[b][1], pT[b][1], XT[b]); }
            }
#pragma unroll
            for (int b = 0; b < 2; ++b) { pX[b][0] = pack8(X[b], 0); pX[b][1] = pack8(X[b], 1); pR[b][0] = pack8(RT[b], 0); pR[b][1] = pack8(RT[b], 1); }
#pragma unroll
            for (int b = 0; b < 2; ++b) {
                R[b] = WK_MFMA(pR[b][0], pX[b][0], R[b]); R[b] = WK_MFMA(pR[b][1], pX[b][1], R[b]);
                if (it < 3 || b == 0) { RT[b] = WK_MFMA(pX[b][0], pR[b][0], RT[b]); RT[b] = WK_MFMA(pX[b][1], pR[b][1], RT[b]); }
            }
        }
        store_T(I2, 1, 0, 0, R[0], lane); store_T(I2, 1, 1, 1, R[1], lane);
        if (h == 0) {
#pragma unroll
            for (int c4 = 0; c4 < 4; ++c4) *(WK_LAS u32x4*)(I2 + off_b(tt, 8 + 4 + c4)) = (u32x4){0u, 0u, 0u, 0u};
        }
        {
            f32x16 t1 = zero16();
#pragma unroll
            for (int ks = 0; ks < 2; ++ks) {
                const WK_LAS float* np = NF + tt * 64 + 32 + 16 * ks + 4 * h; const f32x4 n0 = *(const WK_LAS f32x4*)np, n1 = *(const WK_LAS f32x4*)(np + 8);
                const bf16x8 a = __builtin_bit_cast(bf16x8, (u32x4){pkbf(n0.x, n0.y), pkbf(n0.z, n0.w), pkbf(n1.x, n1.y), pkbf(n1.z, n1.w)});
                t1 = WK_MFMA(a, pack8(R[1], ks), t1);
            }
            f32x16 m01 = zero16();
#pragma unroll
            for (int ks = 0; ks < 2; ++ks) m01 = WK_MFMA(pack8(RT[0], ks), pack8(t1, ks), m01);
#pragma unroll
            for (int r = 0; r < 16; ++r) m01[r] = -m01[r];
            store_T(I2, 1, 0, 1, m01, lane);
        }
    } else if (w < 4) {
        prod<false, true>(accA, I4, 0, omb, I2, 0, onb, lane);
        if (w == 1) prod<false, true>(accC, I4, 0, 0, I2, 0, 0, lane);
    } else {
        prod<true, true>(accA, I1, 0, omb, I2, 0, onb, lane);
        f32x16 q = zero16(); prod<true, false>(q, I2, 0, omb, I3, 0, onb, lane); store_T(I3, 1, omb, onb, q, lane);
    }
    WK_OPQ();
    PBE(32);
    __syncthreads();
    WK_OPQ();
    PBS(33);
    {
        f32x16 acc = zero16();
        if (w < 4) { prod<true, false>(acc, I0, 0, omb, I2, 1, onb, lane); store_T(I5, 0, omb, onb, acc, lane); }
        else       { prod<true, false>(acc, I3, 1, omb, I2, 1, onb, lane); store_T(I5, 1, omb, onb, acc, lane); }
    }
    PBE(33);
    __syncthreads();
    WK_OPQ();
#pragma unroll
    for (int a = 0; a < 6; ++a) asm volatile("" :: "v"(P.x[a]));
    PBS(34);
    if (w < 4) {
        f32x16 acc = zero16();
        prod<true, false>(acc, I5, 0, omb, I4, 1, onb, lane);
        { const unsigned row = 32 * onb + (lane & 31);
#pragma unroll
            for (int g = 0; g < 4; ++g) { const u32x2 rv = *(const WK_LAS u32x2*)(I1 + off_b(row, 8 + 4 * omb + g) + 8 * h);
                acc[4 * g] = __builtin_bit_cast(float, rv.x << 16) - acc[4 * g]; acc[4 * g + 1] = __builtin_bit_cast(float, rv.x & 0xffff0000u) - acc[4 * g + 1];
                acc[4 * g + 2] = __builtin_bit_cast(float, rv.y << 16) - acc[4 * g + 2]; acc[4 * g + 3] = __builtin_bit_cast(float, rv.y & 0xffff0000u) - acc[4 * g + 3]; } }
#pragma unroll
        for (int s = 0; s < 2; ++s) *(bf16x8*)(urec + UNIT_RF + (((omb * 2 + onb) * 2 + s) * 64 + lane) * 16) = pack8(acc, s);
        if (w >= 1) {
            prod<false, true>(accB, I4, 1, omb, I5, 1, onb, lane);
#pragma unroll
            for (int r = 0; r < 16; ++r) accA[r] -= accB[r];
            store_tile_bf16(urec + UNIT_Y0 + (omb * 2 + onb) * 2048, accA, lane);
            if (w == 1) { f32x16 b2 = zero16(); prod<false, true>(b2, I4, 1, 0, I5, 1, 0, lane);
#pragma unroll
                for (int r = 0; r < 16; ++r) accC[r] -= b2[r];
                store_tile_bf16(urec + UNIT_Y0, accC, lane); }
        }
    } else {
        f32x16 x = zero16();
        prod<true, true>(x, I5, 0, omb, I0, 1, onb, lane);
        const float gj = GAM[32 * onb + (lane & 31)];
#pragma unroll
        for (int r = 0; r < 16; ++r) x[r] = gj * (((32 * omb + crow(r, h)) == (32 * onb + (lane & 31)) ? 1.f : 0.f) - x[r]);
#pragma unroll
        for (int s = 0; s < 2; ++s) *(bf16x8*)(urec + UNIT_GF + (((omb * 2 + onb) * 2 + s) * 64 + lane) * 16) = pack8(x, s);
        prod<true, true>(accB, I0, 1, omb, I5, 1, onb, lane);
#pragma unroll
        for (int g = 0; g < 4; ++g) { const f32x4 gv = *(const WK_LAS f32x4*)(GAM + 32 * omb + 8 * g + 4 * h);
            accA[4 * g] = gv.x * (accA[4 * g] - accB[4 * g]); accA[4 * g + 1] = gv.y * (accA[4 * g + 1] - accB[4 * g + 1]); accA[4 * g + 2] = gv.z * (accA[4 * g + 2] - accB[4 * g + 2]); accA[4 * g + 3] = gv.w * (accA[4 * g + 3] - accB[4 * g + 3]); }
        store_tile_bf16(urec + UNIT_HT + (omb * 2 + onb) * 2048, accA, lane);
    }
    PBE(34);
    __syncthreads();
#undef WK_OPQ
}
constexpr int R2_NS = 8, R2_CTL = R2_NS * 4096;
struct R2G { bf16x8 g[8]; u32x4 h[2][2]; };
__device__ __forceinline__ void r2_ld_g(R2G& X, const unsigned char* u, int vb, int lane) {
#pragma unroll
    for (int f = 0; f < 8; ++f) X.g[f] = *(const bf16x8*)(u + UNIT_GF + (f * 64 + lane) * 16);
#pragma unroll
    for (int mbk = 0; mbk < 2; ++mbk)
#pragma unroll
        for (int q = 0; q < 2; ++q) X.h[mbk][q] = *(const u32x4*)(u + UNIT_HT + (mbk * 2 + vb) * 2048 + (q * 64 + lane) * 16);
}
__device__ __forceinline__ void r2_step_a(f32x16& S0, f32x16& S1, const R2G& X, WK_LAS unsigned char* L, int ci, int lane) {
    volatile WK_LAS unsigned* ctl = (volatile WK_LAS unsigned*)(L + R2_CTL);
    if (ci >= R2_NS) { unsigned sp_ = 0; while (((int)ctl[1] < ci - R2_NS + 1 || (int)ctl[2] < ci - R2_NS + 1) && ++sp_ < (1u << 22)) __builtin_amdgcn_s_sleep(1); }
    const bf16x8 s00 = pack8(S0, 0), s01 = pack8(S0, 1), s10 = pack8(S1, 0), s11 = pack8(S1, 1);
    WK_LAS bf16x8* slot = (WK_LAS bf16x8*)(L + (ci % R2_NS) * 4096) + lane;
    slot[0] = s00; slot[64] = s01; slot[128] = s10; slot[192] = s11;
    asm volatile("s_waitcnt lgkmcnt(0)" ::: "memory");
    if (lane == 0) ctl[0] = (unsigned)(ci + 1);
    f32x16 h0, h1; unpack_tile_bf16(h0, X.h[0][0], X.h[0][1]); unpack_tile_bf16(h1, X.h[1][0], X.h[1][1]);
    h0 = WK_MFMA(X.g[0], s00, h0); h0 = WK_MFMA(X.g[1], s01, h0); h0 = WK_MFMA(X.g[4], s10, h0); h0 = WK_MFMA(X.g[5], s11, h0);
    h1 = WK_MFMA(X.g[2], s00, h1); h1 = WK_MFMA(X.g[3], s01, h1); h1 = WK_MFMA(X.g[6], s10, h1); h1 = WK_MFMA(X.g[7], s11, h1);
    S0 = h0; S1 = h1;
}
struct R2Rh { bf16x8 r[4]; u32x4 y[2]; };
__device__ __forceinline__ void r2_ld_rh(R2Rh& X, const unsigned char* u, int vb, int tb, int lane) {
#pragma unroll
    for (int ib = 0; ib < 2; ++ib)
#pragma unroll
        for (int s = 0; s < 2; ++s) X.r[ib * 2 + s] = *(const bf16x8*)(u + UNIT_RF + ((((ib * 2 + tb) * 2 + s) * 64) + lane) * 16);
#pragma unroll
    for (int q = 0; q < 2; ++q) X.y[q] = *(const u32x4*)(u + UNIT_Y0 + (tb * 2 + vb) * 2048 + (q * 64 + lane) * 16);
}
__device__ __forceinline__ void r2_step_b(R2Rh& X, const unsigned char* unext, WK_LAS unsigned char* L, int ci, unsigned short* Yo, int brow0, int dir, int col0, int vb, int tb, int lane) {
    volatile WK_LAS unsigned* ctl = (volatile WK_LAS unsigned*)(L + R2_CTL);
    { unsigned sp_ = 0; while ((int)ctl[0] < ci + 1 && ++sp_ < (1u << 22)) __builtin_amdgcn_s_sleep(1); }
    asm volatile("" ::: "memory");
    const WK_LAS bf16x8* slot = (const WK_LAS bf16x8*)(L + (ci % R2_NS) * 4096) + lane;
    const bf16x8 s00 = slot[0], s01 = slot[64], s10 = slot[128], s11 = slot[192];
    f32x16 yo; unpack_tile_bf16(yo, X.y[0], X.y[1]);
    yo = WK_MFMA(X.r[0], s00, yo); yo = WK_MFMA(X.r[1], s01, yo); yo = WK_MFMA(X.r[2], s10, yo); yo = WK_MFMA(X.r[3], s11, yo);
    asm volatile("s_waitcnt lgkmcnt(0)" ::: "memory");
    if (lane == 0) ctl[1 + tb] = (unsigned)(ci + 1);
    r2_ld_rh(X, unext, vb, tb, lane);
    const int uc = dir == 0 ? ci : (ci < 4 ? 3 - ci : 71 - ci);
    int lo_ = lane; asm volatile("" : "+v"(lo_));
    WK_LAS unsigned short* ys = (WK_LAS unsigned short*)(L + R2_CTL + 256 + tb * 2048);
    const int n_ = lo_ & 31, h_ = lo_ >> 5;
#pragma unroll
    for (int r = 0; r < 16; r += 2) { const unsigned pr_ = pkbf(yo[r], yo[r + 1]);
        ys[((r & 3) + 8 * (r >> 2) + 4 * h_) * 32 + n_] = (unsigned short)pr_; ys[(((r + 1) & 3) + 8 * ((r + 1) >> 2) + 4 * h_) * 32 + n_] = (unsigned short)(pr_ >> 16); }
    asm volatile("s_waitcnt lgkmcnt(0)" ::: "memory");
#pragma unroll
    for (int k = 0; k < 2; ++k) { const int pl = 16 * k + (lo_ >> 2), pos = 32 * tb + pl; const u32x4 v = *(const WK_LAS u32x4*)((const WK_LAS unsigned char*)ys + pl * 64 + (lo_ & 3) * 16);
        *(u32x4*)(Yo + (size_t)(brow0 + 64 * uc + (dir ? 63 - pos : pos)) * BW + col0 + 32 * vb + (lo_ & 3) * 8) = v; }
    asm volatile("s_waitcnt lgkmcnt(0)" ::: "memory");
}
__device__ __forceinline__ void wkv_r2_chain(const unsigned char* urec0, unsigned short* Yo, int brow0, int dir, int col0, int vb, int lane, int role, WK_LAS unsigned char* L) {
#define R2_U(ci_) (urec0 + (size_t)((ci_) < 68 ? (ci_) : 67) * UNIT_BYTES)
    if (role == 0) {
        f32x16 S0 = zero16(), S1 = zero16();
        R2G X0, X1; r2_ld_g(X0, R2_U(0), vb, lane); r2_ld_g(X1, R2_U(1), vb, lane);
        for (int ci = 0; ci < 68; ci += 2) {
            r2_step_a(S0, S1, X0, L, ci, lane);     r2_ld_g(X0, R2_U(ci + 2), vb, lane);
            r2_step_a(S0, S1, X1, L, ci + 1, lane); r2_ld_g(X1, R2_U(ci + 3), vb, lane);
        }
    } else {
        const int tb = role - 1;
        R2Rh X0, X1, X2, X3; r2_ld_rh(X0, R2_U(0), vb, tb, lane); r2_ld_rh(X1, R2_U(1), vb, tb, lane); r2_ld_rh(X2, R2_U(2), vb, tb, lane); r2_ld_rh(X3, R2_U(3), vb, tb, lane);
        for (int ci = 0; ci < 68; ci += 4) {
            r2_step_b(X0, R2_U(ci + 4), L, ci, Yo, brow0, dir, col0, vb, tb, lane);
            r2_step_b(X1, R2_U(ci + 5), L, ci + 1, Yo, brow0, dir, col0, vb, tb, lane);
            r2_step_b(X2, R2_U(ci + 6), L, ci + 2, Yo, brow0, dir, col0, vb, tb, lane);
            r2_step_b(X3, R2_U(ci + 7), L, ci + 3, Yo, brow0, dir, col0, vb, tb, lane);
        }
    }
#undef R2_U
}
#undef WK_LAS
#undef WK_MFMA
}
__device__ __forceinline__ void ph_wkv_r1(const Ctx& F, const Args& A, int l) {
    const bf16* STR = (const bf16*)(A.ws + WS_STR);
#define R1_UNIT_SETUP(u_, in_, row0_, rstep_, col0_) do { const int ci_ = (u_) % 68, hd_ = ((u_) / 68) & 15, dir_ = ((u_) / (68 * 16)) & 1, b_ = (u_) / (68 * 32); \
        const int uc_ = dir_ == 0 ? ci_ : (ci_ < 4 ? 3 - ci_ : 71 - ci_); \
        in_.R = STR; in_.KS = STR + (size_t)M * BW; in_.VS = STR + 2 * (size_t)M * BW; in_.KK = STR + 3 * (size_t)M * BW; \
        in_.E = (const _Float16*)(A.ws + WS_LO) + (size_t)dir_ * M * BW; in_.Aa = (const bf16*)(A.ws + WS_AG) + (size_t)dir_ * M * BW; in_.ka = A.in[21] + l * BW; \
        row0_ = b_ * SU + 64 * uc_ + (dir_ ? 63 : 0); rstep_ = dir_ ? -1 : 1; col0_ = 64 * hd_; } while (0)
    constexpr int NU = 2 * 2 * 16 * 68;
    wk::R1Pre P; wk::R1In in, inN; int row0, rstep, col0, row0N = 0, rstepN = 1, col0N = 0;
    int u = F.vcu;
    if (u < NU) { R1_UNIT_SETUP(u, in, row0, rstep, col0); wk::r1_load(P, in, row0, rstep, col0, F.tid); }
    for (; u < NU; u += F.G) {
        const bool hn = (u + F.G) < NU; inN = in;
        if (hn) R1_UNIT_SETUP(u + F.G, inN, row0N, rstepN, col0N);
        wk::wkv_r1_unit(F.lds, in, P, col0, A.ws + WS_RW + (size_t)u * wk::UNIT_BYTES, F.tid, hn, inN, row0N, rstepN, col0N);
        in = inN; col0 = col0N;
    }
#undef R1_UNIT_SETUP
}
__device__ __forceinline__ void ph_attn(const Ctx& F, const Args& A, int l, char* ldsg) {
    const bool last = (l == DEPTH - 1);
    typedef attn_body::bf16 abf;
    for (int i = 0;; ++i) {
        int u;
        if (F.G == 256) { if (i == 0) u = F.vcu; else if (F.vcu < 128 || i > 3) break; else if (i < 3) u = 256 + 2 * (F.vcu - 128) + (i - 1); else { if (last || F.vcu >= 160) break; u = 512 + (F.vcu - 128); } }
        else { u = i * F.G + F.vcu; if (u >= (last ? 512 : 544)) break; }
        attn_body::AttnJob J;
        if (u < 256) {
            const int b = u >> 7, h = (u >> 4) & 7, qb = u & 15; const size_t r0 = (size_t)b * SU, q0 = r0 + CT + (size_t)qb * 256;
            J.Qw0 = (const abf*)(((bf16*)(A.ws + WS_QC)) + q0 * 512 + h * 64); J.Kh = (const abf*)(((bf16*)(A.ws + WS_KC)) + r0 * 128 + (h >> 2) * 64); J.Vh = (const abf*)(((bf16*)(A.ws + WS_P)) + r0 * NINP + PC_V + (h >> 2) * 64);
            J.o_off = (unsigned)(q0 * D + 1536 + h * 64); J.NT = 68; J.lat_lo = 0; J.qpos0 = 0; J.sidx = -1;
            attn_body::attn_unit<0, 8>(J, A, ldsg, F.wave);
        } else if (u < 512) {
            const int w = u - 256, b = w >> 7, h = (w >> 4) & 7, qb = w & 15; const size_t r0 = (size_t)b * SU, q0 = r0 + CT + (size_t)qb * 256;
            const int lo = (4 * qb - 2) < 0 ? 0 : 4 * qb - 2, hi = (4 * qb + 5) > 63 ? 63 : 4 * qb + 5;
            J.Qw0 = (const abf*)(((bf16*)(A.ws + WS_QA)) + q0 * 512 + h * 64); J.Kh = (const abf*)(((bf16*)(A.ws + WS_KA)) + r0 * 128 + (h >> 2) * 64); J.Vh = (const abf*)(((bf16*)(A.ws + WS_P)) + r0 * NINP + PA_V + (h >> 2) * 64);
            J.o_off = (unsigned)(q0 * D + h * 64); J.NT = 4 + (hi - lo + 1); J.lat_lo = lo; J.qpos0 = qb * 256; J.sidx = l * 8 + h;
            attn_body::attn_unit<1, 8>(J, A, ldsg, F.wave);
        } else {
            const int c = u - 512, part = c >> 4, b = (c >> 3) & 1, h = c & 7; const size_t r0 = (size_t)b * SU;
            J.Qw0 = (const abf*)((part ? ((bf16*)(A.ws + WS_QC)) : ((bf16*)(A.ws + WS_QA))) + r0 * 512 + h * 64); J.Kh = (const abf*)((part ? ((bf16*)(A.ws + WS_KC)) : ((bf16*)(A.ws + WS_KA))) + r0 * 128 + (h >> 2) * 64);
            J.Vh = (const abf*)(((bf16*)(A.ws + WS_P)) + r0 * NINP + (part ? PC_V : PA_V) + (h >> 2) * 64); J.o_off = (unsigned)(r0 * D + (part ? 1536 : 0) + h * 64);
            J.NT = 4; J.lat_lo = 0; J.qpos0 = 0; J.sidx = part ? -1 : l * 8 + h;
            attn_body::attn_unit<0, 8>(J, A, ldsg, F.wave);
        }
    }
    if (F.tid < 4) ((volatile LAS unsigned*)(F.lds + wk::R2_CTL))[F.tid] = 0u;
    __syncthreads();
    { PB_BEGIN(12);
      for (int hc = F.vcu; hc < 128; hc += F.G) if (F.wave < 3) {
          const int ch = hc >> 1, b = ch >> 5, hd = (ch >> 1) & 15, dir = ch & 1;
          wk::wkv_r2_chain(A.ws + WS_RW + (size_t)(((b * 2 + dir) * 16 + hd) * 68) * wk::UNIT_BYTES, (bf16*)(A.ws + WS_Y) + (size_t)dir * M * BW, b * SU, dir, 64 * hd, hc & 1, F.lane, F.wave, F.lds);
      }
      PB_END(12); }
}
#define MKARGS() const __attribute__((address_space(4))) Args* ap_ = (const __attribute__((address_space(4))) Args*)__builtin_amdgcn_kernarg_segment_ptr(); asm volatile("" : "+s"(ap_)); const Args& A = *(const Args*)ap_
#define MKCTX() MKARGS(); Ctx F; { int t_ = wv * 64 + hw_lane(); asm volatile("" : "+v"(t_)); F.lds = ldsb; F.tid = t_; F.lane = t_ & 63; F.wave = __builtin_amdgcn_readfirstlane(t_ >> 6); F.G = gridDim.x; \
        { const int bx = blockIdx.x; F.vcu = (F.G % 8 == 0) ? (bx % 8) * (F.G / 8) + bx / 8 : bx; } F.gw = F.vcu * NWAVES + F.wave; F.NGW = F.G * NWAVES; }
#ifndef ONLY_PHASE
#define ONLY_PHASE -1
#endif
#define EN(j) (ONLY_PHASE < 0 || ONLY_PHASE == (j))
#define IN(k) (lo <= (k) && (k) < hi)
#define SEAM(k) do { if (IN((k) + 1)) { if (MK_PER_PHASE) { if (wv == 0 && hw_lane() == 0) __hip_atomic_store(ctl + CW_TMO, 0xBADBA0u, RLX_AGENT); } else { xcd_barrier(bar, wv == 0 && hw_lane() == 0); if (PROBE_PHASE == 20) xcd_barrier(bar, wv == 0 && hw_lane() == 0); } } } while (0)
template <int l> __device__ __forceinline__ void layer_phases(int wv, int lo, int hi, const XcdBarrier& bar, gu32* ctl, LAS unsigned char* const ldsb, unsigned char* lds_raw) {
        const int pb = 2 + PPL * l; const bool last = (l == DEPTH - 1);
        if (EN(2) && IN(pb + 0)) { MKCTX(); PB_BEGIN(2); ph_norm(F, A, l, 0); PB_END(2); SEAM(pb + 0); }
        if (EN(3) && IN(pb + 1)) {
            MKARGS();
            pg8::Gemm g{((bf16*)(A.ws + WS_U)), ((bf16*)(A.ws + WS_WIN)) + (size_t)l * NINP * D, M, NINP, D}; pg8::StaticOrder S; S.init(M, NINP, (int)gridDim.x, (int)blockIdx.x);
            pg8::EpiBf16<0> E{((bf16*)(A.ws + WS_P)), NINP, nullptr, 0, 0, 1.f};
            PB_BEGIN(3);
            pg8::gemm_phase<pg8::EpiBf16<0>, pg8::StaticOrder, true, true>(ldsb, g, S, E, wv * 64 + hw_lane());
            if ((int)gridDim.x == 256 && (int)blockIdx.x >= 202) { MKCTX(); convert_items(F, A, l, 1, 0, CI_OUT, ((int)blockIdx.x - 202) * NWAVES + F.wave, 54 * NWAVES); }
            PB_END(3);
            SEAM(pb + 1);
        }
        if (EN(4) && IN(pb + 2)) { MKCTX(); PB_BEGIN(4); ph_prep(F, A, l); PB_END(4); SEAM(pb + 2); }
        if (EN(5) && IN(pb + 3)) {
            MKARGS();
            pg8::Gemm g{((bf16*)(A.ws + WS_LA)), ((bf16*)(A.ws + WS_LW)) + (size_t)l * 5 * 1024 * 256, 5 * M, 5 * 1024, 256}; pg8::LoraOrder S{(int)gridDim.x, (int)blockIdx.x};
            pg8::EpiLora E{((_Float16*)(A.ws + WS_LO)), (bf16*)(A.ws + WS_AG), (A.in[15]) + (size_t)l * 2 * BW, (A.in[17]) + (size_t)l * 2 * BW};
            PB_BEGIN(5);
            pg8::gemm_phase<pg8::EpiLora, pg8::LoraOrder, true, true>(ldsb, g, S, E, wv * 64 + hw_lane());
            PB_END(5);
            SEAM(pb + 3);
        }
        if (EN(13) && IN(pb + 4)) { MKCTX(); PB_BEGIN(13); ph_wkv_r1(F, A, l); PB_END(13); SEAM(pb + 4); }
        if (EN(6) && IN(pb + 5)) { MKCTX(); PB_BEGIN(6); ph_attn(F, A, l, (char*)lds_raw); PB_END(6); SEAM(pb + 5); }
        if (EN(7) && IN(pb + 6)) { MKCTX(); PB_BEGIN(7); ph_readout(F, A, l); PB_END(7); SEAM(pb + 6); }
        if (EN(8) && IN(pb + 7)) {
            MKARGS();
            pg8::Gemm g{((bf16*)(A.ws + WS_MIX)), ((bf16*)(A.ws + WS_WOUT)) + (size_t)l * D * D, M, D, D}; pg8::RowMapOrder S; S.init2(D, D, (int)gridDim.x, (int)blockIdx.x, last ? 1 : 0, 8);
            pg8::EpiResid E{l == 0 ? (A.in[0]) : (A.out), l == 0 ? (A.in[2]) : ((float*)(A.ws + WS_HCTX)), (A.out), ((float*)(A.ws + WS_HCTX)), ((float*)(A.ws + WS_MOD)) + (size_t)l * 3 * MODW + 2 * D, (float*)(A.ws + WS_SL)};
            PB_BEGIN(8);
            pg8::gemm_phase<pg8::EpiResid, pg8::RowMapOrder, true, true>(ldsb, g, S, E, wv * 64 + hw_lane());
            if (!last && (int)gridDim.x == 256 && (int)blockIdx.x >= 128) { MKCTX(); const int w0_ = ((int)blockIdx.x - 128) * NWAVES + F.wave, nw_ = 128 * NWAVES;
                convert_items(F, A, l, 2, 0, CI_1, w0_, nw_); convert_items(F, A, 3, 3, l * (CI_2 / 3 + 1), (l + 1) * (CI_2 / 3 + 1) < CI_2 ? (l + 1) * (CI_2 / 3 + 1) : CI_2, w0_, nw_); }
            PB_END(8);
            SEAM(pb + 7);
        }
        if (EN(9) && IN(pb + 8)) { MKCTX(); PB_BEGIN(9); ph_norm(F, A, l, 1); PB_END(9); SEAM(pb + 8); }
        if (EN(10) && IN(pb + 9)) {
            MKARGS();
            pg8::Gemm g{((bf16*)(A.ws + WS_U)), ((bf16*)(A.ws + WS_W1)) + (size_t)l * FF * D, M, FF, D}; pg8::RowMapOrder S; S.init2(FF, D, (int)gridDim.x, (int)blockIdx.x, last ? 1 : 0, 1);
            pg8::EpiRelu2 E{((bf16*)(A.ws + WS_HID)), FF};
            PB_BEGIN(10);
            pg8::gemm_phase<pg8::EpiRelu2, pg8::RowMapOrder, true, true>(ldsb, g, S, E, wv * 64 + hw_lane());
            if (!last && (int)gridDim.x == 256 && (int)blockIdx.x >= 64) { MKCTX(); const int w0_ = ((int)blockIdx.x - 64) * NWAVES + F.wave, nw_ = 192 * NWAVES;
                convert_items(F, A, l, 3, 0, CI_2, w0_, nw_); convert_items(F, A, 3, 2, l * (CI_1 / 3 + 1), (l + 1) * (CI_1 / 3 + 1) < CI_1 ? (l + 1) * (CI_1 / 3 + 1) : CI_1, w0_, nw_); }
            PB_END(10);
            SEAM(pb + 9);
        }
        if (EN(11) && IN(pb + 10)) {
            MKARGS();
            pg8::Gemm g{((bf16*)(A.ws + WS_HID)), ((bf16*)(A.ws + WS_W2)) + (size_t)l * D * FF, M, D, FF}; pg8::RowMapOrder S; S.init2(D, FF, (int)gridDim.x, (int)blockIdx.x, last ? 1 : 0, 8);
            pg8::EpiResid E{(A.out), ((float*)(A.ws + WS_HCTX)), (A.out), ((float*)(A.ws + WS_HCTX)), ((float*)(A.ws + WS_MOD)) + (size_t)l * 3 * MODW + 5 * D, (float*)(A.ws + WS_SL)};
            PB_BEGIN(11);
            pg8::gemm_phase<pg8::EpiResid, pg8::RowMapOrder, true, true>(ldsb, g, S, E, wv * 64 + hw_lane());
            if (!last && (int)gridDim.x == 256 && (int)blockIdx.x >= 128) { MKCTX(); convert_items(F, A, l + 1, 0, 0, CI_IN, ((int)blockIdx.x - 128) * NWAVES + F.wave, 128 * NWAVES); }
            PB_END(11);
            SEAM(pb + 10);
        }
}
__global__ void __launch_bounds__(NWAVES * 64, 2) fwd(Args args) {
    extern __shared__ __attribute__((aligned(16))) unsigned char lds_raw[];
    LAS unsigned char* const ldsb = (LAS unsigned char*)lds_raw;
    unsigned char* ws = args.ws;
    const int wv = __builtin_amdgcn_readfirstlane((int)threadIdx.x >> 6);
    for (int u = wv * 64 + hw_lane(); u < (LDS_BYTES - LDSCTL_OFF) / 4; u += NWAVES * 64) ((LAS unsigned*)(ldsb + LDSCTL_OFF))[u] = 0u;
    __syncthreads();
    gu32* ctl = (gu32*)(ws + WS_CTL);
    XcdBarrier bar; bar.bar = (unsigned*)(ctl + CW_BAR); bar.x = 0; bar.st = nullptr;
    if (!MK_PER_PHASE) bar = xcd_barrier_post((unsigned*)(ctl + CW_BAR), (volatile LAS unsigned*)(ldsb + MISC_OFF) + 8, wv == 0 && hw_lane() == 0);
    const int lo = args.ph_lo, hi = args.ph_hi;
    if (EN(0) && IN(0)) { MKCTX(); PB_BEGIN(0); p0_prologue(F, A); PB_END(0); SEAM(0); }
    if (EN(1) && IN(1)) { MKCTX(); PB_BEGIN(1); p0b_mods(F, A); PB_END(1); SEAM(1); }
    layer_phases<0>(wv, lo, hi, bar, ctl, ldsb, lds_raw); layer_phases<1>(wv, lo, hi, bar, ctl, ldsb, lds_raw); layer_phases<2>(wv, lo, hi, bar, ctl, ldsb, lds_raw); layer_phases<3>(wv, lo, hi, bar, ctl, ldsb, lds_raw);
#undef IN
#undef SEAM
}
extern "C" void kernel_launch(void* const* d_in, const int* in_sizes, int n_in, void* d_out, int out_size, void* d_ws, size_t ws_size, hipStream_t stream) {
    static int grid = 0;
    if (grid == 0) {
        if (n_in != 28 || out_size != NB * T * D || ws_size < WS_END) { fprintf(stderr, "kernel_launch: unexpected shapes (n_in %d, out %d, ws %zu < %zu)\n", n_in, out_size, ws_size, (size_t)WS_END); grid = -1; return; }
        int dev = 0, cus = 0, per_cu = 0;
        if (hipGetDevice(&dev) != hipSuccess || hipDeviceGetAttribute(&cus, hipDeviceAttributeMultiprocessorCount, dev) != hipSuccess) { grid = -1; return; }
        if (hipFuncSetAttribute((const void*)fwd, hipFuncAttributeMaxDynamicSharedMemorySize, LDS_BYTES) != hipSuccess) { fprintf(stderr, "kernel_launch: hipFuncSetAttribute failed\n"); grid = -1; return; }
        if (hipOccupancyMaxActiveBlocksPerMultiprocessor(&per_cu, (const void*)fwd, NWAVES * 64, LDS_BYTES) != hipSuccess || per_cu < 1) fprintf(stderr, "kernel_launch: occupancy query reports %d\n", per_cu);
        (void)hipGetLastError();
        grid = cus;
    }
    if (grid < 0) return;
    if (hipMemsetAsync((char*)d_ws + WS_CTL, 0, CTL_ZERO_BYTES, stream) != hipSuccess) return;
    Args a{};
    for (int i = 0; i < 28; ++i) a.in[i] = (const float*)d_in[i];
    a.out = (float*)d_out; a.ws = (unsigned char*)d_ws;
#if MK_PER_PHASE
    for (int p = 0; p < N_PHASES; ++p) { a.ph_lo = p; a.ph_hi = p + 1; hipLaunchKernelGGL(fwd, dim3(grid), dim3(NWAVES * 64), LDS_BYTES, stream, a); }
#else
    a.ph_lo = 0; a.ph_hi = N_PHASES;
    hipLaunchKernelGGL(fwd, dim3(grid), dim3(NWAVES * 64), LDS_BYTES, stream, a);
#endif
    const hipError_t le = hipPeekAtLastError();
    if (le != hipSuccess) fprintf(stderr, "kernel_launch: launch failed: %s\n", hipGetErrorName(le));
}
```
